# Optimizing an MI355X kernel written in HIP

```python
import math
import jax, jax.numpy as jnp
from jax import lax
import numpy as np

D_MODEL = 1024
BATCH = 2
SEQ = 8192
DEPTH = 2

CHUNK = 64
Q_BLOCK = 128
MIX_W = 512
N_BRANCH = 3
EPS = 1e-6
FOX_HEADS = 8
FOX_HD = MIX_W // FOX_HEADS
GLA_HEADS = 4
GLA_DK = 64
GLA_DV = MIX_W // GLA_HEADS
GLA_RANK = 16
GLA_GATE_NORM = 16.0
SSM_HEADS = 8
SSM_HD = MIX_W // SSM_HEADS
SSM_GROUPS = 2
SSM_STATE = 64
SSM_CONV = 4
SSM_CONV_DIM = MIX_W + 2 * SSM_GROUPS * SSM_STATE
N_EGROUPS = 4
EXP_PER_GROUP = 4
N_EXPERTS = N_EGROUPS * EXP_PER_GROUP
TOP_K = 2
D_EXPERT = 512
FOX_COLS = 3 * MIX_W + FOX_HEADS
GLA_COLS = 2 * GLA_HEADS * GLA_DK + 2 * MIX_W + GLA_RANK
SSM_COLS = MIX_W + SSM_CONV_DIM + SSM_HEADS
GATE_COLS = N_BRANCH * D_MODEL
IN_COLS = FOX_COLS + GLA_COLS + SSM_COLS + GATE_COLS

kernel_name = "hybrid_fox_gla_ssd_hiermoe_block"


def rms_norm(x, gain):
    xf = x.astype(jnp.float32)
    y = xf * lax.rsqrt(jnp.mean(xf * xf, axis=-1, keepdims=True) + EPS)
    return (y * gain.astype(jnp.float32)).astype(x.dtype)


def _to_chunks(t):
    b, s, h = t.shape[:3]
    rest = t.shape[3:]
    t = t.reshape((b, s // CHUNK, CHUNK, h) + rest)
    perm = (0, 3, 1, 2) + tuple(range(4, t.ndim))
    return jnp.transpose(t, perm).astype(jnp.float32)


def _scan_chunk_states(decay, upd):
    dec = jnp.moveaxis(decay, 2, 0)
    up = jnp.moveaxis(upd, 2, 0)

    def step(state, inp):
        d, u = inp
        return d * state + u, state

    _, prev = lax.scan(step, jnp.zeros(up.shape[1:], up.dtype), (dec, up))
    return jnp.moveaxis(prev, 0, 2)


def forgetting_attention(q, k, v, f_logit, q_gain, k_gain):
    b, s, h, hd = q.shape
    q = rms_norm(q, q_gain) * (hd ** -0.5)
    k = rms_norm(k, k_gain)
    c = jnp.cumsum(jax.nn.log_sigmoid(f_logit.astype(jnp.float32)), axis=1)
    c = jnp.transpose(c, (0, 2, 1))
    qh = jnp.transpose(q, (0, 2, 1, 3))
    kh = jnp.transpose(k, (0, 2, 1, 3))
    vh = jnp.transpose(v, (0, 2, 1, 3))
    nqb = s // Q_BLOCK
    qb = jnp.transpose(qh.reshape(b, h, nqb, Q_BLOCK, hd), (2, 0, 1, 3, 4))
    cb = jnp.transpose(c.reshape(b, h, nqb, Q_BLOCK), (2, 0, 1, 3))
    qpos = jnp.arange(nqb)[:, None] * Q_BLOCK + jnp.arange(Q_BLOCK)[None, :]
    kpos = jnp.arange(s)

    def block(args):
        qi, ci, pi = args
        sc = jnp.einsum('bhqd,bhkd->bhqk', qi, kh).astype(jnp.float32)
        sc = sc + ci[..., None] - c[:, :, None, :]
        sc = jnp.where(pi[:, None] >= kpos[None, :], sc, -jnp.inf)
        p = jax.nn.softmax(sc, axis=-1)
        return jnp.einsum('bhqk,bhkd->bhqd', p.astype(vh.dtype), vh)

    o = lax.map(block, (qb, cb, qpos))
    return jnp.transpose(o, (1, 0, 3, 2, 4)).reshape(b, s, h * hd)


def gla_chunked(q, k, v, log_a):
    b, s, h, dk = q.shape
    dv = v.shape[-1]
    qc = _to_chunks(q) * (dk ** -0.5)
    kc = _to_chunks(k)
    vc = _to_chunks(v)
    g = _to_chunks(log_a)
    bcum = jnp.cumsum(g, axis=3)
    b_last = bcum[:, :, :, -1:, :]
    q_dec = qc * jnp.exp(bcum)
    k_dec = kc * jnp.exp(-bcum)
    causal = jnp.tril(jnp.ones((CHUNK, CHUNK), dtype=bool))
    attn = jnp.where(causal, jnp.einsum('bhctd,bhcsd->bhcts', q_dec, k_dec), 0.0)
    o_intra = jnp.einsum('bhcts,bhcsv->bhctv', attn, vc)
    kv = jnp.einsum('bhcsd,bhcsv->bhcdv', kc * jnp.exp(b_last - bcum), vc)
    prev = _scan_chunk_states(jnp.exp(b_last[:, :, :, 0, :])[..., None], kv)
    o = o_intra + jnp.einsum('bhctd,bhcdv->bhctv', q_dec, prev)
    return jnp.transpose(o, (0, 2, 3, 1, 4)).reshape(b, s, h, dv).astype(q.dtype)


def causal_depthwise_conv(u, w, bias):
    ch = u.shape[-1]
    out = lax.conv_general_dilated(u, w[:, None, :].astype(u.dtype), window_strides=(1,),
                                   padding=[(w.shape[0] - 1, 0)],
                                   dimension_numbers=('NWC', 'WIO', 'NWC'),
                                   feature_group_count=ch)
    return out + bias


def ssd_chunked(x, dt, a, bm, cm):
    hpg = SSM_HEADS // SSM_GROUPS
    bc = _to_chunks(jnp.repeat(bm, hpg, axis=2))
    cc = _to_chunks(jnp.repeat(cm, hpg, axis=2))
    xc = _to_chunks(x)
    dtc = _to_chunks(dt)
    acs = jnp.cumsum(dtc * a[:, None, None], axis=-1)
    causal = jnp.tril(jnp.ones((CHUNK, CHUNK), dtype=bool))
    decay = jnp.exp(jnp.where(causal, acs[..., :, None] - acs[..., None, :], -jnp.inf))
    xdt = xc * dtc[..., None]
    scores = jnp.einsum('bhctn,bhcsn->bhcts', cc, bc) * decay
    y_intra = jnp.einsum('bhcts,bhcsp->bhctp', scores, xdt)
    to_end = jnp.exp(acs[..., -1:] - acs)
    states = jnp.einsum('bhcsn,bhcsp->bhcnp', bc * to_end[..., None], xdt)
    prev = _scan_chunk_states(jnp.exp(acs[..., -1])[..., None, None], states)
    y = y_intra + jnp.einsum('bhctn,bhcnp->bhctp', cc * jnp.exp(acs)[..., None], prev)
    b, h, nc, c, p = y.shape
    return jnp.transpose(y, (0, 2, 3, 1, 4)).reshape(b, nc * c, h, p)


def mamba2_branch(z, xbc, dt_raw, conv_w, conv_b, dt_bias, a_log, d_skip, out_norm):
    b, s, _ = z.shape
    xbc = jax.nn.silu(causal_depthwise_conv(xbc, conv_w, conv_b))
    xs, bm, cm = jnp.split(xbc, [MIX_W, MIX_W + SSM_GROUPS * SSM_STATE], axis=-1)
    xs_h = xs.reshape(b, s, SSM_HEADS, SSM_HD)
    dt = jax.nn.softplus((dt_raw + dt_bias).astype(jnp.float32))
    a = -jnp.exp(a_log.astype(jnp.float32))
    y = ssd_chunked(xs_h, dt, a, bm.reshape(b, s, SSM_GROUPS, SSM_STATE),
                    cm.reshape(b, s, SSM_GROUPS, SSM_STATE))
    y = y + d_skip.astype(jnp.float32)[:, None] * xs_h.astype(jnp.float32)
    y = y.reshape(b, s, MIX_W).astype(z.dtype) * jax.nn.silu(z)
    y = rms_norm(y.reshape(b, s, SSM_GROUPS, MIX_W // SSM_GROUPS),
                 out_norm.reshape(SSM_GROUPS, MIX_W // SSM_GROUPS))
    return y.reshape(b, s, MIX_W)


def hierarchical_moe(h, w_router_grp, b_router_grp, w_router_exp, b_router_exp,
                     w_exp_gate, w_exp_up, w_exp_down):
    b, s, d = h.shape
    t = h.reshape(b * s, d)
    g_prob = jax.nn.softmax((t @ w_router_grp + b_router_grp).astype(jnp.float32), axis=-1)
    g_w, g_sel = lax.top_k(g_prob, 1)
    e_logits = (t @ w_router_exp + b_router_exp).astype(jnp.float32)
    e_logits = e_logits.reshape(-1, N_EGROUPS, EXP_PER_GROUP)
    e_in = jnp.einsum('tg,tge->te', jax.nn.one_hot(g_sel[:, 0], N_EGROUPS, dtype=jnp.float32), e_logits)
    top_w, top_i = lax.top_k(jax.nn.softmax(e_in, axis=-1), TOP_K)
    top_w = top_w / jnp.sum(top_w, axis=-1, keepdims=True) * g_w
    expert_id = g_sel * EXP_PER_GROUP + top_i
    combine = jnp.sum(jax.nn.one_hot(expert_id, N_EXPERTS, dtype=jnp.float32) * top_w[..., None], axis=1)
    combine = combine.astype(t.dtype)
    out = jnp.zeros_like(t)
    for e in range(N_EXPERTS):
        hid = jax.nn.silu(t @ w_exp_gate[e]) * (t @ w_exp_up[e])
        out = out + combine[:, e:e + 1] * (hid @ w_exp_down[e])
    return out.reshape(b, s, d)


def _layer(x, norm_mix, w_in, fox_f_bias, fox_q_norm, fox_k_norm, gla_w_lr, gla_b_gate,
           gla_out_norm, ssm_conv_w, ssm_conv_b, ssm_dt_bias, ssm_a_log, ssm_d, ssm_out_norm,
           w_branch, b_branch_gate, w_out, norm_ffn, w_router_grp, b_router_grp,
           w_router_exp, b_router_exp, w_exp_gate, w_exp_up, w_exp_down):
    b, s, _ = x.shape
    h = rms_norm(x, norm_mix)
    proj = h @ w_in
    sizes = [MIX_W, MIX_W, MIX_W, FOX_HEADS,
             GLA_HEADS * GLA_DK, GLA_HEADS * GLA_DK, MIX_W, MIX_W, GLA_RANK,
             MIX_W, SSM_CONV_DIM, SSM_HEADS, GATE_COLS]
    offsets = [int(o) for o in np.cumsum(sizes)[:-1]]
    (fq, fk, fv, ff, gq, gk, gv, gr, glr, sz, sxbc, sdt, gate_pre) = jnp.split(proj, offsets, axis=-1)
    o_a = forgetting_attention(fq.reshape(b, s, FOX_HEADS, FOX_HD), fk.reshape(b, s, FOX_HEADS, FOX_HD),
                               fv.reshape(b, s, FOX_HEADS, FOX_HD), ff + fox_f_bias,
                               fox_q_norm, fox_k_norm)
    log_a = jax.nn.log_sigmoid((glr @ gla_w_lr + gla_b_gate).astype(jnp.float32)) / GLA_GATE_NORM
    o_b = gla_chunked(gq.reshape(b, s, GLA_HEADS, GLA_DK), gk.reshape(b, s, GLA_HEADS, GLA_DK),
                      gv.reshape(b, s, GLA_HEADS, GLA_DV), log_a.reshape(b, s, GLA_HEADS, GLA_DK))
    o_b = rms_norm(o_b, gla_out_norm).reshape(b, s, MIX_W) * jax.nn.silu(gr)
    o_c = mamba2_branch(sz, sxbc, sdt, ssm_conv_w, ssm_conv_b, ssm_dt_bias, ssm_a_log, ssm_d, ssm_out_norm)
    branches = jnp.stack([o_a, o_b, o_c], axis=2)
    proj_b = jnp.einsum('bsrc,rcd->bsrd', branches, w_branch)
    gates = jax.nn.sigmoid(gate_pre.reshape(b, s, N_BRANCH, D_MODEL) + b_branch_gate)
    x = x + jnp.sum(gates * proj_b, axis=2) @ w_out
    x = x + hierarchical_moe(rms_norm(x, norm_ffn), w_router_grp, b_router_grp, w_router_exp,
                             b_router_exp, w_exp_gate, w_exp_up, w_exp_down)
    return x


def setup_inputs(seed: int = 0) -> dict:
    key = jax.random.key(seed)
    ks = jax.random.split(key, 32)
    L, D = DEPTH, D_MODEL
    f32 = jnp.float32

    def nrm(k, shape, scale):
        return jax.random.normal(k, shape, f32) * scale

    dt = jnp.exp(jax.random.uniform(ks[12], (L, SSM_HEADS), f32) * (math.log(0.1) - math.log(0.001))
                 + math.log(0.001))
    return {
        "x": nrm(ks[0], (BATCH, SEQ, D), 1.0),
        "norm_mix": 1.0 + nrm(ks[1], (L, D), 0.05),
        "w_in": nrm(ks[2], (L, D, IN_COLS), D ** -0.5),
        "fox_f_bias": 2.0 + nrm(ks[3], (L, FOX_HEADS), 0.5),
        "fox_q_norm": 1.0 + nrm(ks[4], (L, FOX_HD), 0.05),
        "fox_k_norm": 1.0 + nrm(ks[5], (L, FOX_HD), 0.05),
        "gla_w_lr": nrm(ks[6], (L, GLA_RANK, GLA_HEADS * GLA_DK), GLA_RANK ** -0.5),
        "gla_b_gate": nrm(ks[7], (L, GLA_HEADS * GLA_DK), 0.1),
        "gla_out_norm": 1.0 + nrm(ks[8], (L, GLA_DV), 0.05),
        "ssm_conv_w": nrm(ks[9], (L, SSM_CONV, SSM_CONV_DIM), SSM_CONV ** -0.5),
        "ssm_conv_b": nrm(ks[10], (L, SSM_CONV_DIM), 0.02),
        "ssm_dt_bias": dt + jnp.log(-jnp.expm1(-dt)),
        "ssm_a_log": jnp.log(jax.random.uniform(ks[11], (L, SSM_HEADS), f32, 1.0, 16.0)),
        "ssm_d": 1.0 + nrm(ks[13], (L, SSM_HEADS), 0.05),
        "ssm_out_norm": 1.0 + nrm(ks[14], (L, MIX_W), 0.05),
        "w_branch": nrm(ks[15], (L, N_BRANCH, MIX_W, D), MIX_W ** -0.5),
        "b_branch_gate": nrm(ks[16], (L, N_BRANCH, D), 0.1),
        "w_out": nrm(ks[17], (L, D, D), D ** -0.5),
        "norm_ffn": 1.0 + nrm(ks[18], (L, D), 0.05),
        "w_router_grp": nrm(ks[19], (L, D, N_EGROUPS), D ** -0.5),
        "b_router_grp": nrm(ks[20], (L, N_EGROUPS), 0.01),
        "w_router_exp": nrm(ks[21], (L, D, N_EXPERTS), D ** -0.5),
        "b_router_exp": nrm(ks[22], (L, N_EXPERTS), 0.01),
        "w_exp_gate": nrm(ks[23], (L, N_EXPERTS, D, D_EXPERT), D ** -0.5),
        "w_exp_up": nrm(ks[24], (L, N_EXPERTS, D, D_EXPERT), D ** -0.5),
        "w_exp_down": nrm(ks[25], (L, N_EXPERTS, D_EXPERT, D), D_EXPERT ** -0.5),
    }


def reference(x, norm_mix, w_in, fox_f_bias, fox_q_norm, fox_k_norm, gla_w_lr, gla_b_gate,
              gla_out_norm, ssm_conv_w, ssm_conv_b, ssm_dt_bias, ssm_a_log, ssm_d, ssm_out_norm,
              w_branch, b_branch_gate, w_out, norm_ffn, w_router_grp, b_router_grp,
              w_router_exp, b_router_exp, w_exp_gate, w_exp_up, w_exp_down):
    for l in range(DEPTH):
        x = _layer(x, norm_mix[l], w_in[l], fox_f_bias[l], fox_q_norm[l], fox_k_norm[l],
                   gla_w_lr[l], gla_b_gate[l], gla_out_norm[l], ssm_conv_w[l], ssm_conv_b[l],
                   ssm_dt_bias[l], ssm_a_log[l], ssm_d[l], ssm_out_norm[l], w_branch[l],
                   b_branch_gate[l], w_out[l], norm_ffn[l], w_router_grp[l], b_router_grp[l],
                   w_router_exp[l], b_router_exp[l], w_exp_gate[l], w_exp_up[l], w_exp_down[l])
    return x
```

```cpp
#include <hip/hip_runtime.h>
#include <cstdio>
#include <cstdint>

#ifndef MK_SPLIT
#define MK_SPLIT 0
#endif

#define GAS __attribute__((address_space(1)))
#define LAS __attribute__((address_space(3)))
typedef unsigned short bf16;
typedef unsigned v4u __attribute__((ext_vector_type(4)));
typedef unsigned v2u __attribute__((ext_vector_type(2)));
typedef float f32x4 __attribute__((ext_vector_type(4)));

constexpr int T_ = 16384, S_ = 8192, D_ = 1024, NLAYER = 2, INC = 7456, NWAVES = 8, NTHR = 512;
constexpr float LOG2E = 1.4426950408889634f, EPS = 1e-6f;
constexpr int FOXP = 1536, GLAP = 1536, SSMP = 1280, SMLP = 32, GATP = 3072;
constexpr size_t MiB = 1u << 20;
constexpr size_t WS_CTL = 0, CTL_ZERO_BYTES = 1 * MiB;
constexpr size_t WS_WSM = 1 * MiB, WS_HB = 21 * MiB, WS_SST = 53 * MiB, WS_FOX = 85 * MiB, WS_GLA = 133 * MiB, WS_SSM = 181 * MiB;
constexpr size_t WS_SML = 221 * MiB, WS_CUM = 223 * MiB, WS_TOKE = 223 * MiB + 512 * 1024, WS_TOKW = 223 * MiB + 768 * 1024, WS_GATES = 224 * MiB, WS_END = 320 * MiB;
constexpr int CW_BAR = 4096;
constexpr int RING_BYTES = 131072, LDSCTL_OFF = RING_BYTES, MISC_OFF = LDSCTL_OFF + 320, LDS_BYTES = 147456;

__device__ __forceinline__ float bf2f(unsigned u) { return __builtin_bit_cast(float, u << 16); }
__device__ __forceinline__ unsigned f2bf(float f) { unsigned u = __builtin_bit_cast(unsigned, f); return (u + 0x7fffu + ((u >> 16) & 1u)) >> 16; }
__device__ __forceinline__ unsigned pk2(float lo, float hi) { return f2bf(lo) | (f2bf(hi) << 16); }
__device__ __forceinline__ float silu_f(float x) { return x / (1.f + __expf(-x)); }
__device__ __forceinline__ float sigmoid_f(float x) { return 1.f / (1.f + __expf(-x)); }
__device__ __forceinline__ float softplus_f(float x) { return fmaxf(x, 0.f) + log1pf(__expf(-fabsf(x))); }
__device__ __forceinline__ float logsig_f(float x) { return fminf(x, 0.f) - log1pf(__expf(-fabsf(x))); }
__device__ __forceinline__ float wave_sum(float v) {
#pragma unroll
    for (int o = 1; o < 64; o <<= 1) v += __shfl_xor(v, o);
    return v;
}

#define XB_TMO      128
#define XB_XCNT(j)  (256  + 64 * (j))
#define XB_XSUB(j)  (1280 + 64 * (j))
#define XB_XGEN(j)  (2304 + 64 * (j))
#define XB_TOP      3328
#define XB_TOPGEN   3392
#define XCD_BAR_WORDS 3456
#define XB_SPIN_CAP (1u << 23)
__device__ __forceinline__ unsigned xb_ld(unsigned* p)              { return __hip_atomic_load(p, __ATOMIC_RELAXED, __HIP_MEMORY_SCOPE_AGENT); }
__device__ __forceinline__ unsigned xb_add(unsigned* p, unsigned v) { return __hip_atomic_fetch_add(p, v, __ATOMIC_RELAXED, __HIP_MEMORY_SCOPE_AGENT); }
__device__ __forceinline__ unsigned xb_xcc_id() { return (unsigned)__builtin_amdgcn_s_getreg((3 << 11) | 20) & 0xFu; }
#define XB_SPIN(cond, bar) do { unsigned _sp = 0; while (cond) { __builtin_amdgcn_s_sleep(1); \
    if ((++_sp & 255u) == 0u) { if (xb_ld(&(bar)[XB_TMO])) break; if (_sp > XB_SPIN_CAP) { atomicAdd(&(bar)[XB_TMO], 1u); break; } } } } while (0)
struct XcdBarrier { unsigned* bar; unsigned x; volatile LAS unsigned* st; };
__device__ __forceinline__ XcdBarrier xcd_barrier_post(unsigned* bar, volatile LAS unsigned* st) {
    XcdBarrier b; b.bar = bar; b.x = xb_xcc_id(); b.st = st;
    if (threadIdx.x == 0) (void)xb_add(&bar[XB_XCNT(b.x)], 1u);
    return b;
}
__device__ __forceinline__ void xcd_barrier_complete(unsigned* bar, unsigned x, unsigned& nloc, unsigned& nx) {
    const unsigned G = gridDim.x * gridDim.y * gridDim.z;
    unsigned sum, cnt, mine, sp = 0u;
    for (;;) {
        sum = 0u; cnt = 0u; mine = 0u;
#pragma unroll
        for (unsigned j = 0; j < 16; ++j) { const unsigned c = xb_ld(&bar[XB_XCNT(j)]); sum += c; cnt += (c > 0u) ? 1u : 0u; mine = (j == x) ? c : mine; }
        if (sum == G) break;
        __builtin_amdgcn_s_sleep(1);
        if ((++sp & 255u) == 0u) { if (xb_ld(&bar[XB_TMO])) break; if (sp > XB_SPIN_CAP) { atomicAdd(&bar[XB_TMO], 1u); break; } }
    }
    nloc = mine > 0u ? mine : 1u; nx = cnt > 0u ? cnt : 1u;
}
__device__ __forceinline__ void xcd_barrier(const XcdBarrier& b) {
    asm volatile("s_waitcnt vmcnt(0)" ::: "memory");
    __syncthreads();
    if (threadIdx.x == 0) {
        unsigned* bar = b.bar;
        __builtin_amdgcn_s_waitcnt(0);
        unsigned nloc = b.st[0], nx = b.st[1];
        if (nloc == 0u) { xcd_barrier_complete(bar, b.x, nloc, nx); b.st[0] = nloc; b.st[1] = nx; }
        const unsigned old = xb_add(&bar[XB_XSUB(b.x)], 1u);
        const unsigned gen = old / nloc;
        if (old + 1u == (gen + 1u) * nloc) {
            __builtin_amdgcn_fence(__ATOMIC_RELEASE, "agent");
            asm volatile("s_waitcnt vmcnt(0)" ::: "memory");
            const unsigned og = xb_add(&bar[XB_TOP], 1u);
            const unsigned tg = og / nx;
            if (og + 1u == (tg + 1u) * nx) xb_add(&bar[XB_TOPGEN], 1u);
            else XB_SPIN(xb_ld(&bar[XB_TOPGEN]) == tg, bar);
            __builtin_amdgcn_fence(__ATOMIC_ACQUIRE, "agent");
            xb_add(&bar[XB_XGEN(b.x)], 1u);
            asm volatile("s_waitcnt vmcnt(0)" ::: "memory");
        } else {
            XB_SPIN(xb_ld(&bar[XB_XGEN(b.x)]) == gen, bar);
            __builtin_amdgcn_fence(__ATOMIC_ACQUIRE, "agent");
            asm volatile("s_waitcnt vmcnt(0)" ::: "memory");
        }
    }
    __syncthreads();
}

__device__ __forceinline__ void ph_norm(const float* x, const float* gain, bf16* out, int wave, int lane) {
    const int gw = blockIdx.x * NWAVES + wave, NGW = gridDim.x * NWAVES;
    for (int m = gw; m < T_; m += NGW) {
        const f32x4* xr = (const f32x4*)(x + (size_t)m * D_) + lane;
        f32x4 v[4]; float s = 0.f;
#pragma unroll
        for (int j = 0; j < 4; ++j) { v[j] = xr[64 * j]; s += (v[j].x * v[j].x + v[j].y * v[j].y) + (v[j].z * v[j].z + v[j].w * v[j].w); }
        const float r = rsqrtf(wave_sum(s) * (1.f / D_) + EPS);
        v2u* o8 = (v2u*)(out + (size_t)m * D_) + lane;
#pragma unroll
        for (int j = 0; j < 4; ++j) { const f32x4 g = ((const f32x4*)gain)[lane + 64 * j]; v2u w; w.x = pk2(v[j].x * r * g.x, v[j].y * r * g.y); w.y = pk2(v[j].z * r * g.z, v[j].w * r * g.w); o8[64 * j] = w; }
    }
}

__device__ __forceinline__ void ph_inproj_simple(const bf16* HB, const float* w_in, const float* f_bias, const float* qn, const float* kn, const float* dt_bias, const float* bgate,
                                                 bf16* FOX, bf16* GLA, bf16* SSM, float* SML, bf16* GATES, int tid) {
    const int r = tid >> 3, cg = tid & 7;
    constexpr int NTC = (INC + 63) / 64;
    for (int item = blockIdx.x; item < (T_ / 64) * NTC; item += gridDim.x) {
        const int tm = item / NTC, tn = item % NTC;
        const int row = tm * 64 + r, c0 = tn * 64 + cg * 8;
        float acc[8];
#pragma unroll
        for (int j = 0; j < 8; ++j) acc[j] = 0.f;
        if (c0 < INC) {
            const bf16* a = HB + (size_t)row * D_;
            const float* w = w_in + c0;
            for (int k8 = 0; k8 < D_ / 8; ++k8) {
                const v4u av = *(const v4u*)(a + 8 * k8);
                float af[8] = {bf2f(av.x & 0xffffu), bf2f(av.x >> 16), bf2f(av.y & 0xffffu), bf2f(av.y >> 16), bf2f(av.z & 0xffffu), bf2f(av.z >> 16), bf2f(av.w & 0xffffu), bf2f(av.w >> 16)};
#pragma unroll
                for (int kk = 0; kk < 8; ++kk) {
                    const f32x4 w0 = *(const f32x4*)(w + (size_t)(8 * k8 + kk) * INC), w1 = *(const f32x4*)(w + (size_t)(8 * k8 + kk) * INC + 4);
                    acc[0] += af[kk] * w0.x; acc[1] += af[kk] * w0.y; acc[2] += af[kk] * w0.z; acc[3] += af[kk] * w0.w;
                    acc[4] += af[kk] * w1.x; acc[5] += af[kk] * w1.y; acc[6] += af[kk] * w1.z; acc[7] += af[kk] * w1.w;
                }
            }
        }
        if (c0 < 1024) {
            float ss = 0.f;
#pragma unroll
            for (int j = 0; j < 8; ++j) ss += acc[j] * acc[j];
            ss += __shfl_xor(ss, 1); ss += __shfl_xor(ss, 2); ss += __shfl_xor(ss, 4);
            const float rs = rsqrtf(ss * (1.f / 64.f) + EPS);
            const bool isq = c0 < 512; const float* gain = isq ? qn : kn; const float sc = isq ? 0.125f * LOG2E : 1.f;
            float v[8];
#pragma unroll
            for (int j = 0; j < 8; ++j) v[j] = acc[j] * rs * gain[(c0 + j) & 63] * sc;
            v4u o; o.x = pk2(v[0], v[1]); o.y = pk2(v[2], v[3]); o.z = pk2(v[4], v[5]); o.w = pk2(v[6], v[7]);
            *(v4u*)(FOX + (size_t)row * FOXP + c0) = o;
        } else if (c0 < INC) {
#pragma unroll
            for (int j = 0; j < 8; ++j) {
                const int col = c0 + j; const float v = acc[j];
                if (col < 1536) FOX[(size_t)row * FOXP + col] = (bf16)f2bf(v);
                else if (col < 1544) SML[(size_t)row * SMLP + (col - 1536)] = logsig_f(v + f_bias[col - 1536]) * LOG2E;
                else if (col < 3080) GLA[(size_t)row * GLAP + (col - 1544)] = (bf16)f2bf(v);
                else if (col < 3096) SML[(size_t)row * SMLP + 8 + (col - 3080)] = v;
                else if (col < 4376) SSM[(size_t)row * SSMP + (col - 3096)] = (bf16)f2bf(v);
                else if (col < 4384) SML[(size_t)row * SMLP + 24 + (col - 4376)] = softplus_f(v + dt_bias[col - 4376]);
                else GATES[(size_t)row * GATP + (col - 4384)] = (bf16)f2bf(sigmoid_f(v + bgate[col - 4384]));
            }
        }
    }
}

__device__ __forceinline__ void ph_cumsum(const float* SML, float* CUM, LAS float* sh, int tid) {
    for (int seq = blockIdx.x; seq < 16; seq += gridDim.x) {
        const int b = seq >> 3, h = seq & 7;
        float loc[16]; float run = 0.f;
#pragma unroll
        for (int i = 0; i < 16; ++i) { run += SML[(size_t)(b * S_ + tid * 16 + i) * SMLP + h]; loc[i] = run; }
        __syncthreads();
        sh[tid] = run;
        __syncthreads();
        if (tid == 0) { float a = 0.f; for (int i = 0; i < NTHR; ++i) { const float t = sh[i]; sh[i] = a; a += t; } }
        __syncthreads();
        const float ex = sh[tid];
#pragma unroll
        for (int i = 0; i < 16; ++i) CUM[(size_t)seq * S_ + tid * 16 + i] = ex + loc[i];
    }
}

__device__ __forceinline__ void attn_simple_wave(bf16* FOX, const float* CUM, int b, int h, int g, int lane) {
    const int t = g * 32 + (lane >> 1), hf = lane & 1;
    const size_t rowq = (size_t)(b * S_ + t) * FOXP + h * 64 + hf * 32;
    float q[32], o[32];
#pragma unroll
    for (int i = 0; i < 4; ++i) { const v4u w = *(const v4u*)(FOX + rowq + 8 * i);
        q[8 * i + 0] = bf2f(w.x & 0xffffu); q[8 * i + 1] = bf2f(w.x >> 16); q[8 * i + 2] = bf2f(w.y & 0xffffu); q[8 * i + 3] = bf2f(w.y >> 16);
        q[8 * i + 4] = bf2f(w.z & 0xffffu); q[8 * i + 5] = bf2f(w.z >> 16); q[8 * i + 6] = bf2f(w.w & 0xffffu); q[8 * i + 7] = bf2f(w.w >> 16); }
#pragma unroll
    for (int d = 0; d < 32; ++d) o[d] = 0.f;
    const float* cs = CUM + (size_t)(b * 8 + h) * S_;
    const float cq = cs[t];
    float m = -1e30f, l = 0.f;
    const int smax = g * 32 + 31;
#pragma unroll 1
    for (int s = 0; s <= smax; ++s) {
        const bf16* kp = FOX + (size_t)(b * S_ + s) * FOXP + 512 + h * 64 + hf * 32;
        float dot = 0.f;
#pragma unroll
        for (int i = 0; i < 4; ++i) { const v4u w = *(const v4u*)(kp + 8 * i);
            dot += q[8 * i + 0] * bf2f(w.x & 0xffffu) + q[8 * i + 1] * bf2f(w.x >> 16) + q[8 * i + 2] * bf2f(w.y & 0xffffu) + q[8 * i + 3] * bf2f(w.y >> 16)
                 + q[8 * i + 4] * bf2f(w.z & 0xffffu) + q[8 * i + 5] * bf2f(w.z >> 16) + q[8 * i + 6] * bf2f(w.w & 0xffffu) + q[8 * i + 7] * bf2f(w.w >> 16); }
        dot += __shfl_xor(dot, 1);
        float logit = dot + (cq - cs[s]);
        if (s > t) logit = -1e30f;
        const float mn = fmaxf(m, logit);
        const float sc = exp2f(m - mn), p = (s > t) ? 0.f : exp2f(logit - mn);
        l = l * sc + p; m = mn;
        const bf16* vp = kp + 512;
#pragma unroll
        for (int i = 0; i < 4; ++i) { const v4u w = *(const v4u*)(vp + 8 * i);
            o[8 * i + 0] = o[8 * i + 0] * sc + p * bf2f(w.x & 0xffffu); o[8 * i + 1] = o[8 * i + 1] * sc + p * bf2f(w.x >> 16);
            o[8 * i + 2] = o[8 * i + 2] * sc + p * bf2f(w.y & 0xffffu); o[8 * i + 3] = o[8 * i + 3] * sc + p * bf2f(w.y >> 16);
            o[8 * i + 4] = o[8 * i + 4] * sc + p * bf2f(w.z & 0xffffu); o[8 * i + 5] = o[8 * i + 5] * sc + p * bf2f(w.z >> 16);
            o[8 * i + 6] = o[8 * i + 6] * sc + p * bf2f(w.w & 0xffffu); o[8 * i + 7] = o[8 * i + 7] * sc + p * bf2f(w.w >> 16); }
    }
    const float rl = 1.f / l;
#pragma unroll
    for (int i = 0; i < 4; ++i) { v4u w; w.x = pk2(o[8 * i] * rl, o[8 * i + 1] * rl); w.y = pk2(o[8 * i + 2] * rl, o[8 * i + 3] * rl); w.z = pk2(o[8 * i + 4] * rl, o[8 * i + 5] * rl); w.w = pk2(o[8 * i + 6] * rl, o[8 * i + 7] * rl);
        *(v4u*)(FOX + rowq + 8 * i) = w; }
}

__device__ __forceinline__ void gla_simple_item(bf16* GLA, const float* SML, const float* w_lr, const float* b_gate, LAS float* L, int b, int h, int tid) {
    LAS float* qs = L; LAS float* ks = L + 4096; LAS float* ad = L + 8192; LAS float* vs = L + 12288; LAS float* ob = L + 20480; LAS float* red = L + 28672;
    const int v = tid & 127, dg = tid >> 7;
    float S[16];
#pragma unroll
    for (int i = 0; i < 16; ++i) S[i] = 0.f;
    for (int c = 0; c < S_ / 64; ++c) {
        const size_t row0 = (size_t)b * S_ + (size_t)c * 64;
        __syncthreads();
        for (int idx = tid; idx < 4096; idx += NTHR) { const int t = idx >> 6, d = idx & 63; const size_t row = row0 + t;
            qs[idx] = bf2f(GLA[row * GLAP + h * 64 + d]) * 0.125f; ks[idx] = bf2f(GLA[row * GLAP + 256 + h * 64 + d]);
            float z = b_gate[h * 64 + d];
#pragma unroll
            for (int j = 0; j < 16; ++j) z += SML[row * SMLP + 8 + j] * w_lr[j * 256 + h * 64 + d];
            ad[idx] = __expf(logsig_f(z) * (1.f / 16.f)); }
        for (int idx = tid; idx < 8192; idx += NTHR) { const int t = idx >> 7, vv = idx & 127; vs[idx] = bf2f(GLA[(row0 + t) * GLAP + 512 + h * 128 + vv]); }
        __syncthreads();
        for (int t = 0; t < 64; ++t) {
            const float vt = vs[t * 128 + v]; float part = 0.f;
#pragma unroll
            for (int i = 0; i < 16; ++i) { const int d = dg * 16 + i; S[i] = ad[t * 64 + d] * S[i] + ks[t * 64 + d] * vt; part += qs[t * 64 + d] * S[i]; }
            red[(t & 1) * 512 + dg * 128 + v] = part;
            __syncthreads();
            if (dg == 0) { const LAS float* rr = red + (t & 1) * 512; ob[t * 128 + v] = (rr[v] + rr[128 + v]) + (rr[256 + v] + rr[384 + v]); }
        }
        __syncthreads();
        for (int idx = tid; idx < 8192; idx += NTHR) { const int t = idx >> 7, vv = idx & 127; GLA[(row0 + t) * GLAP + 512 + h * 128 + vv] = (bf16)f2bf(ob[idx]); }
    }
}

__device__ __forceinline__ void ssd_simple_item(bf16* SSM, const float* SML, const float* conv_w, const float* conv_b, const float* a_log, const float* d_skip, LAS float* L, int b, int h, int tid) {
    LAS float* xs = L; LAS float* Bs = L + 4096; LAS float* Cs = L + 8192; LAS float* dts = L + 12288; LAS float* yb = L + 12352; LAS float* red = L + 16448;
    const int p = tid & 63, ng = tid >> 6, g = h >> 2;
    const float a = -__expf(a_log[h]), Dk = d_skip[h];
    float hs[8];
#pragma unroll
    for (int i = 0; i < 8; ++i) hs[i] = 0.f;
    for (int c = 0; c < S_ / 64; ++c) {
        const int s0 = c * 64;
        __syncthreads();
        for (int idx = tid; idx < 3 * 4096; idx += NTHR) { const int which = idx >> 12, t = (idx >> 6) & 63, n = idx & 63;
            const int ch = (which == 0) ? (h * 64 + n) : (which == 1 ? 512 + g * 64 + n : 640 + g * 64 + n);
            float acc = conv_b[ch];
#pragma unroll
            for (int j = 0; j < 4; ++j) { const int s = s0 + t - 3 + j; if (s >= 0) acc += conv_w[j * 768 + ch] * bf2f(SSM[((size_t)b * S_ + s) * SSMP + 512 + ch]); }
            L[idx] = silu_f(acc); }
        if (tid < 64) dts[tid] = SML[((size_t)b * S_ + s0 + tid) * SMLP + 24 + h];
        __syncthreads();
        for (int t = 0; t < 64; ++t) {
            const float dt = dts[t], dA = __expf(dt * a), xt = xs[t * 64 + p]; float part = 0.f;
#pragma unroll
            for (int i = 0; i < 8; ++i) { const int n = ng * 8 + i; hs[i] = dA * hs[i] + dt * Bs[t * 64 + n] * xt; part += Cs[t * 64 + n] * hs[i]; }
            red[(t & 1) * 512 + ng * 64 + p] = part;
            __syncthreads();
            if (ng == 0) { const LAS float* rr = red + (t & 1) * 512; float y = 0.f;
#pragma unroll
                for (int i = 0; i < 8; ++i) y += rr[i * 64 + p];
                yb[t * 64 + p] = y + Dk * xt; }
        }
        __syncthreads();
        for (int idx = tid; idx < 4096; idx += NTHR) { const int t = idx >> 6, pp = idx & 63; const size_t e = ((size_t)b * S_ + s0 + t) * SSMP + h * 64 + pp;
            const float z = bf2f(SSM[e]); SSM[e] = (bf16)f2bf(yb[idx] * silu_f(z)); }
    }
}

__device__ __forceinline__ void ph_mix_simple(bf16* FOX, const float* CUM, bf16* GLA, bf16* SSM, const float* SML, const float* w_lr, const float* b_gate,
                                              const float* conv_w, const float* conv_b, const float* a_log, const float* d_skip, LAS float* L, int tid, int wave, int lane) {
    for (int it = blockIdx.x; it < 24 + 512; it += gridDim.x) {
        if (it < 8) gla_simple_item(GLA, SML, w_lr, b_gate, L, it >> 2, it & 3, tid);
        else if (it < 24) ssd_simple_item(SSM, SML, conv_w, conv_b, a_log, d_skip, L, (it - 8) >> 3, (it - 8) & 7, tid);
        else { const int wi = (it - 24) * 8 + wave; const int bh = wi >> 8, g = wi & 255; attn_simple_wave(FOX, CUM, bh >> 3, bh & 7, g, lane); }
        __syncthreads();
    }
}

__device__ __forceinline__ void ph_post(bf16* GLA, bf16* SSM, const float* gla_norm, const float* ssm_norm, int wave, int lane) {
    const int gw = blockIdx.x * NWAVES + wave, NGW = gridDim.x * NWAVES;
    for (int m = gw; m < T_; m += NGW) {
        {
            const v4u w = *(const v4u*)(GLA + (size_t)m * GLAP + 512 + 8 * lane), gr = *(const v4u*)(GLA + (size_t)m * GLAP + 1024 + 8 * lane);
            float o[8] = {bf2f(w.x & 0xffffu), bf2f(w.x >> 16), bf2f(w.y & 0xffffu), bf2f(w.y >> 16), bf2f(w.z & 0xffffu), bf2f(w.z >> 16), bf2f(w.w & 0xffffu), bf2f(w.w >> 16)};
            float gg[8] = {bf2f(gr.x & 0xffffu), bf2f(gr.x >> 16), bf2f(gr.y & 0xffffu), bf2f(gr.y >> 16), bf2f(gr.z & 0xffffu), bf2f(gr.z >> 16), bf2f(gr.w & 0xffffu), bf2f(gr.w >> 16)};
            float ss = 0.f;
#pragma unroll
            for (int j = 0; j < 8; ++j) ss += o[j] * o[j];
            ss += __shfl_xor(ss, 1); ss += __shfl_xor(ss, 2); ss += __shfl_xor(ss, 4); ss += __shfl_xor(ss, 8);
            const float rs = rsqrtf(ss * (1.f / 128.f) + EPS);
            float r[8];
#pragma unroll
            for (int j = 0; j < 8; ++j) r[j] = o[j] * rs * gla_norm[(8 * lane + j) & 127] * silu_f(gg[j]);
            v4u ov; ov.x = pk2(r[0], r[1]); ov.y = pk2(r[2], r[3]); ov.z = pk2(r[4], r[5]); ov.w = pk2(r[6], r[7]);
            *(v4u*)(GLA + (size_t)m * GLAP + 1024 + 8 * lane) = ov;
        }
        {
            const v4u w = *(const v4u*)(SSM + (size_t)m * SSMP + 8 * lane);
            float o[8] = {bf2f(w.x & 0xffffu), bf2f(w.x >> 16), bf2f(w.y & 0xffffu), bf2f(w.y >> 16), bf2f(w.z & 0xffffu), bf2f(w.z >> 16), bf2f(w.w & 0xffffu), bf2f(w.w >> 16)};
            float ss = 0.f;
#pragma unroll
            for (int j = 0; j < 8; ++j) ss += o[j] * o[j];
            ss += __shfl_xor(ss, 1); ss += __shfl_xor(ss, 2); ss += __shfl_xor(ss, 4); ss += __shfl_xor(ss, 8); ss += __shfl_xor(ss, 16);
            const float rs = rsqrtf(ss * (1.f / 256.f) + EPS);
            float r[8];
#pragma unroll
            for (int j = 0; j < 8; ++j) r[j] = o[j] * rs * ssm_norm[8 * lane + j];
            v4u ov; ov.x = pk2(r[0], r[1]); ov.y = pk2(r[2], r[3]); ov.z = pk2(r[4], r[5]); ov.w = pk2(r[6], r[7]);
            *(v4u*)(SSM + (size_t)m * SSMP + 8 * lane) = ov;
        }
    }
}

__device__ __forceinline__ void ph_merge_simple(bf16* FOX, const bf16* GLA, const bf16* SSM, const bf16* GATES, const float* w_branch, int tid) {
    const int r = tid >> 3, cg = tid & 7;
    for (int item = blockIdx.x; item < (T_ / 64) * 16; item += gridDim.x) {
        const int tm = item >> 4, tn = item & 15; const int row = tm * 64 + r, d0 = tn * 64 + cg * 8;
        float macc[8];
#pragma unroll
        for (int j = 0; j < 8; ++j) macc[j] = 0.f;
#pragma unroll 1
        for (int r3 = 0; r3 < 3; ++r3) {
            const bf16* a = (r3 == 0) ? FOX + (size_t)row * FOXP : (r3 == 1 ? GLA + (size_t)row * GLAP + 1024 : SSM + (size_t)row * SSMP);
            const float* w = w_branch + (size_t)r3 * 512 * 1024 + d0;
            float acc[8];
#pragma unroll
            for (int j = 0; j < 8; ++j) acc[j] = 0.f;
            for (int k8 = 0; k8 < 64; ++k8) {
                const v4u av = *(const v4u*)(a + 8 * k8);
                float af[8] = {bf2f(av.x & 0xffffu), bf2f(av.x >> 16), bf2f(av.y & 0xffffu), bf2f(av.y >> 16), bf2f(av.z & 0xffffu), bf2f(av.z >> 16), bf2f(av.w & 0xffffu), bf2f(av.w >> 16)};
#pragma unroll
                for (int kk = 0; kk < 8; ++kk) {
                    const f32x4 w0 = *(const f32x4*)(w + (size_t)(8 * k8 + kk) * 1024), w1 = *(const f32x4*)(w + (size_t)(8 * k8 + kk) * 1024 + 4);
                    acc[0] += af[kk] * w0.x; acc[1] += af[kk] * w0.y; acc[2] += af[kk] * w0.z; acc[3] += af[kk] * w0.w;
                    acc[4] += af[kk] * w1.x; acc[5] += af[kk] * w1.y; acc[6] += af[kk] * w1.z; acc[7] += af[kk] * w1.w;
                }
            }
            const v4u gv = *(const v4u*)(GATES + (size_t)row * GATP + r3 * 1024 + d0);
            macc[0] += bf2f(gv.x & 0xffffu) * acc[0]; macc[1] += bf2f(gv.x >> 16) * acc[1]; macc[2] += bf2f(gv.y & 0xffffu) * acc[2]; macc[3] += bf2f(gv.y >> 16) * acc[3];
            macc[4] += bf2f(gv.z & 0xffffu) * acc[4]; macc[5] += bf2f(gv.z >> 16) * acc[5]; macc[6] += bf2f(gv.w & 0xffffu) * acc[6]; macc[7] += bf2f(gv.w >> 16) * acc[7];
        }
        v4u o; o.x = pk2(macc[0], macc[1]); o.y = pk2(macc[2], macc[3]); o.z = pk2(macc[4], macc[5]); o.w = pk2(macc[6], macc[7]);
        *(v4u*)(FOX + (size_t)row * FOXP + 512 + d0) = o;
    }
}

__device__ __forceinline__ void ph_out_simple(const bf16* FOX, const float* w_out, const float* xold, float* xnew, int tid) {
    const int r = tid >> 3, cg = tid & 7;
    for (int item = blockIdx.x; item < (T_ / 64) * 16; item += gridDim.x) {
        const int tm = item >> 4, tn = item & 15; const int row = tm * 64 + r, d0 = tn * 64 + cg * 8;
        const bf16* a = FOX + (size_t)row * FOXP + 512; const float* w = w_out + d0;
        float acc[8];
#pragma unroll
        for (int j = 0; j < 8; ++j) acc[j] = 0.f;
        for (int k8 = 0; k8 < 128; ++k8) {
            const v4u av = *(const v4u*)(a + 8 * k8);
            float af[8] = {bf2f(av.x & 0xffffu), bf2f(av.x >> 16), bf2f(av.y & 0xffffu), bf2f(av.y >> 16), bf2f(av.z & 0xffffu), bf2f(av.z >> 16), bf2f(av.w & 0xffffu), bf2f(av.w >> 16)};
#pragma unroll
            for (int kk = 0; kk < 8; ++kk) {
                const f32x4 w0 = *(const f32x4*)(w + (size_t)(8 * k8 + kk) * 1024), w1 = *(const f32x4*)(w + (size_t)(8 * k8 + kk) * 1024 + 4);
                acc[0] += af[kk] * w0.x; acc[1] += af[kk] * w0.y; acc[2] += af[kk] * w0.z; acc[3] += af[kk] * w0.w;
                acc[4] += af[kk] * w1.x; acc[5] += af[kk] * w1.y; acc[6] += af[kk] * w1.z; acc[7] += af[kk] * w1.w;
            }
        }
        const f32x4 x0 = *(const f32x4*)(xold + (size_t)row * D_ + d0), x1 = *(const f32x4*)(xold + (size_t)row * D_ + d0 + 4);
        *(f32x4*)(xnew + (size_t)row * D_ + d0) = (f32x4){x0.x + acc[0], x0.y + acc[1], x0.z + acc[2], x0.w + acc[3]};
        *(f32x4*)(xnew + (size_t)row * D_ + d0 + 4) = (f32x4){x1.x + acc[4], x1.y + acc[5], x1.z + acc[6], x1.w + acc[7]};
    }
}

__device__ __forceinline__ void ph_norm2_route(const float* x, const float* gain, bf16* out, const float* wg, const float* bg, const float* we, const float* be, int* tok_e, float* tok_w, int wave, int lane) {
    const int gw = blockIdx.x * NWAVES + wave, NGW = gridDim.x * NWAVES;
    for (int m = gw; m < T_; m += NGW) {
        const f32x4* xr = (const f32x4*)(x + (size_t)m * D_) + lane;
        f32x4 v[4]; float s = 0.f;
#pragma unroll
        for (int j = 0; j < 4; ++j) { v[j] = xr[64 * j]; s += (v[j].x * v[j].x + v[j].y * v[j].y) + (v[j].z * v[j].z + v[j].w * v[j].w); }
        const float r = rsqrtf(wave_sum(s) * (1.f / D_) + EPS);
        v2u* o8 = (v2u*)(out + (size_t)m * D_) + lane;
        float gl[4] = {0.f, 0.f, 0.f, 0.f}; float hn[16];
#pragma unroll
        for (int j = 0; j < 4; ++j) { const f32x4 g = ((const f32x4*)gain)[lane + 64 * j];
            const float h0 = v[j].x * r * g.x, h1 = v[j].y * r * g.y, h2 = v[j].z * r * g.z, h3 = v[j].w * r * g.w;
            v2u w; w.x = pk2(h0, h1); w.y = pk2(h2, h3); o8[64 * j] = w;
            hn[4 * j] = h0; hn[4 * j + 1] = h1; hn[4 * j + 2] = h2; hn[4 * j + 3] = h3;
#pragma unroll
            for (int i = 0; i < 4; ++i) { const int k = 4 * (lane + 64 * j) + i; const f32x4 a = *(const f32x4*)(wg + (size_t)k * 4);
                gl[0] += hn[4 * j + i] * a.x; gl[1] += hn[4 * j + i] * a.y; gl[2] += hn[4 * j + i] * a.z; gl[3] += hn[4 * j + i] * a.w; } }
#pragma unroll
        for (int i = 0; i < 4; ++i) gl[i] = wave_sum(gl[i]) + bg[i];
        int gs = 0; float gm = gl[0];
#pragma unroll
        for (int i = 1; i < 4; ++i) if (gl[i] > gm) { gm = gl[i]; gs = i; }
        float gsum = 0.f;
#pragma unroll
        for (int i = 0; i < 4; ++i) gsum += __expf(gl[i] - gm);
        const float g_w = 1.f / gsum;
        gs = __builtin_amdgcn_readfirstlane(gs);
        float el[4] = {0.f, 0.f, 0.f, 0.f};
#pragma unroll
        for (int j = 0; j < 4; ++j)
#pragma unroll
            for (int i = 0; i < 4; ++i) { const int k = 4 * (lane + 64 * j) + i; const f32x4 c = *(const f32x4*)(we + (size_t)k * 16 + 4 * gs);
                el[0] += hn[4 * j + i] * c.x; el[1] += hn[4 * j + i] * c.y; el[2] += hn[4 * j + i] * c.z; el[3] += hn[4 * j + i] * c.w; }
#pragma unroll
        for (int i = 0; i < 4; ++i) el[i] = wave_sum(el[i]) + be[4 * gs + i];
        int i0 = 0; float m0 = el[0];
#pragma unroll
        for (int i = 1; i < 4; ++i) if (el[i] > m0) { m0 = el[i]; i0 = i; }
        int i1 = -1; float m1 = -3.0e38f;
#pragma unroll
        for (int i = 0; i < 4; ++i) if (i != i0 && el[i] > m1) { m1 = el[i]; i1 = i; }
        const float p1 = __expf(m1 - m0);
        const float w0 = g_w / (1.f + p1), w1 = g_w * p1 / (1.f + p1);
        if (lane == 0) { tok_e[2 * m] = gs * 4 + i0; tok_e[2 * m + 1] = gs * 4 + i1; tok_w[2 * m] = w0; tok_w[2 * m + 1] = w1; }
    }
}

__device__ __forceinline__ void ph_moe_simple(const bf16* HB, const int* tok_e, const float* tok_w, const float* wgate, const float* wup, const float* wdown, float* x, LAS float* L, int tid) {
    LAS float* hrow = L; LAS float* hid = L + 1024;
    for (int m = blockIdx.x; m < T_; m += gridDim.x) {
        __syncthreads();
        hrow[tid] = bf2f(HB[(size_t)m * D_ + tid]); hrow[tid + 512] = bf2f(HB[(size_t)m * D_ + tid + 512]);
        float y0 = 0.f, y1 = 0.f;
#pragma unroll 1
        for (int sl = 0; sl < 2; ++sl) {
            const int e = tok_e[2 * m + sl]; const float wt = tok_w[2 * m + sl];
            __syncthreads();
            const float* G = wgate + (size_t)e * 1024 * 512 + tid; const float* U = wup + (size_t)e * 1024 * 512 + tid;
            float g = 0.f, u = 0.f;
#pragma unroll 8
            for (int k = 0; k < 1024; ++k) { const float hk = hrow[k]; g += hk * G[(size_t)k * 512]; u += hk * U[(size_t)k * 512]; }
            hid[tid] = silu_f(g) * u;
            __syncthreads();
            const float* Dn = wdown + (size_t)e * 512 * 1024 + tid;
            float a0 = 0.f, a1 = 0.f;
#pragma unroll 8
            for (int j = 0; j < 512; ++j) { const float hj = hid[j]; a0 += hj * Dn[(size_t)j * 1024]; a1 += hj * Dn[(size_t)j * 1024 + 512]; }
            y0 += wt * a0; y1 += wt * a1;
        }
        x[(size_t)m * D_ + tid] += y0; x[(size_t)m * D_ + tid + 512] += y1;
    }
}

constexpr int NPH = 9;
struct Args { const float* in[26]; float* out; unsigned char* ws; int ph_lo, ph_hi; };
__global__ void __launch_bounds__(NTHR, 2) mega(Args a) {
    extern __shared__ __attribute__((aligned(16))) unsigned char lds[];
    const int tid = threadIdx.x, lane = tid & 63, wave = __builtin_amdgcn_readfirstlane(tid >> 6);
    LAS unsigned char* L8 = (LAS unsigned char*)lds;
    LAS float* L = (LAS float*)lds;
    volatile LAS unsigned* MISC = (volatile LAS unsigned*)(L8 + MISC_OFF);
    for (int u = tid; u < (LDS_BYTES - LDSCTL_OFF) / 4; u += NTHR) ((LAS unsigned*)(L8 + LDSCTL_OFF))[u] = 0u;
    __syncthreads();
    unsigned char* ws = a.ws;
    unsigned* ctl = (unsigned*)(ws + WS_CTL);
    XcdBarrier bar; bar.bar = ctl + CW_BAR; bar.x = 0; bar.st = nullptr;
    if (!MK_SPLIT) bar = xcd_barrier_post(ctl + CW_BAR, MISC + 8);
    bf16* HB = (bf16*)(ws + WS_HB); bf16* FOX = (bf16*)(ws + WS_FOX); bf16* GLA = (bf16*)(ws + WS_GLA); bf16* SSM = (bf16*)(ws + WS_SSM);
    float* SML = (float*)(ws + WS_SML); float* CUM = (float*)(ws + WS_CUM); int* TOKE = (int*)(ws + WS_TOKE); float* TOKW = (float*)(ws + WS_TOKW); bf16* GATES = (bf16*)(ws + WS_GATES);
    const int lo = a.ph_lo, hi = a.ph_hi;
#define IN(k) (lo <= (k) && (k) < hi)
#define SEAM(k) do { if (IN(k) && IN((k) + 1)) xcd_barrier(bar); } while (0)
    for (int l = 0; l < NLAYER; ++l) {
        const int pb = l * NPH;
        const float* xin = (l == 0) ? a.in[0] : a.out;
        if (IN(pb + 0)) ph_norm(xin, a.in[1] + l * D_, HB, wave, lane);
        SEAM(pb + 0);
        if (IN(pb + 1)) ph_inproj_simple(HB, a.in[2] + (size_t)l * D_ * INC, a.in[3] + l * 8, a.in[4] + l * 64, a.in[5] + l * 64, a.in[11] + l * 8, a.in[16] + l * 3072, FOX, GLA, SSM, SML, GATES, tid);
        SEAM(pb + 1);
        if (IN(pb + 2)) ph_cumsum(SML, CUM, L, tid);
        SEAM(pb + 2);
        if (IN(pb + 3)) ph_mix_simple(FOX, CUM, GLA, SSM, SML, a.in[6] + l * 16 * 256, a.in[7] + l * 256, a.in[9] + l * 4 * 768, a.in[10] + l * 768, a.in[12] + l * 8, a.in[13] + l * 8, L, tid, wave, lane);
        SEAM(pb + 3);
        if (IN(pb + 4)) ph_post(GLA, SSM, a.in[8] + l * 128, a.in[14] + l * 512, wave, lane);
        SEAM(pb + 4);
        if (IN(pb + 5)) ph_merge_simple(FOX, GLA, SSM, GATES, a.in[15] + (size_t)l * 3 * 512 * 1024, tid);
        SEAM(pb + 5);
        if (IN(pb + 6)) ph_out_simple(FOX, a.in[17] + (size_t)l * D_ * D_, xin, a.out, tid);
        SEAM(pb + 6);
        if (IN(pb + 7)) ph_norm2_route(a.out, a.in[18] + l * D_, HB, a.in[19] + l * D_ * 4, a.in[20] + l * 4, a.in[21] + l * D_ * 16, a.in[22] + l * 16, TOKE, TOKW, wave, lane);
        SEAM(pb + 7);
        if (IN(pb + 8)) ph_moe_simple(HB, TOKE, TOKW, a.in[23] + (size_t)l * 16 * 1024 * 512, a.in[24] + (size_t)l * 16 * 1024 * 512, a.in[25] + (size_t)l * 16 * 512 * 1024, a.out, L, tid);
        SEAM(pb + 8);
    }
#undef IN
#undef SEAM
}

extern "C" void kernel_launch(void* const* d_in, const int* in_sizes, int n_in, void* d_out, int out_size, void* d_ws, size_t ws_size, hipStream_t stream) {
    static int grid = 0;
    if (grid == 0) {
        if (n_in != 26 || out_size != T_ * D_ || ws_size < WS_END) { fprintf(stderr, "kernel_launch: unexpected sizes\n"); grid = -1; return; }
        int dev = 0, cus = 0;
        if (hipGetDevice(&dev) != hipSuccess || hipDeviceGetAttribute(&cus, hipDeviceAttributeMultiprocessorCount, dev) != hipSuccess) { grid = -1; return; }
        if (hipFuncSetAttribute((const void*)mega, hipFuncAttributeMaxDynamicSharedMemorySize, LDS_BYTES) != hipSuccess) { grid = -1; return; }
        int per_cu = 0;
        (void)hipOccupancyMaxActiveBlocksPerMultiprocessor(&per_cu, (const void*)mega, NTHR, LDS_BYTES);
        (void)hipGetLastError();
        grid = cus;
    }
    if (grid < 0) return;
    if (hipMemsetAsync((char*)d_ws + WS_CTL, 0, CTL_ZERO_BYTES, stream) != hipSuccess) return;
    Args a{};
    for (int i = 0; i < 26; ++i) a.in[i] = (const float*)d_in[i];
    a.out = (float*)d_out; a.ws = (unsigned char*)d_ws;
#if MK_SPLIT
    for (int p = 0; p < NLAYER * NPH; ++p) { a.ph_lo = p; a.ph_hi = p + 1; hipLaunchKernelGGL(mega, dim3(grid), dim3(NTHR), LDS_BYTES, stream, a); }
#else
    a.ph_lo = 0; a.ph_hi = NLAYER * NPH;
    hipLaunchKernelGGL(mega, dim3(grid), dim3(NTHR), LDS_BYTES, stream, a);
#endif
}
```

```cpp
#include <hip/hip_runtime.h>
#include <hip/hip_bf16.h>
#include <cstdio>
#include <cstdint>

#ifndef FAST_INPROJ
#define FAST_INPROJ 1
#endif
#ifndef DUAL_INPROJ
#define DUAL_INPROJ 0
#endif
#ifndef EPI_SKIP
#define EPI_SKIP(pn) (false)
#endif
#ifndef FAST_MERGE
#define FAST_MERGE 1
#endif
#ifndef FAST_OUT
#define FAST_OUT 1
#endif
#ifndef FAST_MOE
#define FAST_MOE 1
#endif
#ifndef FAST_ATTN
#define FAST_ATTN 1
#endif
#ifndef FAST_MIX
#define FAST_MIX 1
#endif
#ifndef MK_SPLIT
#define MK_SPLIT 0
#endif

#define GAS __attribute__((address_space(1)))
#define LAS __attribute__((address_space(3)))
typedef unsigned short bf16;
typedef unsigned v4u __attribute__((ext_vector_type(4)));
typedef unsigned v2u __attribute__((ext_vector_type(2)));
typedef float f32x4 __attribute__((ext_vector_type(4)));

constexpr int T_ = 16384, S_ = 8192, D_ = 1024, NLAYER = 2, INC = 7456, NWAVES = 8, NTHR = 512;
constexpr float LOG2E = 1.4426950408889634f, EPS = 1e-6f;
constexpr int FOXP = 1536, GLAP = 1536, SSMP = 1536, SMLP = 32, GATP = 3072;
constexpr size_t MiB = 1u << 20;
constexpr size_t WS_CTL = 0, CTL_ZERO_BYTES = 1 * MiB;
constexpr size_t WS_WIN = 1 * MiB, WS_WBR = 16 * MiB, WS_WOUT = 19 * MiB;
constexpr size_t WS_HB = 21 * MiB, WS_SST = 53 * MiB, WS_FOX = 85 * MiB, WS_GLA = 133 * MiB, WS_SSM = 181 * MiB;
constexpr size_t WS_SML = 229 * MiB, WS_CUM = 231 * MiB, WS_TOKE = WS_CUM + 512 * 1024, WS_TOKW = WS_CUM + 640 * 1024, WS_LRANK = WS_CUM + 768 * 1024, WS_ROWTOK = WS_CUM + 896 * 1024,
                 WS_ROWW = WS_CUM + 1056 * 1024, WS_CNTBLK = WS_CUM + 1216 * 1024, WS_GATES = 233 * MiB, WS_END = 329 * MiB;
constexpr size_t WS_W1E = WS_GATES, WS_WDE = WS_GATES + 32 * MiB, WS_HID = WS_GATES + 48 * MiB, WS_HS = WS_FOX;
constexpr size_t WS_GST = WS_HB, WS_GDEC = WS_CUM + 1280 * 1024, WS_SDEC = WS_CUM + 1536 * 1024;
constexpr int MOE_ROWS = 36864;
static_assert(WS_HID + (size_t)MOE_ROWS * 512 * 2 <= WS_END && WS_HS + (size_t)MOE_ROWS * 1024 * 2 <= WS_SSM + 48 * MiB, "MoE overlays");
constexpr int CW_BAR = 4096;
constexpr int RING_BYTES = 131072, LDSCTL_OFF = RING_BYTES, MISC_OFF = LDSCTL_OFF + 320, LDS_TB = LDSCTL_OFF + 512  , LDS_TOT = LDSCTL_OFF + 640  , LDS_BYTES = 147456;

__device__ __forceinline__ GAS unsigned char* opq(unsigned char* p) { GAS unsigned char* g = (GAS unsigned char*)p; asm volatile("" : "+s"(g)); return g; }
__device__ __forceinline__ float bf2f(unsigned u) { return __builtin_bit_cast(float, u << 16); }
__device__ __forceinline__ unsigned f2bf(float f) { unsigned u = __builtin_bit_cast(unsigned, f); return (u + 0x7fffu + ((u >> 16) & 1u)) >> 16; }
__device__ __forceinline__ unsigned pk2(float lo, float hi) { return f2bf(lo) | (f2bf(hi) << 16); }
__device__ __forceinline__ float silu_f(float x) { return x / (1.f + __expf(-x)); }
__device__ __forceinline__ float sigmoid_f(float x) { return 1.f / (1.f + __expf(-x)); }
__device__ __forceinline__ float softplus_f(float x) { return fmaxf(x, 0.f) + log1pf(__expf(-fabsf(x))); }
__device__ __forceinline__ float logsig_f(float x) { return fminf(x, 0.f) - log1pf(__expf(-fabsf(x))); }
__device__ __forceinline__ float wave_sum(float v) {
#pragma unroll
    for (int o = 1; o < 64; o <<= 1) v += __shfl_xor(v, o);
    return v;
}

#define XB_TMO      128
#define XB_XCNT(j)  (256  + 64 * (j))
#define XB_XSUB(j)  (1280 + 64 * (j))
#define XB_XGEN(j)  (2304 + 64 * (j))
#define XB_TOP      3328
#define XB_TOPGEN   3392
#define XCD_BAR_WORDS 3456
#define XB_SPIN_CAP (1u << 23)
__device__ __forceinline__ unsigned xb_ld(unsigned* p)              { return __hip_atomic_load(p, __ATOMIC_RELAXED, __HIP_MEMORY_SCOPE_AGENT); }
__device__ __forceinline__ unsigned xb_add(unsigned* p, unsigned v) { return __hip_atomic_fetch_add(p, v, __ATOMIC_RELAXED, __HIP_MEMORY_SCOPE_AGENT); }
__device__ __forceinline__ unsigned xb_xcc_id() { return (unsigned)__builtin_amdgcn_s_getreg((3 << 11) | 20) & 0xFu; }
#define XB_SPIN(cond, bar) do { unsigned _sp = 0; while (cond) { __builtin_amdgcn_s_sleep(1); \
    if ((++_sp & 255u) == 0u) { if (xb_ld(&(bar)[XB_TMO])) break; if (_sp > XB_SPIN_CAP) { atomicAdd(&(bar)[XB_TMO], 1u); break; } } } } while (0)
struct XcdBarrier { unsigned* bar; unsigned x; volatile LAS unsigned* st; };
__device__ __forceinline__ XcdBarrier xcd_barrier_post(unsigned* bar, volatile LAS unsigned* st) {
    XcdBarrier b; b.bar = bar; b.x = xb_xcc_id(); b.st = st;
    if (threadIdx.x == 0) (void)xb_add(&bar[XB_XCNT(b.x)], 1u);
    return b;
}
__device__ __forceinline__ void xcd_barrier_complete(unsigned* bar, unsigned x, unsigned& nloc, unsigned& nx) {
    const unsigned G = gridDim.x * gridDim.y * gridDim.z;
    unsigned sum, cnt, mine, sp = 0u;
    for (;;) {
        sum = 0u; cnt = 0u; mine = 0u;
#pragma unroll
        for (unsigned j = 0; j < 16; ++j) { const unsigned c = xb_ld(&bar[XB_XCNT(j)]); sum += c; cnt += (c > 0u) ? 1u : 0u; mine = (j == x) ? c : mine; }
        if (sum == G) break;
        __builtin_amdgcn_s_sleep(1);
        if ((++sp & 255u) == 0u) { if (xb_ld(&bar[XB_TMO])) break; if (sp > XB_SPIN_CAP) { atomicAdd(&bar[XB_TMO], 1u); break; } }
    }
    nloc = mine > 0u ? mine : 1u; nx = cnt > 0u ? cnt : 1u;
}
__device__ __forceinline__ void xcd_barrier(const XcdBarrier& b) {
    asm volatile("s_waitcnt vmcnt(0)" ::: "memory");
    __syncthreads();
    if (threadIdx.x == 0) {
        unsigned* bar = b.bar;
        __builtin_amdgcn_s_waitcnt(0);
        unsigned nloc = b.st[0], nx = b.st[1];
        if (nloc == 0u) { xcd_barrier_complete(bar, b.x, nloc, nx); b.st[0] = nloc; b.st[1] = nx; }
        const unsigned old = xb_add(&bar[XB_XSUB(b.x)], 1u);
        const unsigned gen = old / nloc;
        if (old + 1u == (gen + 1u) * nloc) {
            __builtin_amdgcn_fence(__ATOMIC_RELEASE, "agent");
            asm volatile("s_waitcnt vmcnt(0)" ::: "memory");
            const unsigned og = xb_add(&bar[XB_TOP], 1u);
            const unsigned tg = og / nx;
            if (og + 1u == (tg + 1u) * nx) xb_add(&bar[XB_TOPGEN], 1u);
            else XB_SPIN(xb_ld(&bar[XB_TOPGEN]) == tg, bar);
            __builtin_amdgcn_fence(__ATOMIC_ACQUIRE, "agent");
            xb_add(&bar[XB_XGEN(b.x)], 1u);
            asm volatile("s_waitcnt vmcnt(0)" ::: "memory");
        } else {
            XB_SPIN(xb_ld(&bar[XB_XGEN(b.x)]) == gen, bar);
            __builtin_amdgcn_fence(__ATOMIC_ACQUIRE, "agent");
            asm volatile("s_waitcnt vmcnt(0)" ::: "memory");
        }
    }
    __syncthreads();
}

__device__ __forceinline__ void ph_norm(const float* x, const float* gain, bf16* out, int wave, int lane) {
    asm volatile("" : "+s"(wave), "+v"(lane));
    const int gw = blockIdx.x * NWAVES + wave, NGW = gridDim.x * NWAVES;
    for (int m = gw; m < T_; m += NGW) {
        const f32x4* xr = (const f32x4*)(x + (size_t)m * D_) + lane;
        f32x4 v[4]; float s = 0.f;
#pragma unroll
        for (int j = 0; j < 4; ++j) { v[j] = xr[64 * j]; s += (v[j].x * v[j].x + v[j].y * v[j].y) + (v[j].z * v[j].z + v[j].w * v[j].w); }
        const float r = rsqrtf(wave_sum(s) * (1.f / D_) + EPS);
        v2u* o8 = (v2u*)(out + (size_t)m * D_) + lane;
#pragma unroll
        for (int j = 0; j < 4; ++j) { const f32x4 g = ((const f32x4*)gain)[lane + 64 * j]; v2u w; w.x = pk2(v[j].x * r * g.x, v[j].y * r * g.y); w.y = pk2(v[j].z * r * g.z, v[j].w * r * g.w); o8[64 * j] = w; }
    }
}

__device__ __forceinline__ void ph_inproj_simple(const bf16* HB, const float* w_in, const float* f_bias, const float* qn, const float* kn, const float* dt_bias, const float* bgate,
                                                 bf16* FOX, bf16* GLA, bf16* SSM, float* SML, bf16* GATES, int tid) {
    asm volatile("" : "+v"(tid));
    const int r = tid >> 3, cg = tid & 7;
    constexpr int NTC = (INC + 63) / 64;
    for (int item = blockIdx.x; item < (T_ / 64) * NTC; item += gridDim.x) {
        const int tm = item / NTC, tn = item % NTC;
        const int row = tm * 64 + r, c0 = tn * 64 + cg * 8;
        float acc[8];
#pragma unroll
        for (int j = 0; j < 8; ++j) acc[j] = 0.f;
        if (c0 < INC) {
            const bf16* a = HB + (size_t)row * D_;
            const float* w = w_in + c0;
            for (int k8 = 0; k8 < D_ / 8; ++k8) {
                const v4u av = *(const v4u*)(a + 8 * k8);
                float af[8] = {bf2f(av.x & 0xffffu), bf2f(av.x >> 16), bf2f(av.y & 0xffffu), bf2f(av.y >> 16), bf2f(av.z & 0xffffu), bf2f(av.z >> 16), bf2f(av.w & 0xffffu), bf2f(av.w >> 16)};
#pragma unroll
                for (int kk = 0; kk < 8; ++kk) {
                    const f32x4 w0 = *(const f32x4*)(w + (size_t)(8 * k8 + kk) * INC), w1 = *(const f32x4*)(w + (size_t)(8 * k8 + kk) * INC + 4);
                    acc[0] += af[kk] * w0.x; acc[1] += af[kk] * w0.y; acc[2] += af[kk] * w0.z; acc[3] += af[kk] * w0.w;
                    acc[4] += af[kk] * w1.x; acc[5] += af[kk] * w1.y; acc[6] += af[kk] * w1.z; acc[7] += af[kk] * w1.w;
                }
            }
        }
        if (c0 < 1024) {
            float ss = 0.f;
#pragma unroll
            for (int j = 0; j < 8; ++j) ss += acc[j] * acc[j];
            ss += __shfl_xor(ss, 1); ss += __shfl_xor(ss, 2); ss += __shfl_xor(ss, 4);
            const float rs = rsqrtf(ss * (1.f / 64.f) + EPS);
            const bool isq = c0 < 512; const float* gain = isq ? qn : kn; const float sc = isq ? 0.125f * LOG2E : 1.f;
            float v[8];
#pragma unroll
            for (int j = 0; j < 8; ++j) v[j] = acc[j] * rs * gain[(c0 + j) & 63] * sc;
            v4u o; o.x = pk2(v[0], v[1]); o.y = pk2(v[2], v[3]); o.z = pk2(v[4], v[5]); o.w = pk2(v[6], v[7]);
            *(v4u*)(FOX + (size_t)row * FOXP + c0) = o;
        } else if (c0 < INC) {
#pragma unroll
            for (int j = 0; j < 8; ++j) {
                const int col = c0 + j; const float v = acc[j];
                if (col < 1536) FOX[(size_t)row * FOXP + col] = (bf16)f2bf(v);
                else if (col < 1544) SML[(size_t)row * SMLP + (col - 1536)] = logsig_f(v + f_bias[col - 1536]) * LOG2E;
                else if (col < 3080) GLA[(size_t)row * GLAP + (col - 1544)] = (bf16)f2bf(v);
                else if (col < 3096) SML[(size_t)row * SMLP + 8 + (col - 3080)] = v;
                else if (col < 4376) SSM[(size_t)row * SSMP + (col - 3096)] = (bf16)f2bf(v);
                else if (col < 4384) SML[(size_t)row * SMLP + 24 + (col - 4376)] = softplus_f(v + dt_bias[col - 4376]);
                else GATES[(size_t)row * GATP + (col - 4384)] = (bf16)f2bf(sigmoid_f(v + bgate[col - 4384]));
            }
        }
    }
}

__device__ __forceinline__ void ph_cumsum(const float* SML, float* CUM, LAS float* sh, int tid) {
    asm volatile("" : "+v"(tid));
    for (int seq = blockIdx.x; seq < 16; seq += gridDim.x) {
        const int b = seq >> 3, h = seq & 7;
        float loc[16]; float run = 0.f;
#pragma unroll
        for (int i = 0; i < 16; ++i) { run += SML[(size_t)(b * S_ + tid * 16 + i) * SMLP + h]; loc[i] = run; }
        __syncthreads();
        sh[tid] = run;
        __syncthreads();
        if (tid == 0) { float a = 0.f; for (int i = 0; i < NTHR; ++i) { const float t = sh[i]; sh[i] = a; a += t; } }
        __syncthreads();
        const float ex = sh[tid];
#pragma unroll
        for (int i = 0; i < 16; ++i) CUM[(size_t)seq * S_ + tid * 16 + i] = ex + loc[i];
    }
}

__device__ __forceinline__ void attn_simple_wave(bf16* FOX, const float* CUM, int b, int h, int g, int lane) {
    const int t = g * 32 + (lane >> 1), hf = lane & 1;
    const size_t rowq = (size_t)(b * S_ + t) * FOXP + h * 64 + hf * 32;
    float q[32], o[32];
#pragma unroll
    for (int i = 0; i < 4; ++i) { const v4u w = *(const v4u*)(FOX + rowq + 8 * i);
        q[8 * i + 0] = bf2f(w.x & 0xffffu); q[8 * i + 1] = bf2f(w.x >> 16); q[8 * i + 2] = bf2f(w.y & 0xffffu); q[8 * i + 3] = bf2f(w.y >> 16);
        q[8 * i + 4] = bf2f(w.z & 0xffffu); q[8 * i + 5] = bf2f(w.z >> 16); q[8 * i + 6] = bf2f(w.w & 0xffffu); q[8 * i + 7] = bf2f(w.w >> 16); }
#pragma unroll
    for (int d = 0; d < 32; ++d) o[d] = 0.f;
    const float* cs = CUM + (size_t)(b * 8 + h) * S_;
    const float cq = cs[t];
    float m = -1e30f, l = 0.f;
    const int smax = g * 32 + 31;
#pragma unroll 1
    for (int s = 0; s <= smax; ++s) {
        const bf16* kp = FOX + (size_t)(b * S_ + s) * FOXP + 512 + h * 64 + hf * 32;
        float dot = 0.f;
#pragma unroll
        for (int i = 0; i < 4; ++i) { const v4u w = *(const v4u*)(kp + 8 * i);
            dot += q[8 * i + 0] * bf2f(w.x & 0xffffu) + q[8 * i + 1] * bf2f(w.x >> 16) + q[8 * i + 2] * bf2f(w.y & 0xffffu) + q[8 * i + 3] * bf2f(w.y >> 16)
                 + q[8 * i + 4] * bf2f(w.z & 0xffffu) + q[8 * i + 5] * bf2f(w.z >> 16) + q[8 * i + 6] * bf2f(w.w & 0xffffu) + q[8 * i + 7] * bf2f(w.w >> 16); }
        dot += __shfl_xor(dot, 1);
        float logit = dot + (cq - cs[s]);
        if (s > t) logit = -1e30f;
        const float mn = fmaxf(m, logit);
        const float sc = exp2f(m - mn), p = (s > t) ? 0.f : exp2f(logit - mn);
        l = l * sc + p; m = mn;
        const bf16* vp = kp + 512;
#pragma unroll
        for (int i = 0; i < 4; ++i) { const v4u w = *(const v4u*)(vp + 8 * i);
            o[8 * i + 0] = o[8 * i + 0] * sc + p * bf2f(w.x & 0xffffu); o[8 * i + 1] = o[8 * i + 1] * sc + p * bf2f(w.x >> 16);
            o[8 * i + 2] = o[8 * i + 2] * sc + p * bf2f(w.y & 0xffffu); o[8 * i + 3] = o[8 * i + 3] * sc + p * bf2f(w.y >> 16);
            o[8 * i + 4] = o[8 * i + 4] * sc + p * bf2f(w.z & 0xffffu); o[8 * i + 5] = o[8 * i + 5] * sc + p * bf2f(w.z >> 16);
            o[8 * i + 6] = o[8 * i + 6] * sc + p * bf2f(w.w & 0xffffu); o[8 * i + 7] = o[8 * i + 7] * sc + p * bf2f(w.w >> 16); }
    }
    const float rl = 1.f / l;
#pragma unroll
    for (int i = 0; i < 4; ++i) { v4u w; w.x = pk2(o[8 * i] * rl, o[8 * i + 1] * rl); w.y = pk2(o[8 * i + 2] * rl, o[8 * i + 3] * rl); w.z = pk2(o[8 * i + 4] * rl, o[8 * i + 5] * rl); w.w = pk2(o[8 * i + 6] * rl, o[8 * i + 7] * rl);
        *(v4u*)(FOX + rowq + 8 * i) = w; }
}

__device__ __forceinline__ void gla_simple_item(bf16* GLA, const float* SML, const float* w_lr, const float* b_gate, LAS float* L, int b, int h, int tid) {
    LAS float* qs = L; LAS float* ks = L + 4096; LAS float* ad = L + 8192; LAS float* vs = L + 12288; LAS float* ob = L + 20480; LAS float* red = L + 28672;
    const int v = tid & 127, dg = tid >> 7;
    float S[16];
#pragma unroll
    for (int i = 0; i < 16; ++i) S[i] = 0.f;
    for (int c = 0; c < S_ / 64; ++c) {
        const size_t row0 = (size_t)b * S_ + (size_t)c * 64;
        __syncthreads();
        for (int idx = tid; idx < 4096; idx += NTHR) { const int t = idx >> 6, d = idx & 63; const size_t row = row0 + t;
            qs[idx] = bf2f(GLA[row * GLAP + h * 64 + d]) * 0.125f; ks[idx] = bf2f(GLA[row * GLAP + 256 + h * 64 + d]);
            float z = b_gate[h * 64 + d];
#pragma unroll
            for (int j = 0; j < 16; ++j) z += SML[row * SMLP + 8 + j] * w_lr[j * 256 + h * 64 + d];
            ad[idx] = __expf(logsig_f(z) * (1.f / 16.f)); }
        for (int idx = tid; idx < 8192; idx += NTHR) { const int t = idx >> 7, vv = idx & 127; vs[idx] = bf2f(GLA[(row0 + t) * GLAP + 512 + h * 128 + vv]); }
        __syncthreads();
        for (int t = 0; t < 64; ++t) {
            const float vt = vs[t * 128 + v]; float part = 0.f;
#pragma unroll
            for (int i = 0; i < 16; ++i) { const int d = dg * 16 + i; S[i] = ad[t * 64 + d] * S[i] + ks[t * 64 + d] * vt; part += qs[t * 64 + d] * S[i]; }
            red[(t & 1) * 512 + dg * 128 + v] = part;
            __syncthreads();
            if (dg == 0) { const LAS float* rr = red + (t & 1) * 512; ob[t * 128 + v] = (rr[v] + rr[128 + v]) + (rr[256 + v] + rr[384 + v]); }
        }
        __syncthreads();
        for (int idx = tid; idx < 8192; idx += NTHR) { const int t = idx >> 7, vv = idx & 127; GLA[(row0 + t) * GLAP + 512 + h * 128 + vv] = (bf16)f2bf(ob[idx]); }
    }
}

__device__ __forceinline__ void ssd_simple_item(bf16* SSM, const float* SML, const float* conv_w, const float* conv_b, const float* a_log, const float* d_skip, LAS float* L, int b, int h, int tid) {
    LAS float* xs = L; LAS float* Bs = L + 4096; LAS float* Cs = L + 8192; LAS float* dts = L + 12288; LAS float* yb = L + 12352; LAS float* red = L + 16448;
    const int p = tid & 63, ng = tid >> 6, g = h >> 2;
    const float a = -__expf(a_log[h]), Dk = d_skip[h];
    float hs[8];
#pragma unroll
    for (int i = 0; i < 8; ++i) hs[i] = 0.f;
    for (int c = 0; c < S_ / 64; ++c) {
        const int s0 = c * 64;
        __syncthreads();
        for (int idx = tid; idx < 3 * 4096; idx += NTHR) { const int which = idx >> 12, t = (idx >> 6) & 63, n = idx & 63;
            const int ch = (which == 0) ? (h * 64 + n) : (which == 1 ? 512 + g * 64 + n : 640 + g * 64 + n);
            float acc = conv_b[ch];
#pragma unroll
            for (int j = 0; j < 4; ++j) { const int s = s0 + t - 3 + j; if (s >= 0) acc += conv_w[j * 768 + ch] * bf2f(SSM[((size_t)b * S_ + s) * SSMP + 512 + ch]); }
            L[idx] = silu_f(acc); }
        if (tid < 64) dts[tid] = SML[((size_t)b * S_ + s0 + tid) * SMLP + 24 + h];
        __syncthreads();
        for (int t = 0; t < 64; ++t) {
            const float dt = dts[t], dA = __expf(dt * a), xt = xs[t * 64 + p]; float part = 0.f;
#pragma unroll
            for (int i = 0; i < 8; ++i) { const int n = ng * 8 + i; hs[i] = dA * hs[i] + dt * Bs[t * 64 + n] * xt; part += Cs[t * 64 + n] * hs[i]; }
            red[(t & 1) * 512 + ng * 64 + p] = part;
            __syncthreads();
            if (ng == 0) { const LAS float* rr = red + (t & 1) * 512; float y = 0.f;
#pragma unroll
                for (int i = 0; i < 8; ++i) y += rr[i * 64 + p];
                yb[t * 64 + p] = y + Dk * xt; }
        }
        __syncthreads();
        for (int idx = tid; idx < 4096; idx += NTHR) { const int t = idx >> 6, pp = idx & 63; const size_t e = ((size_t)b * S_ + s0 + t) * SSMP + h * 64 + pp;
            const float z = bf2f(SSM[e]); SSM[e] = (bf16)f2bf(yb[idx] * silu_f(z)); }
    }
}

__device__ __forceinline__ void ph_mix_simple(bf16* FOX, const float* CUM, bf16* GLA, bf16* SSM, const float* SML, const float* w_lr, const float* b_gate,
                                              const float* conv_w, const float* conv_b, const float* a_log, const float* d_skip, LAS float* L, int tid, int wave, int lane) {
    asm volatile("" : "+v"(tid), "+s"(wave), "+v"(lane));
    for (int it = blockIdx.x; it < (FAST_ATTN ? 24 : 24 + 512); it += gridDim.x) {
        if (it < 8) gla_simple_item(GLA, SML, w_lr, b_gate, L, it >> 2, it & 3, tid);
        else if (it < 24) ssd_simple_item(SSM, SML, conv_w, conv_b, a_log, d_skip, L, (it - 8) >> 3, (it - 8) & 7, tid);
        else { const int wi = (it - 24) * 8 + wave; const int bh = wi >> 8, g = wi & 255; attn_simple_wave(FOX, CUM, bh >> 3, bh & 7, g, lane); }
        __syncthreads();
    }
}

__device__ __forceinline__ void ph_post(bf16* GLA, bf16* SSM, const float* gla_norm, const float* ssm_norm, int wave, int lane) {
    asm volatile("" : "+s"(wave), "+v"(lane));
    const int gw = blockIdx.x * NWAVES + wave, NGW = gridDim.x * NWAVES;
    for (int m = gw; m < T_; m += NGW) {
        {
            const v4u w = *(const v4u*)(GLA + (size_t)m * GLAP + 512 + 8 * lane), gr = *(const v4u*)(GLA + (size_t)m * GLAP + 1024 + 8 * lane);
            float o[8] = {bf2f(w.x & 0xffffu), bf2f(w.x >> 16), bf2f(w.y & 0xffffu), bf2f(w.y >> 16), bf2f(w.z & 0xffffu), bf2f(w.z >> 16), bf2f(w.w & 0xffffu), bf2f(w.w >> 16)};
            float gg[8] = {bf2f(gr.x & 0xffffu), bf2f(gr.x >> 16), bf2f(gr.y & 0xffffu), bf2f(gr.y >> 16), bf2f(gr.z & 0xffffu), bf2f(gr.z >> 16), bf2f(gr.w & 0xffffu), bf2f(gr.w >> 16)};
            float ss = 0.f;
#pragma unroll
            for (int j = 0; j < 8; ++j) ss += o[j] * o[j];
            ss += __shfl_xor(ss, 1); ss += __shfl_xor(ss, 2); ss += __shfl_xor(ss, 4); ss += __shfl_xor(ss, 8);
            const float rs = rsqrtf(ss * (1.f / 128.f) + EPS);
            float r[8];
#pragma unroll
            for (int j = 0; j < 8; ++j) r[j] = o[j] * rs * gla_norm[(8 * lane + j) & 127] * silu_f(gg[j]);
            v4u ov; ov.x = pk2(r[0], r[1]); ov.y = pk2(r[2], r[3]); ov.z = pk2(r[4], r[5]); ov.w = pk2(r[6], r[7]);
            *(v4u*)(GLA + (size_t)m * GLAP + 1024 + 8 * lane) = ov;
        }
        {
            const v4u w = *(const v4u*)(SSM + (size_t)m * SSMP + 8 * lane);
            float o[8] = {bf2f(w.x & 0xffffu), bf2f(w.x >> 16), bf2f(w.y & 0xffffu), bf2f(w.y >> 16), bf2f(w.z & 0xffffu), bf2f(w.z >> 16), bf2f(w.w & 0xffffu), bf2f(w.w >> 16)};
            float ss = 0.f;
#pragma unroll
            for (int j = 0; j < 8; ++j) ss += o[j] * o[j];
            ss += __shfl_xor(ss, 1); ss += __shfl_xor(ss, 2); ss += __shfl_xor(ss, 4); ss += __shfl_xor(ss, 8); ss += __shfl_xor(ss, 16);
            const float rs = rsqrtf(ss * (1.f / 256.f) + EPS);
            float r[8];
#pragma unroll
            for (int j = 0; j < 8; ++j) r[j] = o[j] * rs * ssm_norm[8 * lane + j];
            v4u ov; ov.x = pk2(r[0], r[1]); ov.y = pk2(r[2], r[3]); ov.z = pk2(r[4], r[5]); ov.w = pk2(r[6], r[7]);
            *(v4u*)(SSM + (size_t)m * SSMP + 8 * lane) = ov;
        }
    }
}

__device__ __forceinline__ void ph_merge_simple(bf16* FOX, const bf16* GLA, const bf16* SSM, const bf16* GATES, const float* w_branch, int tid) {
    asm volatile("" : "+v"(tid));
    const int r = tid >> 3, cg = tid & 7;
    for (int item = blockIdx.x; item < (T_ / 64) * 16; item += gridDim.x) {
        const int tm = item >> 4, tn = item & 15; const int row = tm * 64 + r, d0 = tn * 64 + cg * 8;
        float macc[8];
#pragma unroll
        for (int j = 0; j < 8; ++j) macc[j] = 0.f;
#pragma unroll 1
        for (int r3 = 0; r3 < 3; ++r3) {
            const bf16* a = (r3 == 0) ? FOX + (size_t)row * FOXP : (r3 == 1 ? GLA + (size_t)row * GLAP + 1024 : SSM + (size_t)row * SSMP);
            const float* w = w_branch + (size_t)r3 * 512 * 1024 + d0;
            float acc[8];
#pragma unroll
            for (int j = 0; j < 8; ++j) acc[j] = 0.f;
            for (int k8 = 0; k8 < 64; ++k8) {
                const v4u av = *(const v4u*)(a + 8 * k8);
                float af[8] = {bf2f(av.x & 0xffffu), bf2f(av.x >> 16), bf2f(av.y & 0xffffu), bf2f(av.y >> 16), bf2f(av.z & 0xffffu), bf2f(av.z >> 16), bf2f(av.w & 0xffffu), bf2f(av.w >> 16)};
#pragma unroll
                for (int kk = 0; kk < 8; ++kk) {
                    const f32x4 w0 = *(const f32x4*)(w + (size_t)(8 * k8 + kk) * 1024), w1 = *(const f32x4*)(w + (size_t)(8 * k8 + kk) * 1024 + 4);
                    acc[0] += af[kk] * w0.x; acc[1] += af[kk] * w0.y; acc[2] += af[kk] * w0.z; acc[3] += af[kk] * w0.w;
                    acc[4] += af[kk] * w1.x; acc[5] += af[kk] * w1.y; acc[6] += af[kk] * w1.z; acc[7] += af[kk] * w1.w;
                }
            }
            const v4u gv = *(const v4u*)(GATES + (size_t)row * GATP + r3 * 1024 + d0);
            macc[0] += bf2f(gv.x & 0xffffu) * acc[0]; macc[1] += bf2f(gv.x >> 16) * acc[1]; macc[2] += bf2f(gv.y & 0xffffu) * acc[2]; macc[3] += bf2f(gv.y >> 16) * acc[3];
            macc[4] += bf2f(gv.z & 0xffffu) * acc[4]; macc[5] += bf2f(gv.z >> 16) * acc[5]; macc[6] += bf2f(gv.w & 0xffffu) * acc[6]; macc[7] += bf2f(gv.w >> 16) * acc[7];
        }
        v4u o; o.x = pk2(macc[0], macc[1]); o.y = pk2(macc[2], macc[3]); o.z = pk2(macc[4], macc[5]); o.w = pk2(macc[6], macc[7]);
        *(v4u*)(FOX + (size_t)row * FOXP + 512 + d0) = o;
    }
}

__device__ __forceinline__ void ph_out_simple(const bf16* FOX, const float* w_out, const float* xold, float* xnew, int tid) {
    asm volatile("" : "+v"(tid));
    const int r = tid >> 3, cg = tid & 7;
    for (int item = blockIdx.x; item < (T_ / 64) * 16; item += gridDim.x) {
        const int tm = item >> 4, tn = item & 15; const int row = tm * 64 + r, d0 = tn * 64 + cg * 8;
        const bf16* a = FOX + (size_t)row * FOXP + 512; const float* w = w_out + d0;
        float acc[8];
#pragma unroll
        for (int j = 0; j < 8; ++j) acc[j] = 0.f;
        for (int k8 = 0; k8 < 128; ++k8) {
            const v4u av = *(const v4u*)(a + 8 * k8);
            float af[8] = {bf2f(av.x & 0xffffu), bf2f(av.x >> 16), bf2f(av.y & 0xffffu), bf2f(av.y >> 16), bf2f(av.z & 0xffffu), bf2f(av.z >> 16), bf2f(av.w & 0xffffu), bf2f(av.w >> 16)};
#pragma unroll
            for (int kk = 0; kk < 8; ++kk) {
                const f32x4 w0 = *(const f32x4*)(w + (size_t)(8 * k8 + kk) * 1024), w1 = *(const f32x4*)(w + (size_t)(8 * k8 + kk) * 1024 + 4);
                acc[0] += af[kk] * w0.x; acc[1] += af[kk] * w0.y; acc[2] += af[kk] * w0.z; acc[3] += af[kk] * w0.w;
                acc[4] += af[kk] * w1.x; acc[5] += af[kk] * w1.y; acc[6] += af[kk] * w1.z; acc[7] += af[kk] * w1.w;
            }
        }
        const f32x4 x0 = *(const f32x4*)(xold + (size_t)row * D_ + d0), x1 = *(const f32x4*)(xold + (size_t)row * D_ + d0 + 4);
        *(f32x4*)(xnew + (size_t)row * D_ + d0) = (f32x4){x0.x + acc[0], x0.y + acc[1], x0.z + acc[2], x0.w + acc[3]};
        *(f32x4*)(xnew + (size_t)row * D_ + d0 + 4) = (f32x4){x1.x + acc[4], x1.y + acc[5], x1.z + acc[6], x1.w + acc[7]};
    }
}

__device__ __forceinline__ void ph_norm2_route(const float* x, const float* gain, bf16* out, const float* wg, const float* bg, const float* we, const float* be, int* tok_e, float* tok_w, int wave, int lane) {
    asm volatile("" : "+s"(wave), "+v"(lane));
    const int gw = blockIdx.x * NWAVES + wave, NGW = gridDim.x * NWAVES;
    for (int m = gw; m < T_; m += NGW) {
        const f32x4* xr = (const f32x4*)(x + (size_t)m * D_) + lane;
        f32x4 v[4]; float s = 0.f;
#pragma unroll
        for (int j = 0; j < 4; ++j) { v[j] = xr[64 * j]; s += (v[j].x * v[j].x + v[j].y * v[j].y) + (v[j].z * v[j].z + v[j].w * v[j].w); }
        const float r = rsqrtf(wave_sum(s) * (1.f / D_) + EPS);
        v2u* o8 = (v2u*)(out + (size_t)m * D_) + lane;
        float gl[4] = {0.f, 0.f, 0.f, 0.f}; float hn[16];
#pragma unroll
        for (int j = 0; j < 4; ++j) { const f32x4 g = ((const f32x4*)gain)[lane + 64 * j];
            const float h0 = v[j].x * r * g.x, h1 = v[j].y * r * g.y, h2 = v[j].z * r * g.z, h3 = v[j].w * r * g.w;
            v2u w; w.x = pk2(h0, h1); w.y = pk2(h2, h3); o8[64 * j] = w;
            hn[4 * j] = h0; hn[4 * j + 1] = h1; hn[4 * j + 2] = h2; hn[4 * j + 3] = h3;
#pragma unroll
            for (int i = 0; i < 4; ++i) { const int k = 4 * (lane + 64 * j) + i; const f32x4 a = *(const f32x4*)(wg + (size_t)k * 4);
                gl[0] += hn[4 * j + i] * a.x; gl[1] += hn[4 * j + i] * a.y; gl[2] += hn[4 * j + i] * a.z; gl[3] += hn[4 * j + i] * a.w; } }
#pragma unroll
        for (int i = 0; i < 4; ++i) gl[i] = wave_sum(gl[i]) + bg[i];
        int gs = 0; float gm = gl[0];
#pragma unroll
        for (int i = 1; i < 4; ++i) if (gl[i] > gm) { gm = gl[i]; gs = i; }
        float gsum = 0.f;
#pragma unroll
        for (int i = 0; i < 4; ++i) gsum += __expf(gl[i] - gm);
        const float g_w = 1.f / gsum;
        gs = __builtin_amdgcn_readfirstlane(gs);
        float el[4] = {0.f, 0.f, 0.f, 0.f};
#pragma unroll
        for (int j = 0; j < 4; ++j)
#pragma unroll
            for (int i = 0; i < 4; ++i) { const int k = 4 * (lane + 64 * j) + i; const f32x4 c = *(const f32x4*)(we + (size_t)k * 16 + 4 * gs);
                el[0] += hn[4 * j + i] * c.x; el[1] += hn[4 * j + i] * c.y; el[2] += hn[4 * j + i] * c.z; el[3] += hn[4 * j + i] * c.w; }
#pragma unroll
        for (int i = 0; i < 4; ++i) el[i] = wave_sum(el[i]) + be[4 * gs + i];
        int i0 = 0; float m0 = el[0];
#pragma unroll
        for (int i = 1; i < 4; ++i) if (el[i] > m0) { m0 = el[i]; i0 = i; }
        int i1 = -1; float m1 = -3.0e38f;
#pragma unroll
        for (int i = 0; i < 4; ++i) if (i != i0 && el[i] > m1) { m1 = el[i]; i1 = i; }
        const float p1 = __expf(m1 - m0);
        const float w0 = g_w / (1.f + p1), w1 = g_w * p1 / (1.f + p1);
        if (lane == 0) { tok_e[2 * m] = gs * 4 + i0; tok_e[2 * m + 1] = gs * 4 + i1; tok_w[2 * m] = w0; tok_w[2 * m + 1] = w1; }
    }
}

__device__ __forceinline__ void ph_moe_simple(const bf16* HB, const int* tok_e, const float* tok_w, const float* wgate, const float* wup, const float* wdown, float* x, LAS float* L, int tid) {
    asm volatile("" : "+v"(tid));
    LAS float* hrow = L; LAS float* hid = L + 1024;
    for (int m = blockIdx.x; m < T_; m += gridDim.x) {
        __syncthreads();
        hrow[tid] = bf2f(HB[(size_t)m * D_ + tid]); hrow[tid + 512] = bf2f(HB[(size_t)m * D_ + tid + 512]);
        float y0 = 0.f, y1 = 0.f;
#pragma unroll 1
        for (int sl = 0; sl < 2; ++sl) {
            const int e = tok_e[2 * m + sl]; const float wt = tok_w[2 * m + sl];
            __syncthreads();
            const float* G = wgate + (size_t)e * 1024 * 512 + tid; const float* U = wup + (size_t)e * 1024 * 512 + tid;
            float g = 0.f, u = 0.f;
#pragma unroll 8
            for (int k = 0; k < 1024; ++k) { const float hk = hrow[k]; g += hk * G[(size_t)k * 512]; u += hk * U[(size_t)k * 512]; }
            hid[tid] = silu_f(g) * u;
            __syncthreads();
            const float* Dn = wdown + (size_t)e * 512 * 1024 + tid;
            float a0 = 0.f, a1 = 0.f;
#pragma unroll 8
            for (int j = 0; j < 512; ++j) { const float hj = hid[j]; a0 += hj * Dn[(size_t)j * 1024]; a1 += hj * Dn[(size_t)j * 1024 + 512]; }
            y0 += wt * a0; y1 += wt * a1;
        }
        x[(size_t)m * D_ + tid] += y0; x[(size_t)m * D_ + tid + 512] += y1;
    }
}


namespace pg8 {
typedef short bf16x8 __attribute__((ext_vector_type(8)));
constexpr int BM = 256, BK = 64, HALF = 128, HTB = HALF * BK * 2, STAGE_BYTES = 8 * HTB, NXCD = 8, WGM = 8;
__host__ __device__ __forceinline__ int lds_byte(int r, int c) { const int st = (r >> 4) * 2 + (c >> 5), rr = r & 15, cc = c & 31, ob = rr * 64 + cc * 2; return st * 1024 + (ob ^ (((ob >> 9) & 1) << 5)); }
__host__ __device__ __forceinline__ void stage_rc(int b, int& R, int& C) { const int st = b / 1024, sb = b % 1024, swz = sb ^ (((sb >> 9) & 1) << 5); R = (st >> 1) * 16 + swz / 64; C = (st & 1) * 32 + (swz % 64) / 2; }
__host__ __device__ __forceinline__ int perm32(int rho) { const int n = rho >> 4, i = rho & 15; return 8 * (i >> 2) + 4 * n + (i & 3); }
struct Unit { int pm, pn, aux; };
struct GridOrder {
    int nM, nN, nwg, G, c; const char* A; const char* B; size_t tsA, tsB;
    __device__ __forceinline__ void init(int M, int N, int G_, int c_, const void* A_, int lda, const void* B_, int ldb) { nM = M / BM; nN = N / BM; nwg = nM * nN; G = G_; c = c_; A = (const char*)A_; B = (const char*)B_; tsA = (size_t)BM * lda * 2; tsB = (size_t)BM * ldb * 2; }
    __device__ __forceinline__ bool next(int i, Unit& u) const {
        const long L = (long)i * G + c; if (L >= nwg) return false;
        int wgid = (int)L; { const int q = nwg / NXCD, r = nwg % NXCD, xcd = wgid % NXCD, off = wgid / NXCD; wgid = (xcd < r ? xcd * (q + 1) : r * (q + 1) + (xcd - r) * q) + off; }
        const int nig = WGM * nN, gid = wgid / nig, fm = gid * WGM, gsz = (nM - fm) < WGM ? (nM - fm) : WGM;
        u.pm = fm + ((wgid % nig) % gsz); u.pn = (wgid % nig) / gsz; u.aux = 0; return true;
    }
    __device__ __forceinline__ const char* abase(const Unit& u) const { return A + (size_t)u.pm * tsA; }
    __device__ __forceinline__ const char* bbase(const Unit& u) const { return B + (size_t)u.pn * tsB; }
};
template <class Epi, class Sched>
__device__ __forceinline__ void gemm_phase(LAS unsigned char* lds, const int K, const int lda, const Sched& S, const Epi& E) {
    int tid = threadIdx.x; asm volatile("" : "+v"(tid));
    const int wid = __builtin_amdgcn_readfirstlane(tid >> 6), lane = tid & 63, wr = wid >> 2, wc = wid & 3, fr = lane & 15, fq = lane >> 4;
    const int nt = K / BK;
    unsigned voffA[2], voffB[2];
#pragma unroll
    for (int i = 0; i < 2; ++i) { int R, C; stage_rc(tid * 16 + i * 8192, R, C); const int Rb = (R & ~31) + perm32(R & 31);
        voffA[i] = (unsigned)(R * lda + C) * 2u; voffB[i] = (unsigned)(Rb * K + C) * 2u; }
    const size_t kstep = (size_t)(BK * 2);
    const size_t hstepA = (size_t)HALF * lda * 2, hstepB = (size_t)HALF * K * 2;
    const unsigned ldsw = (unsigned)wid * 1024u;
    const int aoff = lds_byte(wr * 64 + fr, fq * 8), boff = lds_byte(wc * 32 + fr, fq * 8);
#define PG8_SA(b, h) (((b) * 2 + (h)) * HTB)
#define PG8_SB(b, h) ((4 + (b) * 2 + (h)) * HTB)
#define PG8_STAGE(bufoff, gbase, voff) do { _Pragma("unroll") for (int _i = 0; _i < 2; ++_i) \
        __builtin_amdgcn_global_load_lds((const unsigned*)((const char*)(gbase) + (voff)[_i]), (LAS unsigned*)(lds + (bufoff) + ldsw + _i * 8192), 16, 0, 0); } while (0)
#define PG8_LDA(dst, b, h) do { _Pragma("unroll") for (int m = 0; m < 4; ++m) _Pragma("unroll") for (int k = 0; k < 2; ++k) dst[m][k] = *(const LAS bf16x8*)(lds + PG8_SA(b, h) + aoff + m * 2048 + k * 1024); } while (0)
#define PG8_LDB(dst, b, h) do { _Pragma("unroll") for (int n = 0; n < 2; ++n) _Pragma("unroll") for (int k = 0; k < 2; ++k) dst[n][k] = *(const LAS bf16x8*)(lds + PG8_SB(b, h) + boff + n * 2048 + k * 1024); } while (0)
#define PG8_MMA(ai, bj, At, Bt) do { __builtin_amdgcn_s_setprio(1); _Pragma("unroll") for (int m = 0; m < 4; ++m) _Pragma("unroll") for (int n = 0; n < 2; ++n) _Pragma("unroll") for (int k = 0; k < 2; ++k) \
        acc[ai][bj][m][n] = __builtin_amdgcn_mfma_f32_16x16x32_bf16(Bt[n][k], At[m][k], acc[ai][bj][m][n], 0, 0, 0); __builtin_amdgcn_s_setprio(0); } while (0)
#define PG8_WAIT_V(n) asm volatile("s_waitcnt vmcnt(" #n ")" ::: "memory")
#define PG8_WAIT_L(n) asm volatile("s_waitcnt lgkmcnt(" #n ")" ::: "memory")
#define PG8_BAR __builtin_amdgcn_s_barrier()
#define PG8_SCHED __builtin_amdgcn_sched_barrier(0)
    Unit cur, nxt; int ui = 0;
    if (!S.next(0, cur)) return;
    f32x4 acc[2][2][4][2];
#pragma unroll
    for (int a = 0; a < 2; ++a)
#pragma unroll
        for (int b = 0; b < 2; ++b)
#pragma unroll
            for (int m = 0; m < 4; ++m)
#pragma unroll
                for (int n = 0; n < 2; ++n) acc[a][b][m][n] = (f32x4){0.f, 0.f, 0.f, 0.f};
    bf16x8 At[4][2], B0[2][2], B1[2][2];
    const char* cA = S.abase(cur); const char* cB = S.bbase(cur);
    PG8_STAGE(PG8_SB(0, 0), cB, voffB); PG8_STAGE(PG8_SB(0, 1), cB + hstepB, voffB); PG8_STAGE(PG8_SA(0, 0), cA, voffA); PG8_STAGE(PG8_SA(0, 1), cA + hstepA, voffA);
    if (wr == 1) PG8_BAR;
    PG8_WAIT_V(2); PG8_BAR;
    PG8_STAGE(PG8_SB(1, 0), cB + kstep, voffB); PG8_STAGE(PG8_SA(1, 0), cA + kstep, voffA); PG8_STAGE(PG8_SB(1, 1), cB + hstepB + kstep, voffB);
    PG8_WAIT_V(6); PG8_BAR;
    for (;;) {
        const bool has_next = S.next(ui + 1, nxt);
        const char* nA = has_next ? S.abase(nxt) : cA; const char* nB = has_next ? S.bbase(nxt) : cB;
        for (int t = 0; t < nt; t += 2) {
            const bool last = (t == nt - 2);
            const char* a1 = cA + (size_t)(t + 1) * kstep;
            const char* a2 = last ? nA : cA + (size_t)(t + 2) * kstep; const char* b2 = last ? nB : cB + (size_t)(t + 2) * kstep;
            const char* a3 = a2 + kstep; const char* b3 = b2 + kstep;
            PG8_LDB(B0, 0, 0); PG8_LDB(B1, 0, 1); PG8_SCHED; PG8_LDA(At, 0, 0); PG8_STAGE(PG8_SA(1, 1), a1 + hstepA, voffA);
            PG8_WAIT_V(8); PG8_WAIT_L(0); PG8_BAR; PG8_MMA(0, 0, At, B0); PG8_MMA(0, 1, At, B1); PG8_BAR; PG8_SCHED;
            PG8_LDA(At, 0, 1); PG8_STAGE(PG8_SB(0, 0), b2, voffB); PG8_STAGE(PG8_SB(0, 1), b2 + hstepB, voffB); PG8_STAGE(PG8_SA(0, 0), a2, voffA);
            PG8_WAIT_V(8); PG8_WAIT_L(0); PG8_BAR; PG8_MMA(1, 0, At, B0); PG8_MMA(1, 1, At, B1); PG8_BAR; PG8_SCHED;
            PG8_LDB(B0, 1, 0); PG8_LDB(B1, 1, 1); PG8_SCHED; PG8_LDA(At, 1, 0); PG8_STAGE(PG8_SA(0, 1), a2 + hstepA, voffA);
            PG8_WAIT_V(8); PG8_WAIT_L(0); PG8_BAR; PG8_MMA(0, 0, At, B0); PG8_MMA(0, 1, At, B1); PG8_BAR; PG8_SCHED;
            PG8_LDA(At, 1, 1); PG8_STAGE(PG8_SB(1, 0), b3, voffB); PG8_STAGE(PG8_SB(1, 1), b3 + hstepB, voffB); PG8_STAGE(PG8_SA(1, 0), a3, voffA);
            PG8_WAIT_V(8); PG8_WAIT_L(0); PG8_BAR; PG8_MMA(1, 0, At, B0); PG8_MMA(1, 1, At, B1); PG8_BAR; PG8_SCHED;
        }
        if (wr == 0) PG8_BAR;
        E(acc, cur, wr, wc, fr, fq);
        if (!has_next) break;
#pragma unroll
        for (int a = 0; a < 2; ++a)
#pragma unroll
            for (int b = 0; b < 2; ++b)
#pragma unroll
                for (int m = 0; m < 4; ++m)
#pragma unroll
                    for (int n = 0; n < 2; ++n) acc[a][b][m][n] = (f32x4){0.f, 0.f, 0.f, 0.f};
        cur = nxt; cA = nA; cB = nB; ++ui;
        if (wr == 1) PG8_BAR;
    }
    PG8_WAIT_V(0);
    PG8_BAR;
#undef PG8_SA
#undef PG8_SB
#undef PG8_STAGE
#undef PG8_LDA
#undef PG8_LDB
#undef PG8_MMA
#undef PG8_WAIT_V
#undef PG8_WAIT_L
#undef PG8_BAR
#undef PG8_SCHED
}
typedef float f32x2_t __attribute__((ext_vector_type(2))); typedef __bf16 bf16x2_t __attribute__((ext_vector_type(2)));
__device__ __forceinline__ unsigned cvt_pk_bf16(float lo, float hi) { f32x2_t v = {lo, hi}; bf16x2_t b = __builtin_convertvector(v, bf16x2_t); return __builtin_bit_cast(unsigned, b); }
__device__ __forceinline__ v4u pack8(const f32x4 a, const f32x4 b) { v4u w; w.x = cvt_pk_bf16(a[0], a[1]); w.y = cvt_pk_bf16(a[2], a[3]); w.z = cvt_pk_bf16(b[0], b[1]); w.w = cvt_pk_bf16(b[2], b[3]); return w; }

struct EpiInproj {
    bf16* FOX; bf16* GLA; bf16* SSM; float* SML; bf16* GATES; const float *qn, *kn, *f_bias, *dt_bias, *bgate;
    __device__ __forceinline__ void operator()(const f32x4 (&acc)[2][2][4][2], const Unit& u, int wr, int wc, int fr, int fq) const {
        asm volatile("" : "+v"(fr), "+v"(fq), "+s"(wr), "+s"(wc));
        const int pn = u.pn; const size_t row0 = (size_t)u.pm * BM + wr * 64 + fr;
        if (EPI_SKIP(pn)) return;
        if (pn < 4) {
            const bool isq = pn < 2; const float* gain = isq ? qn : kn; const float sc = isq ? 0.125f * LOG2E : 1.f;
            f32x4 g[2][2];
#pragma unroll
            for (int bj = 0; bj < 2; ++bj)
#pragma unroll
                for (int n = 0; n < 2; ++n) g[bj][n] = *(const f32x4*)(gain + 32 * bj + 8 * fq + 4 * n);
            bf16* dst = FOX + (isq ? 0 : 512) + (pn & 1) * 256 + 64 * wc + 8 * fq;
#pragma unroll
            for (int ai = 0; ai < 2; ++ai)
#pragma unroll
                for (int m = 0; m < 4; ++m) {
                    float ss = 0.f;
#pragma unroll
                    for (int bj = 0; bj < 2; ++bj)
#pragma unroll
                        for (int n = 0; n < 2; ++n) { const f32x4 x = acc[ai][bj][m][n]; ss += (x[0] * x[0] + x[1] * x[1]) + (x[2] * x[2] + x[3] * x[3]); }
                    ss += __shfl_xor(ss, 16); ss += __shfl_xor(ss, 32);
                    const float rs = rsqrtf(ss * (1.f / 64.f) + EPS) * sc;
                    bf16* rp = dst + (row0 + ai * HALF + m * 16) * FOXP;
#pragma unroll
                    for (int bj = 0; bj < 2; ++bj) *(v4u*)(rp + 32 * bj) = pack8(acc[ai][bj][m][0] * rs * g[bj][0], acc[ai][bj][m][1] * rs * g[bj][1]);
                }
        } else if (pn == 17) {
            if (wc == 0) {
                f32x4 b0 = (f32x4){0.f, 0.f, 0.f, 0.f}, b1 = b0;
                if (fq == 0) { b0 = *(const f32x4*)(f_bias); b1 = *(const f32x4*)(f_bias + 4); }
                if (fq == 3) { b0 = *(const f32x4*)(dt_bias); b1 = *(const f32x4*)(dt_bias + 4); }
#pragma unroll
                for (int ai = 0; ai < 2; ++ai)
#pragma unroll
                    for (int m = 0; m < 4; ++m) {
                        f32x4 v0 = acc[ai][0][m][0] + b0, v1 = acc[ai][0][m][1] + b1;
                        if (fq == 0) {
#pragma unroll
                            for (int i = 0; i < 4; ++i) { v0[i] = logsig_f(v0[i]) * LOG2E; v1[i] = logsig_f(v1[i]) * LOG2E; } }
                        if (fq == 3) {
#pragma unroll
                            for (int i = 0; i < 4; ++i) { v0[i] = softplus_f(v0[i]); v1[i] = softplus_f(v1[i]); } }
                        float* rp = SML + (row0 + ai * HALF + m * 16) * SMLP + 8 * fq;
                        *(f32x4*)rp = v0; *(f32x4*)(rp + 4) = v1;
                    }
            }
        } else if (pn >= 18) {
            const int colt = (pn - 18) * 256 + 32 * wc + 8 * fq;
#pragma unroll
            for (int bj = 0; bj < 2; ++bj) {
                const f32x4 b0 = *(const f32x4*)(bgate + colt + bj * HALF), b1 = *(const f32x4*)(bgate + colt + bj * HALF + 4);
#pragma unroll
                for (int ai = 0; ai < 2; ++ai)
#pragma unroll
                    for (int m = 0; m < 4; ++m) {
                        f32x4 v0 = acc[ai][bj][m][0] + b0, v1 = acc[ai][bj][m][1] + b1;
#pragma unroll
                        for (int i = 0; i < 4; ++i) { v0[i] = __builtin_amdgcn_rcpf(1.f + __expf(-v0[i])); v1[i] = __builtin_amdgcn_rcpf(1.f + __expf(-v1[i])); }
                        *(v4u*)(GATES + (row0 + ai * HALF + m * 16) * GATP + colt + bj * HALF) = pack8(v0, v1);
                    }
            }
        } else {
            bf16* dst = (pn < 6) ? FOX + 1024 + (pn - 4) * 256 : (pn < 12 ? GLA + (pn - 6) * 256 : SSM + (pn - 12) * 256);
            dst += 32 * wc + 8 * fq;
#pragma unroll
            for (int ai = 0; ai < 2; ++ai)
#pragma unroll
                for (int m = 0; m < 4; ++m) { bf16* rp = dst + (row0 + ai * HALF + m * 16) * 1536;
#pragma unroll
                    for (int bj = 0; bj < 2; ++bj) *(v4u*)(rp + bj * HALF) = pack8(acc[ai][bj][m][0], acc[ai][bj][m][1]); }
        }
    }
};
struct EpiResidual {
    const float* xold; float* xnew;
    __device__ __forceinline__ void operator()(const f32x4 (&acc)[2][2][4][2], const Unit& u, int wr, int wc, int fr, int fq) const {
        asm volatile("" : "+v"(fr), "+v"(fq), "+s"(wr), "+s"(wc));
        const size_t row0 = (size_t)u.pm * BM + wr * 64 + fr; const int col0 = u.pn * BM + 32 * wc + 8 * fq;
#pragma unroll
        for (int ai = 0; ai < 2; ++ai)
#pragma unroll
            for (int m = 0; m < 4; ++m) { const size_t off = (row0 + ai * HALF + m * 16) * D_ + col0;
#pragma unroll
                for (int bj = 0; bj < 2; ++bj) { const f32x4 x0 = *(const f32x4*)(xold + off + bj * HALF), x1 = *(const f32x4*)(xold + off + bj * HALF + 4);
                    *(f32x4*)(xnew + off + bj * HALF) = x0 + acc[ai][bj][m][0]; *(f32x4*)(xnew + off + bj * HALF + 4) = x1 + acc[ai][bj][m][1]; } }
    }
};
struct MergeOrder {
    int G, c; const char* ws; const char* B;
    __device__ __forceinline__ bool next(int i, Unit& u) const { const int q = i / 3; const int tile = c + q * G; if (tile >= 256) return false; u.pm = tile >> 2; u.pn = tile & 3; u.aux = i - 3 * q; return true; }
    __device__ __forceinline__ const char* abase(const Unit& u) const { return ws + WS_FOX + (size_t)u.aux * (48 * MiB) + (size_t)(u.aux & 1) * 2048 + (size_t)u.pm * BM * 1536 * 2; }
    __device__ __forceinline__ const char* bbase(const Unit& u) const { return B + ((size_t)u.aux * 1024 + (size_t)u.pn * BM) * 512 * 2; }
};
static_assert(WS_GLA - WS_FOX == 48 * MiB && WS_SSM - WS_GLA == 48 * MiB, "MergeOrder::abase");
struct EpiMerge {
    const bf16* GATES; bf16* MB;
    __device__ __forceinline__ void operator()(const f32x4 (&acc)[2][2][4][2], const Unit& u, int wr, int wc, int fr, int fq) const {
        asm volatile("" : "+v"(fr), "+v"(fq), "+s"(wr), "+s"(wc));
        const size_t row0 = (size_t)u.pm * BM + wr * 64 + fr; const int col0 = u.pn * BM + 32 * wc + 8 * fq; const int r = u.aux;
#pragma unroll
        for (int ai = 0; ai < 2; ++ai)
#pragma unroll
            for (int m = 0; m < 4; ++m) { const size_t row = row0 + ai * HALF + m * 16;
#pragma unroll
                for (int bj = 0; bj < 2; ++bj) {
                    const v4u gv = *(const v4u*)(GATES + row * GATP + r * 1024 + col0 + bj * HALF);
                    f32x4 v0 = acc[ai][bj][m][0], v1 = acc[ai][bj][m][1];
                    v0[0] *= bf2f(gv.x & 0xffffu); v0[1] *= bf2f(gv.x >> 16); v0[2] *= bf2f(gv.y & 0xffffu); v0[3] *= bf2f(gv.y >> 16);
                    v1[0] *= bf2f(gv.z & 0xffffu); v1[1] *= bf2f(gv.z >> 16); v1[2] *= bf2f(gv.w & 0xffffu); v1[3] *= bf2f(gv.w >> 16);
                    bf16* mp = MB + row * FOXP + col0 + bj * HALF;
                    if (r > 0) { const v4u pv = *(const v4u*)mp;
                        v0[0] += bf2f(pv.x & 0xffffu); v0[1] += bf2f(pv.x >> 16); v0[2] += bf2f(pv.y & 0xffffu); v0[3] += bf2f(pv.y >> 16);
                        v1[0] += bf2f(pv.z & 0xffffu); v1[1] += bf2f(pv.z >> 16); v1[2] += bf2f(pv.w & 0xffffu); v1[3] += bf2f(pv.w >> 16); }
                    *(v4u*)mp = pack8(v0, v1);
                } }
    }
};
}

__device__ __forceinline__ int inproj_src_col(int p) {
    const int tile = p >> 8, q = p & 255;
    if (tile < 4) { const int base = (tile < 2 ? 0 : 512) + (tile & 1) * 256; return base + 64 * ((q >> 5) & 3) + 32 * (q >> 7) + (q & 31); }
    if (tile < 6) return 1024 + (tile - 4) * 256 + q;
    if (tile < 12) return 1544 + (tile - 6) * 256 + q;
    if (tile < 17) return 3096 + (tile - 12) * 256 + q;
    if (tile == 17) return q < 8 ? 1536 + q : (q < 24 ? 3080 + (q - 8) : (q < 32 ? 4376 + (q - 24) : -1));
    return 4384 + (tile - 18) * 256 + q;
}
__device__ __forceinline__ void transpose_item(const float* W, int ldw, int src, bf16* WT, int K, int p0, int k0, LAS float* scr, int lane) {
#pragma unroll 8
    for (int i = 0; i < 32; ++i) { const int kk = 2 * i + (lane >> 5); scr[kk * 33 + (lane & 31)] = (src >= 0) ? W[(size_t)(k0 + kk) * ldw + src] : 0.f; }
    asm volatile("s_waitcnt lgkmcnt(0)" ::: "memory");
    const int c = lane & 7;
#pragma unroll
    for (int j = 0; j < 4; ++j) { const int n = (lane >> 3) + 8 * j; const LAS float* sp = scr + (8 * c) * 33 + n;
        v4u o; o.x = pk2(sp[0 * 33], sp[1 * 33]); o.y = pk2(sp[2 * 33], sp[3 * 33]); o.z = pk2(sp[4 * 33], sp[5 * 33]); o.w = pk2(sp[6 * 33], sp[7 * 33]);
        *(v4u*)(WT + (size_t)(p0 + n) * K + k0 + 8 * c) = o; }
    asm volatile("s_waitcnt lgkmcnt(0)" ::: "memory");
}
__device__ __forceinline__ void convert_small_weights(const float* w_in, const float* w_branch, const float* w_out, bf16* WIN, bf16* WBR, bf16* WOUT, LAS float* scr, int wave, int lane) {
    asm volatile("" : "+s"(wave), "+v"(lane));
    const int gw = blockIdx.x * NWAVES + wave, NGW = gridDim.x * NWAVES;
    constexpr int I_IN = 16 * 240, I_BR = 8 * 32, I_OUT = 16 * 32;
    for (int it = gw; it < I_IN + 3 * I_BR + I_OUT; it += NGW) {
        int r = it;
        if (r < I_IN) { const int kb = r / 240, pb = r % 240; transpose_item(w_in, INC, inproj_src_col(pb * 32 + (lane & 31)), WIN, 1024, pb * 32, kb * 64, scr, lane); continue; } r -= I_IN;
        if (r < 3 * I_BR) { const int br = r / I_BR, q = r % I_BR, kb = q / 32, pb = q % 32; transpose_item(w_branch + (size_t)br * 512 * 1024, 1024, pb * 32 + (lane & 31), WBR + (size_t)br * 1024 * 512, 512, pb * 32, kb * 64, scr, lane); continue; } r -= 3 * I_BR;
        { const int kb = r / 32, pb = r % 32; transpose_item(w_out, 1024, pb * 32 + (lane & 31), WOUT, 1024, pb * 32, kb * 64, scr, lane); }
    }
}

__device__ __forceinline__ void ph_norm2_route_blk(const float* x, const float* gain, bf16* out, const float* wg, const float* bg, const float* we, const float* be,
                                                   int* tok_e, float* tok_w, int* lrank, int* cntblk, LAS int* sE, int tid, int wave, int lane) {
    asm volatile("" : "+v"(tid), "+s"(wave), "+v"(lane));
    LAS int* sR = sE + 128;
    for (int blk = blockIdx.x; blk < 256; blk += gridDim.x) {
        __syncthreads();
#pragma unroll 1
        for (int i = 0; i < 8; ++i) {
            const int m = blk * 64 + wave * 8 + i;
            const f32x4* xr = (const f32x4*)(x + (size_t)m * D_) + lane;
            f32x4 v[4]; float s = 0.f;
#pragma unroll
            for (int j = 0; j < 4; ++j) { v[j] = xr[64 * j]; s += (v[j].x * v[j].x + v[j].y * v[j].y) + (v[j].z * v[j].z + v[j].w * v[j].w); }
            const float r = rsqrtf(wave_sum(s) * (1.f / D_) + EPS);
            v2u* o8 = (v2u*)(out + (size_t)m * D_) + lane;
            float gl[4] = {0.f, 0.f, 0.f, 0.f}; float hn[16];
#pragma unroll
            for (int j = 0; j < 4; ++j) { const f32x4 g = ((const f32x4*)gain)[lane + 64 * j];
                const float h0 = v[j].x * r * g.x, h1 = v[j].y * r * g.y, h2 = v[j].z * r * g.z, h3 = v[j].w * r * g.w;
                v2u w; w.x = pk2(h0, h1); w.y = pk2(h2, h3); o8[64 * j] = w;
                hn[4 * j] = h0; hn[4 * j + 1] = h1; hn[4 * j + 2] = h2; hn[4 * j + 3] = h3;
#pragma unroll
                for (int q = 0; q < 4; ++q) { const int k = 4 * (lane + 64 * j) + q; const f32x4 a = *(const f32x4*)(wg + (size_t)k * 4);
                    gl[0] += hn[4 * j + q] * a.x; gl[1] += hn[4 * j + q] * a.y; gl[2] += hn[4 * j + q] * a.z; gl[3] += hn[4 * j + q] * a.w; } }
#pragma unroll
            for (int q = 0; q < 4; ++q) gl[q] = wave_sum(gl[q]) + bg[q];
            int gs = 0; float gm = gl[0];
#pragma unroll
            for (int q = 1; q < 4; ++q) if (gl[q] > gm) { gm = gl[q]; gs = q; }
            float gsum = 0.f;
#pragma unroll
            for (int q = 0; q < 4; ++q) gsum += __expf(gl[q] - gm);
            const float g_w = 1.f / gsum;
            gs = __builtin_amdgcn_readfirstlane(gs);
            float el[4] = {0.f, 0.f, 0.f, 0.f};
#pragma unroll
            for (int j = 0; j < 4; ++j)
#pragma unroll
                for (int q = 0; q < 4; ++q) { const int k = 4 * (lane + 64 * j) + q; const f32x4 c = *(const f32x4*)(we + (size_t)k * 16 + 4 * gs);
                    el[0] += hn[4 * j + q] * c.x; el[1] += hn[4 * j + q] * c.y; el[2] += hn[4 * j + q] * c.z; el[3] += hn[4 * j + q] * c.w; }
#pragma unroll
            for (int q = 0; q < 4; ++q) el[q] = wave_sum(el[q]) + be[4 * gs + q];
            int i0 = 0; float m0 = el[0];
#pragma unroll
            for (int q = 1; q < 4; ++q) if (el[q] > m0) { m0 = el[q]; i0 = q; }
            int i1 = -1; float m1 = -3.0e38f;
#pragma unroll
            for (int q = 0; q < 4; ++q) if (q != i0 && el[q] > m1) { m1 = el[q]; i1 = q; }
            const float p1 = __expf(m1 - m0);
            if (lane == 0) { const int e0 = gs * 4 + i0, e1 = gs * 4 + i1; tok_e[2 * m] = e0; tok_e[2 * m + 1] = e1; tok_w[2 * m] = g_w / (1.f + p1); tok_w[2 * m + 1] = g_w * p1 / (1.f + p1);
                sE[(wave * 8 + i) * 2] = e0; sE[(wave * 8 + i) * 2 + 1] = e1; }
        }
        __syncthreads();
        if (tid < 16) { int cnt = 0; for (int a = 0; a < 128; ++a) if (sE[a] == tid) { sR[a] = cnt; ++cnt; } cntblk[blk * 16 + tid] = cnt; }
        __syncthreads();
        if (tid < 128) lrank[blk * 128 + tid] = sR[tid];
    }
}
__device__ __forceinline__ void convert_expert_weights(const float* wgate, const float* wup, const float* wdown, bf16* W1, bf16* WD, LAS float* scr, int wave, int lane) {
    asm volatile("" : "+s"(wave), "+v"(lane));
    const int gw = blockIdx.x * NWAVES + wave, NGW = gridDim.x * NWAVES;
    for (int it = gw; it < 16 * 768; it += NGW) {
        const int e = it / 768; int r = it - e * 768;
        if (r < 512) { const int kb = r >> 5, pb = r & 31, t = pb >> 3, sub = pb & 7; const float* src = ((sub < 4) ? wgate : wup) + (size_t)e * 1024 * 512;
            transpose_item(src, 512, 128 * t + (sub & 3) * 32 + (lane & 31), W1 + (size_t)e * 1024 * 1024, 1024, pb * 32, kb * 64, scr, lane); }
        else { r -= 512; const int kb = r >> 5, pb = r & 31; transpose_item(wdown + (size_t)e * 512 * 1024, 1024, pb * 32 + (lane & 31), WD + (size_t)e * 1024 * 512, 512, pb * 32, kb * 64, scr, lane); }
    }
}
__device__ __forceinline__ void ph_moe_scatter(const bf16* HB, bf16* HS, const int* tok_e, const float* tok_w, const int* lrank, const int* cntblk, int* rowtok, float* roww,
                                               LAS int* sPre, LAS int* sRow, LAS int* sTb, LAS int* sTot, int tid, int wave, int lane) {
    asm volatile("" : "+v"(tid), "+s"(wave), "+v"(lane));
    __syncthreads();
    if (tid < 16) { int run = 0; for (int blk = 0; blk < 256; ++blk) { sPre[blk * 16 + tid] = run; run += cntblk[blk * 16 + tid]; } sTot[tid] = run; }
    __syncthreads();
    if (tid == 0) { int t = 0; for (int e = 0; e < 16; ++e) { sTb[e] = t; t += (sTot[e] + 255) >> 8; } sTb[16] = t; }
    __syncthreads();
    for (int e = blockIdx.x; e < 16; e += gridDim.x) { const int r1 = sTb[e + 1] * 256; for (int r = sTb[e] * 256 + sTot[e] + tid; r < r1; r += NTHR) rowtok[r] = -1; }
    for (int blk = blockIdx.x; blk < 256; blk += gridDim.x) {
        __syncthreads();
        if (tid < 128) { const int t = blk * 64 + (tid >> 1); const int e = tok_e[2 * t + (tid & 1)];
            const int row = sTb[e] * 256 + sPre[blk * 16 + e] + lrank[blk * 128 + tid]; rowtok[row] = t; roww[row] = tok_w[2 * t + (tid & 1)]; sRow[tid] = row; }
        __syncthreads();
        for (int a = wave; a < 128; a += NWAVES) { const int t = blk * 64 + (a >> 1); const int row = sRow[a];
            const v4u* src = (const v4u*)(HB + (size_t)t * D_); v4u* dst = (v4u*)(HS + (size_t)row * D_); const v4u a0 = src[lane], a1 = src[lane + 64]; dst[lane] = a0; dst[lane + 64] = a1; }
    }
}
namespace pg8 {
struct MoeOrder {
    int G, c; const char* A; size_t tsA; const char* B; size_t strideE, tsB; const LAS int* tb;
    __device__ __forceinline__ bool next(int i, Unit& u) const {
        const int uu = c + i * G; const int TT = __builtin_amdgcn_readfirstlane(tb[16]); if (uu >= 4 * TT) return false;
        const int grt = uu >> 2; u.pm = grt; u.pn = uu & 3; int e = 0;
#pragma unroll
        for (int k = 1; k < 16; ++k) e += (grt >= __builtin_amdgcn_readfirstlane(tb[k])) ? 1 : 0;
        u.aux = e; return true; }
    __device__ __forceinline__ const char* abase(const Unit& u) const { return A + (size_t)u.pm * tsA; }
    __device__ __forceinline__ const char* bbase(const Unit& u) const { return B + (size_t)u.aux * strideE + (size_t)u.pn * tsB; }
};
struct EpiMoe1 {
    bf16* HID;
    __device__ __forceinline__ void operator()(const f32x4 (&acc)[2][2][4][2], const Unit& u, int wr, int wc, int fr, int fq) const {
        asm volatile("" : "+v"(fr), "+v"(fq), "+s"(wr), "+s"(wc));
        const size_t row0 = (size_t)u.pm * BM + wr * 64 + fr; const int col = u.pn * 128 + 32 * wc + 8 * fq;
#pragma unroll
        for (int ai = 0; ai < 2; ++ai)
#pragma unroll
            for (int m = 0; m < 4; ++m) {
                f32x4 h0, h1;
#pragma unroll
                for (int i = 0; i < 4; ++i) { const float g0 = acc[ai][0][m][0][i], g1 = acc[ai][0][m][1][i];
                    h0[i] = g0 * __builtin_amdgcn_rcpf(1.f + __expf(-g0)) * acc[ai][1][m][0][i]; h1[i] = g1 * __builtin_amdgcn_rcpf(1.f + __expf(-g1)) * acc[ai][1][m][1][i]; }
                *(v4u*)(HID + (row0 + ai * HALF + m * 16) * 512 + col) = pack8(h0, h1);
            }
    }
};
struct EpiMoe2 {
    const int* rowtok; const float* roww; float* x;
    __device__ __forceinline__ void operator()(const f32x4 (&acc)[2][2][4][2], const Unit& u, int wr, int wc, int fr, int fq) const {
        asm volatile("" : "+v"(fr), "+v"(fq), "+s"(wr), "+s"(wc));
        const size_t row0 = (size_t)u.pm * BM + wr * 64 + fr; const int col0 = u.pn * BM + 32 * wc + 8 * fq;
#pragma unroll
        for (int ai = 0; ai < 2; ++ai)
#pragma unroll
            for (int m = 0; m < 4; ++m) { const size_t grow = row0 + ai * HALF + m * 16; const int tok = rowtok[grow];
                if (tok >= 0) { const float w = roww[grow]; float* p = x + (size_t)tok * D_ + col0;
#pragma unroll
                    for (int bj = 0; bj < 2; ++bj)
#pragma unroll
                        for (int i = 0; i < 4; ++i) { (void)__hip_atomic_fetch_add(p + bj * HALF + i, w * acc[ai][bj][m][0][i], __ATOMIC_RELAXED, __HIP_MEMORY_SCOPE_AGENT);
                            (void)__hip_atomic_fetch_add(p + bj * HALF + 4 + i, w * acc[ai][bj][m][1][i], __ATOMIC_RELAXED, __HIP_MEMORY_SCOPE_AGENT); } } }
    }
};
}

namespace mm {
typedef short bf16x8 __attribute__((ext_vector_type(8)));
constexpr int LD = 72;
__device__ __forceinline__ bf16x8 frag(const LAS bf16* M, int r0, int k0, int lane) { return *(const LAS bf16x8*)(M + (r0 + (lane & 15)) * LD + k0 + 8 * (lane >> 4)); }
__device__ __forceinline__ bf16x8 frag_g(const float* M, int r0, int k0, int lane) {
    const float* p = M + (size_t)(r0 + (lane & 15)) * 64 + k0 + 8 * (lane >> 4); const f32x4 a = *(const f32x4*)p, b = *(const f32x4*)(p + 4);
    const v4u w = pg8::pack8(a, b); return __builtin_bit_cast(bf16x8, w); }
__device__ __forceinline__ f32x4 mma(bf16x8 xf, bf16x8 yf, f32x4 acc) { return __builtin_amdgcn_mfma_f32_16x16x32_bf16(xf, yf, acc, 0, 0, 0); }
__device__ __forceinline__ float wave_incl_scan(float v, int lane) {
#pragma unroll
    for (int o = 1; o < 64; o <<= 1) { const float t = __shfl_up(v, o); if (lane >= o) v += t; }
    return v; }
}
constexpr int GST_CH = 8192, SST_CH = 4096;

__device__ __forceinline__ void gla_bcum(const float* SML, const float* w_lr, const float* b_gate, LAS float* BC, LAS float* BL, size_t row0, int h, int wave, int lane) {
    const float* gp = SML + (row0 + lane) * SMLP + 8;
    const f32x4 g0 = *(const f32x4*)gp, g1 = *(const f32x4*)(gp + 4), g2 = *(const f32x4*)(gp + 8), g3 = *(const f32x4*)(gp + 12);
    const float gl[16] = {g0[0], g0[1], g0[2], g0[3], g1[0], g1[1], g1[2], g1[3], g2[0], g2[1], g2[2], g2[3], g3[0], g3[1], g3[2], g3[3]};
#pragma unroll
    for (int dd = 0; dd < 8; ++dd) { const int d = wave * 8 + dd, col = h * 64 + d;
        float z = b_gate[col];
#pragma unroll
        for (int j = 0; j < 16; ++j) z += gl[j] * w_lr[j * 256 + col];
        const float bc = mm::wave_incl_scan(logsig_f(z) * (1.f / 16.f), lane);
        BC[lane * 64 + d] = bc; if (lane == 63) BL[d] = bc; }
}
__device__ __forceinline__ void gla_stage_vt(const bf16* GLA, LAS bf16* VT, size_t row0, int h, int tid) {
#pragma unroll
    for (int j = 0; j < 2; ++j) { const int idx = tid + j * NTHR, s = idx >> 4, vg = idx & 15;
        const v4u w = *(const v4u*)(GLA + (row0 + s) * GLAP + 512 + h * 128 + vg * 8); LAS bf16* o = VT + (vg * 8) * mm::LD + s;
        o[0] = (bf16)(w.x & 0xffffu); o[mm::LD] = (bf16)(w.x >> 16); o[2 * mm::LD] = (bf16)(w.y & 0xffffu); o[3 * mm::LD] = (bf16)(w.y >> 16);
        o[4 * mm::LD] = (bf16)(w.z & 0xffffu); o[5 * mm::LD] = (bf16)(w.z >> 16); o[6 * mm::LD] = (bf16)(w.w & 0xffffu); o[7 * mm::LD] = (bf16)(w.w >> 16); }
}
__device__ __forceinline__ void gla_local_unit(const bf16* GLA, const float* SML, const float* w_lr, const float* b_gate, float* GST, float* GDEC, LAS unsigned char* L8, int bh, int c, int tid, int wave, int lane) {
    LAS float* BC = (LAS float*)L8; LAS float* BL = (LAS float*)(L8 + 16384); LAS bf16* KE = (LAS bf16*)(L8 + 16640); LAS bf16* VT = (LAS bf16*)(L8 + 25856);
    const int b = bh >> 2, h = bh & 3; const size_t row0 = (size_t)b * S_ + (size_t)c * 64;
    __syncthreads();
    gla_bcum(SML, w_lr, b_gate, BC, BL, row0, h, wave, lane);
    __syncthreads();
    { const int s = tid >> 3, dg = tid & 7; const v4u w = *(const v4u*)(GLA + (row0 + s) * GLAP + 256 + h * 64 + dg * 8);
      const float kf[8] = {bf2f(w.x & 0xffffu), bf2f(w.x >> 16), bf2f(w.y & 0xffffu), bf2f(w.y >> 16), bf2f(w.z & 0xffffu), bf2f(w.z >> 16), bf2f(w.w & 0xffffu), bf2f(w.w >> 16)};
#pragma unroll
      for (int i = 0; i < 8; ++i) { const int d = dg * 8 + i; KE[d * mm::LD + s] = (bf16)f2bf(kf[i] * __expf(BL[d] - BC[s * 64 + d])); } }
    gla_stage_vt(GLA, VT, row0, h, tid);
    if (tid < 64) GDEC[((size_t)bh * 128 + c) * 64 + tid] = __expf(BL[tid]);
    __syncthreads();
    f32x4 acc[4];
#pragma unroll
    for (int i = 0; i < 4; ++i) acc[i] = (f32x4){0.f, 0.f, 0.f, 0.f};
#pragma unroll
    for (int kk = 0; kk < 64; kk += 32) { const mm::bf16x8 yf = mm::frag(VT, wave * 16, kk, lane);
#pragma unroll
        for (int dt = 0; dt < 4; ++dt) acc[dt] = mm::mma(mm::frag(KE, dt * 16, kk, lane), yf, acc[dt]); }
    float* dst = GST + ((size_t)bh * 128 + c) * GST_CH + (size_t)(wave * 16 + (lane & 15)) * 64 + 4 * (lane >> 4);
#pragma unroll
    for (int dt = 0; dt < 4; ++dt) *(f32x4*)(dst + dt * 16) = acc[dt];
}
__device__ __forceinline__ void gla_out_unit(bf16* GLA, const float* SML, const float* w_lr, const float* b_gate, const float* GST, const float* gla_norm, LAS unsigned char* L8, int bh, int c, int tid, int wave, int lane) {
    LAS float* BC = (LAS float*)L8; LAS float* BL = (LAS float*)(L8 + 16384); LAS bf16* QD = (LAS bf16*)(L8 + 16640); LAS bf16* KD = (LAS bf16*)(L8 + 25856);
    LAS bf16* VT = (LAS bf16*)(L8 + 35072); LAS bf16* AL = (LAS bf16*)(L8 + 53504); LAS float* RED = (LAS float*)(L8 + 62720);
    const int b = bh >> 2, h = bh & 3; const size_t row0 = (size_t)b * S_ + (size_t)c * 64;
    __syncthreads();
    gla_bcum(SML, w_lr, b_gate, BC, BL, row0, h, wave, lane);
    __syncthreads();
    { const int s = tid >> 3, dg = tid & 7; const v4u wq = *(const v4u*)(GLA + (row0 + s) * GLAP + h * 64 + dg * 8), wk = *(const v4u*)(GLA + (row0 + s) * GLAP + 256 + h * 64 + dg * 8);
      const float qf[8] = {bf2f(wq.x & 0xffffu), bf2f(wq.x >> 16), bf2f(wq.y & 0xffffu), bf2f(wq.y >> 16), bf2f(wq.z & 0xffffu), bf2f(wq.z >> 16), bf2f(wq.w & 0xffffu), bf2f(wq.w >> 16)};
      const float kf[8] = {bf2f(wk.x & 0xffffu), bf2f(wk.x >> 16), bf2f(wk.y & 0xffffu), bf2f(wk.y >> 16), bf2f(wk.z & 0xffffu), bf2f(wk.z >> 16), bf2f(wk.w & 0xffffu), bf2f(wk.w >> 16)};
      float qd[8], kd[8];
#pragma unroll
      for (int i = 0; i < 8; ++i) { const float bc = BC[s * 64 + dg * 8 + i]; qd[i] = qf[i] * 0.125f * __expf(bc); kd[i] = kf[i] * __expf(-bc); }
      v4u o; o.x = pk2(qd[0], qd[1]); o.y = pk2(qd[2], qd[3]); o.z = pk2(qd[4], qd[5]); o.w = pk2(qd[6], qd[7]); *(LAS v4u*)(QD + s * mm::LD + dg * 8) = o;
      o.x = pk2(kd[0], kd[1]); o.y = pk2(kd[2], kd[3]); o.z = pk2(kd[4], kd[5]); o.w = pk2(kd[6], kd[7]); *(LAS v4u*)(KD + s * mm::LD + dg * 8) = o; }
    gla_stage_vt(GLA, VT, row0, h, tid);
    __syncthreads();
#pragma unroll
    for (int ii = 0; ii < 2; ++ii) { const int id = wave + 8 * ii, tt = id >> 2, st = id & 3;
        f32x4 a = (f32x4){0.f, 0.f, 0.f, 0.f};
        if (st <= tt) {
#pragma unroll
            for (int kk = 0; kk < 64; kk += 32) a = mm::mma(mm::frag(KD, st * 16, kk, lane), mm::frag(QD, tt * 16, kk, lane), a); }
        const int t = tt * 16 + (lane & 15), s0 = st * 16 + 4 * (lane >> 4);
        v2u w; w.x = pk2(s0 <= t ? a[0] : 0.f, s0 + 1 <= t ? a[1] : 0.f); w.y = pk2(s0 + 2 <= t ? a[2] : 0.f, s0 + 3 <= t ? a[3] : 0.f);
        *(LAS v2u*)(AL + t * mm::LD + s0) = w; }
    __syncthreads();
    const int tt = wave & 3, vh = wave >> 2;
    const float* Sc = GST + ((size_t)bh * 128 + c) * GST_CH;
    f32x4 acc[4];
#pragma unroll
    for (int i = 0; i < 4; ++i) acc[i] = (f32x4){0.f, 0.f, 0.f, 0.f};
#pragma unroll
    for (int kk = 0; kk < 64; kk += 32) { const mm::bf16x8 yq = mm::frag(QD, tt * 16, kk, lane), ya = mm::frag(AL, tt * 16, kk, lane);
#pragma unroll
        for (int j = 0; j < 4; ++j) { acc[j] = mm::mma(mm::frag_g(Sc, (vh * 4 + j) * 16, kk, lane), yq, acc[j]); acc[j] = mm::mma(mm::frag(VT, (vh * 4 + j) * 16, kk, lane), ya, acc[j]); } }
    float ss = 0.f;
#pragma unroll
    for (int j = 0; j < 4; ++j) ss += (acc[j][0] * acc[j][0] + acc[j][1] * acc[j][1]) + (acc[j][2] * acc[j][2] + acc[j][3] * acc[j][3]);
    ss += __shfl_xor(ss, 16); ss += __shfl_xor(ss, 32);
    const int t = tt * 16 + (lane & 15);
    if (lane < 16) RED[vh * 64 + t] = ss;
    __syncthreads();
    const float rs = rsqrtf((RED[t] + RED[64 + t]) * (1.f / 128.f) + EPS);
#pragma unroll
    for (int j = 0; j < 4; ++j) { const int v = (vh * 4 + j) * 16 + 4 * (lane >> 4);
        const f32x4 gn = *(const f32x4*)(gla_norm + v); bf16* gp = GLA + (row0 + t) * GLAP + 1024 + h * 128 + v; const v2u gr = *(const v2u*)gp;
        v2u o; o.x = pk2(acc[j][0] * rs * gn[0] * silu_f(bf2f(gr.x & 0xffffu)), acc[j][1] * rs * gn[1] * silu_f(bf2f(gr.x >> 16)));
        o.y = pk2(acc[j][2] * rs * gn[2] * silu_f(bf2f(gr.y & 0xffffu)), acc[j][3] * rs * gn[3] * silu_f(bf2f(gr.y >> 16))); *(v2u*)gp = o; }
}
__device__ __forceinline__ void ssd_acs(const float* SML, const float* a_log, LAS float* ACS, LAS float* DT, LAS float* AL4, size_t row0, int g, int wave, int lane) {
    if (wave < 4) { const float dt = SML[(row0 + lane) * SMLP + 24 + 4 * g + wave]; const float a = -__expf(a_log[4 * g + wave]);
        const float v = mm::wave_incl_scan(dt * a, lane); ACS[lane * 4 + wave] = v; DT[lane * 4 + wave] = dt; if (lane == 63) AL4[wave] = v; }
}
__device__ __forceinline__ void ssd_conv8(const bf16* SSM, const float* conv_w, const float* conv_b, int b, int s, int ch0, float (&out)[8]) {
    const f32x4 b0 = *(const f32x4*)(conv_b + ch0), b1 = *(const f32x4*)(conv_b + ch0 + 4);
    float acc[8] = {b0[0], b0[1], b0[2], b0[3], b1[0], b1[1], b1[2], b1[3]};
#pragma unroll
    for (int j = 0; j < 4; ++j) { const int sp = s - 3 + j;
        if (sp >= 0) { const v4u w = *(const v4u*)(SSM + ((size_t)b * S_ + sp) * SSMP + 512 + ch0);
            const f32x4 w0 = *(const f32x4*)(conv_w + j * 768 + ch0), w1 = *(const f32x4*)(conv_w + j * 768 + ch0 + 4);
            acc[0] += w0[0] * bf2f(w.x & 0xffffu); acc[1] += w0[1] * bf2f(w.x >> 16); acc[2] += w0[2] * bf2f(w.y & 0xffffu); acc[3] += w0[3] * bf2f(w.y >> 16);
            acc[4] += w1[0] * bf2f(w.z & 0xffffu); acc[5] += w1[1] * bf2f(w.z >> 16); acc[6] += w1[2] * bf2f(w.w & 0xffffu); acc[7] += w1[3] * bf2f(w.w >> 16); } }
#pragma unroll
    for (int i = 0; i < 8; ++i) out[i] = silu_f(acc[i]);
}
__device__ __forceinline__ void ssd_local_unit(const bf16* SSM, const float* SML, const float* conv_w, const float* conv_b, const float* a_log, float* SST, float* SDEC, LAS unsigned char* L8, int bg, int c, int tid, int wave, int lane) {
    LAS float* ACS = (LAS float*)L8; LAS float* DT = (LAS float*)(L8 + 1024); LAS float* AL4 = (LAS float*)(L8 + 2048); LAS bf16* XE = (LAS bf16*)(L8 + 2304); LAS bf16* BT = (LAS bf16*)(L8 + 39168);
    const int b = bg >> 1, g = bg & 1; const size_t row0 = (size_t)b * S_ + (size_t)c * 64;
    __syncthreads();
    ssd_acs(SML, a_log, ACS, DT, AL4, row0, g, wave, lane);
    __syncthreads();
#pragma unroll 1
    for (int it = tid; it < 64 * 40; it += NTHR) { const int t = it / 40, cg = it - t * 40; float v[8];
        if (cg < 32) { ssd_conv8(SSM, conv_w, conv_b, b, c * 64 + t, g * 256 + cg * 8, v); const int hh = cg >> 3, p0 = (cg & 7) * 8;
            const float sc = DT[t * 4 + hh] * __expf(AL4[hh] - ACS[t * 4 + hh]); LAS bf16* o = XE + (hh * 64 + p0) * mm::LD + t;
#pragma unroll
            for (int i = 0; i < 8; ++i) o[i * mm::LD] = (bf16)f2bf(v[i] * sc); }
        else { ssd_conv8(SSM, conv_w, conv_b, b, c * 64 + t, 512 + g * 64 + (cg - 32) * 8, v); LAS bf16* o = BT + ((cg - 32) * 8) * mm::LD + t;
#pragma unroll
            for (int i = 0; i < 8; ++i) o[i * mm::LD] = (bf16)f2bf(v[i]); } }
    if (tid < 4) SDEC[((size_t)(b * 8 + 4 * g + tid)) * 128 + c] = __expf(AL4[tid]);
    __syncthreads();
    const int hh = wave >> 1;
    f32x4 acc[2][4];
#pragma unroll
    for (int j = 0; j < 2; ++j)
#pragma unroll
        for (int n = 0; n < 4; ++n) acc[j][n] = (f32x4){0.f, 0.f, 0.f, 0.f};
#pragma unroll
    for (int kk = 0; kk < 64; kk += 32)
#pragma unroll
        for (int j = 0; j < 2; ++j) { const mm::bf16x8 yf = mm::frag(XE + hh * 64 * mm::LD, ((wave & 1) * 2 + j) * 16, kk, lane);
#pragma unroll
            for (int n = 0; n < 4; ++n) acc[j][n] = mm::mma(mm::frag(BT, n * 16, kk, lane), yf, acc[j][n]); }
    float* dst = SST + ((size_t)(b * 8 + 4 * g + hh) * 128 + c) * SST_CH + 4 * (lane >> 4);
#pragma unroll
    for (int j = 0; j < 2; ++j) { const int p = ((wave & 1) * 2 + j) * 16 + (lane & 15);
#pragma unroll
        for (int n = 0; n < 4; ++n) *(f32x4*)(dst + (size_t)p * 64 + n * 16) = acc[j][n]; }
}
__device__ __forceinline__ void ssd_out_unit(bf16* SSM, const float* SML, const float* conv_w, const float* conv_b, const float* a_log, const float* d_skip, const float* ssm_norm, const float* SST,
                                             LAS unsigned char* L8, int bg, int c, int tid, int wave, int lane) {
    LAS float* ACS = (LAS float*)L8; LAS float* DT = (LAS float*)(L8 + 1024); LAS float* AL4 = (LAS float*)(L8 + 2048); LAS bf16* XT = (LAS bf16*)(L8 + 2304);
    LAS bf16* BM = (LAS bf16*)(L8 + 39168); LAS bf16* CM = (LAS bf16*)(L8 + 48384); LAS bf16* SCL = (LAS bf16*)(L8 + 57600); LAS float* RED = (LAS float*)(L8 + 94464);
    const int b = bg >> 1, g = bg & 1; const size_t row0 = (size_t)b * S_ + (size_t)c * 64;
    __syncthreads();
    ssd_acs(SML, a_log, ACS, DT, AL4, row0, g, wave, lane);
#pragma unroll 1
    for (int it = tid; it < 64 * 48; it += NTHR) { const int t = it / 48, cg = it - t * 48; float v[8];
        if (cg < 32) { ssd_conv8(SSM, conv_w, conv_b, b, c * 64 + t, g * 256 + cg * 8, v); LAS bf16* o = XT + ((cg >> 3) * 64 + (cg & 7) * 8) * mm::LD + t;
#pragma unroll
            for (int i = 0; i < 8; ++i) o[i * mm::LD] = (bf16)f2bf(v[i]); }
        else { const bool isb = cg < 40; const int n0 = (cg - (isb ? 32 : 40)) * 8; ssd_conv8(SSM, conv_w, conv_b, b, c * 64 + t, (isb ? 512 : 640) + g * 64 + n0, v);
            v4u o; o.x = pk2(v[0], v[1]); o.y = pk2(v[2], v[3]); o.z = pk2(v[4], v[5]); o.w = pk2(v[6], v[7]); *(LAS v4u*)((isb ? BM : CM) + t * mm::LD + n0) = o; } }
    __syncthreads();
#pragma unroll
    for (int ii = 0; ii < 2; ++ii) { const int id = wave + 8 * ii, tt = id >> 2, st = id & 3;
        f32x4 a = (f32x4){0.f, 0.f, 0.f, 0.f};
        if (st <= tt) {
#pragma unroll
            for (int kk = 0; kk < 64; kk += 32) a = mm::mma(mm::frag(BM, st * 16, kk, lane), mm::frag(CM, tt * 16, kk, lane), a); }
        const int t = tt * 16 + (lane & 15), s0 = st * 16 + 4 * (lane >> 4);
#pragma unroll
        for (int hh = 0; hh < 4; ++hh) { const float at = ACS[t * 4 + hh]; float sc[4];
#pragma unroll
            for (int r = 0; r < 4; ++r) sc[r] = (s0 + r <= t) ? a[r] * __expf(at - ACS[(s0 + r) * 4 + hh]) * DT[(s0 + r) * 4 + hh] : 0.f;
            v2u w; w.x = pk2(sc[0], sc[1]); w.y = pk2(sc[2], sc[3]); *(LAS v2u*)(SCL + (hh * 64 + t) * mm::LD + s0) = w; } }
    __syncthreads();
    const int hh = wave >> 1, head = 4 * g + hh;
    const float* Sc = SST + ((size_t)(b * 8 + head) * 128 + c) * SST_CH;
    f32x4 acc[2][4];
#pragma unroll
    for (int j = 0; j < 2; ++j)
#pragma unroll
        for (int n = 0; n < 4; ++n) acc[j][n] = (f32x4){0.f, 0.f, 0.f, 0.f};
#pragma unroll
    for (int kk = 0; kk < 64; kk += 32) { mm::bf16x8 xf[4];
#pragma unroll
        for (int n = 0; n < 4; ++n) xf[n] = mm::frag_g(Sc, n * 16, kk, lane);
#pragma unroll
        for (int j = 0; j < 2; ++j) { const mm::bf16x8 yf = mm::frag(CM, ((wave & 1) * 2 + j) * 16, kk, lane);
#pragma unroll
            for (int n = 0; n < 4; ++n) acc[j][n] = mm::mma(xf[n], yf, acc[j][n]); } }
#pragma unroll
    for (int j = 0; j < 2; ++j) { const float e = __expf(ACS[(((wave & 1) * 2 + j) * 16 + (lane & 15)) * 4 + hh]);
#pragma unroll
        for (int n = 0; n < 4; ++n) acc[j][n] *= e; }
#pragma unroll
    for (int kk = 0; kk < 64; kk += 32)
#pragma unroll
        for (int j = 0; j < 2; ++j) { const mm::bf16x8 yf = mm::frag(SCL + hh * 64 * mm::LD, ((wave & 1) * 2 + j) * 16, kk, lane);
#pragma unroll
            for (int n = 0; n < 4; ++n) acc[j][n] = mm::mma(mm::frag(XT + hh * 64 * mm::LD, n * 16, kk, lane), yf, acc[j][n]); }
    const float Dk = d_skip[head];
#pragma unroll
    for (int j = 0; j < 2; ++j) { const int t = ((wave & 1) * 2 + j) * 16 + (lane & 15); float ss = 0.f;
#pragma unroll
        for (int n = 0; n < 4; ++n) { const int p = n * 16 + 4 * (lane >> 4); const v2u zz = *(const v2u*)(SSM + (row0 + t) * SSMP + head * 64 + p);
            const float zf[4] = {bf2f(zz.x & 0xffffu), bf2f(zz.x >> 16), bf2f(zz.y & 0xffffu), bf2f(zz.y >> 16)};
#pragma unroll
            for (int r = 0; r < 4; ++r) { const float xs = bf2f(XT[(hh * 64 + p + r) * mm::LD + t]); const float y = (acc[j][n][r] + Dk * xs) * silu_f(zf[r]); acc[j][n][r] = y; ss += y * y; } }
        ss += __shfl_xor(ss, 16); ss += __shfl_xor(ss, 32);
        if (lane < 16) RED[hh * 64 + t] = ss; }
    __syncthreads();
#pragma unroll
    for (int j = 0; j < 2; ++j) { const int t = ((wave & 1) * 2 + j) * 16 + (lane & 15);
        const float rs = rsqrtf(((RED[t] + RED[64 + t]) + (RED[128 + t] + RED[192 + t])) * (1.f / 256.f) + EPS);
#pragma unroll
        for (int n = 0; n < 4; ++n) { const int p = n * 16 + 4 * (lane >> 4); const f32x4 gn = *(const f32x4*)(ssm_norm + g * 256 + hh * 64 + p);
            v2u o; o.x = pk2(acc[j][n][0] * rs * gn[0], acc[j][n][1] * rs * gn[1]); o.y = pk2(acc[j][n][2] * rs * gn[2], acc[j][n][3] * rs * gn[3]);
            *(v2u*)(SSM + (row0 + t) * SSMP + head * 64 + p) = o; } }
}
__device__ __forceinline__ void ph_scan(float* GST, const float* GDEC, float* SST, const float* SDEC, int tid) {
    asm volatile("" : "+v"(tid));
    for (int e = blockIdx.x * NTHR + tid; e < 131072; e += gridDim.x * NTHR) {
        const bool isg = e < 65536; const int ee = isg ? e : e - 65536;
        const int bh = isg ? (ee >> 13) : (ee >> 12), el = isg ? (ee & 8191) : (ee & 4095), chs = isg ? GST_CH : SST_CH;
        float* base = (isg ? GST : SST) + (size_t)bh * 128 * chs + el; const float* dec = isg ? GDEC + (size_t)bh * 128 * 64 + (el & 63) : SDEC + (size_t)bh * 128; const int dst = isg ? 64 : 1;
        float S = 0.f;
#pragma unroll 1
        for (int c0 = 0; c0 < 128; c0 += 8) { float kv[8], dc[8];
#pragma unroll
            for (int i = 0; i < 8; ++i) { kv[i] = base[(size_t)(c0 + i) * chs]; dc[i] = dec[(size_t)(c0 + i) * dst]; }
#pragma unroll
            for (int i = 0; i < 8; ++i) { base[(size_t)(c0 + i) * chs] = S; S = dc[i] * S + kv[i]; } }
    }
}
__device__ __forceinline__ void ph_local(const float* SML, float* CUM, const bf16* GLA, const bf16* SSM, const float* w_lr, const float* b_gate, const float* conv_w, const float* conv_b, const float* a_log,
                                         float* GST, float* GDEC, float* SST, float* SDEC, LAS unsigned char* L8, int tid, int wave, int lane) {
    asm volatile("" : "+v"(tid), "+s"(wave), "+v"(lane));
    for (int u = blockIdx.x; u < 1024 + 512; u += gridDim.x) {
        if (u < 1024) gla_local_unit(GLA, SML, w_lr, b_gate, GST, GDEC, L8, u >> 7, u & 127, tid, wave, lane);
        else ssd_local_unit(SSM, SML, conv_w, conv_b, a_log, SST, SDEC, L8, (u - 1024) >> 7, (u - 1024) & 127, tid, wave, lane);
    }
}
__device__ __forceinline__ void ph_mixout(bf16* GLA, bf16* SSM, const float* SML, const float* w_lr, const float* b_gate, const float* gla_norm, const float* conv_w, const float* conv_b, const float* a_log, const float* d_skip,
                                          const float* ssm_norm, const float* GST, const float* SST, LAS unsigned char* L8, int tid, int wave, int lane) {
    asm volatile("" : "+v"(tid), "+s"(wave), "+v"(lane));
    for (int u = blockIdx.x; u < 1024 + 512; u += gridDim.x) {
        if (u < 1024) gla_out_unit(GLA, SML, w_lr, b_gate, GST, gla_norm, L8, u >> 7, u & 127, tid, wave, lane);
        else ssd_out_unit(SSM, SML, conv_w, conv_b, a_log, d_skip, ssm_norm, SST, L8, (u - 1024) >> 7, (u - 1024) & 127, tid, wave, lane);
    }
}

namespace attn_body {
using bf16=__hip_bfloat16;
using bf16x8=__attribute__((ext_vector_type(8)))short;
using s16x4=__attribute__((ext_vector_type(4)))short;
using f32x16=__attribute__((ext_vector_type(16)))float;
using u32x4=__attribute__((ext_vector_type(4)))unsigned;
using f32x4g=__attribute__((ext_vector_type(4)))float;
constexpr int BATCH=2,NHEAD=8,SEQ=8192,D=64,PITCH=1536;
constexpr int NW=8,QBLK=32,QB=QBLK*NW,KVBLK=64,NQB=SEQ/QB;
constexpr int ATTN_PITCH=PITCH, ATTN_UNIT_ROWS=QB;
__device__ __forceinline__ int crow(int r,int hi){return (r&3)+8*(r>>2)+4*hi;}
#define SBAR() __builtin_amdgcn_sched_barrier(0)
__device__ __forceinline__ void cmask(f32x16&p0,f32x16&p1,int jb,int qrel,int hi){
  const float NEG=-INFINITY; int kb=64*jb+4*hi;
  #pragma unroll
  for(int r=0;r<16;++r){int kv=kb+(r&3)+8*(r>>2); if(kv>qrel)p0[r]=NEG; if(kv+32>qrel)p1[r]=NEG;}
}

constexpr int NSLOT=3, SLOTB=8192;
constexpr int LDS_K=0, LDS_V=NSLOT*SLOTB, LDS_WS=2*NSLOT*SLOTB, LDS_OST=LDS_WS+NW*64*4, LDS_C=LDS_OST+NW*4096, LDS_BYTES=LDS_C+SEQ*4;
constexpr float C2=0.125f*1.4426950408889634f;
__device__ __forceinline__ void glds16(const void*gsrc,unsigned lds_dst){unsigned keep;
  asm volatile("s_mov_b32 %0, m0\n\ts_mov_b32 m0, %2\n\ts_nop 0\n\tglobal_load_lds_dwordx4 %1, off\n\ts_mov_b32 m0, %0":"=&s"(keep):"v"(gsrc),"s"(lds_dst):"memory");}
__device__ __forceinline__ float max3f(float a,float b,float c){float r;asm("v_max3_f32 %0, %1, %2, %3":"=v"(r):"v"(a),"v"(b),"v"(c));return r;}
__device__ __forceinline__ float max2f(float a,float b){float r;asm("v_max_f32_e32 %0, %1, %2":"=v"(r):"v"(a),"v"(b));return r;}
__device__ __forceinline__ float fadd_s(float a,float b){float r;asm("v_add_f32_e32 %0, %1, %2":"=v"(r):"v"(a),"v"(b));return r;}
__device__ __forceinline__ float fsub_s(float a,float b){float r;asm("v_sub_f32_e32 %0, %1, %2":"=v"(r):"v"(a),"v"(b));return r;}
typedef float f32x2_t __attribute__((ext_vector_type(2))); typedef __bf16 bf16x2_t __attribute__((ext_vector_type(2)));
__device__ __forceinline__ unsigned cvtpk_s(float lo,float hi){f32x2_t v={lo,hi};bf16x2_t b=__builtin_convertvector(v,bf16x2_t);return __builtin_bit_cast(unsigned,b);}
#define WAIT_BAR(N) asm volatile("s_waitcnt vmcnt(" #N ") lgkmcnt(0)\n\ts_barrier":::"memory")

__device__ __forceinline__ void qkt(f32x16&p0,f32x16&p1,const char*Kslot,const bf16x8*qr,int r32,int hi){
  const char*kb=Kslot+hi*1024+r32*16;
  #pragma unroll
  for(int d0=0;d0<4;++d0){
    const bf16x8 b0=*reinterpret_cast<const bf16x8*>(kb+d0*2048);
    const bf16x8 b1=*reinterpret_cast<const bf16x8*>(kb+d0*2048+512);
    {p0=__builtin_amdgcn_mfma_f32_32x32x16_bf16(b0,qr[d0],p0,0,0,0);p1=__builtin_amdgcn_mfma_f32_32x32x16_bf16(b1,qr[d0],p1,0,0,0);}}
}
typedef __attribute__((address_space(3))) const char* lds_cptr;
typedef short v4i16_t __attribute__((ext_vector_type(4)));
__device__ __forceinline__ void kload8(bf16x8*kf,lds_cptr kp){
  kf[0]=*(const __attribute__((address_space(3))) bf16x8*)(kp);      kf[1]=*(const __attribute__((address_space(3))) bf16x8*)(kp+512);
  kf[2]=*(const __attribute__((address_space(3))) bf16x8*)(kp+2048); kf[3]=*(const __attribute__((address_space(3))) bf16x8*)(kp+2560);
  kf[4]=*(const __attribute__((address_space(3))) bf16x8*)(kp+4096); kf[5]=*(const __attribute__((address_space(3))) bf16x8*)(kp+4608);
  kf[6]=*(const __attribute__((address_space(3))) bf16x8*)(kp+6144); kf[7]=*(const __attribute__((address_space(3))) bf16x8*)(kp+6656);
}
__device__ __forceinline__ void kload2(bf16x8*kf,lds_cptr kp,int j){ kf[2*j]=*(const __attribute__((address_space(3))) bf16x8*)(kp+j*2048); kf[2*j+1]=*(const __attribute__((address_space(3))) bf16x8*)(kp+j*2048+512); }
__device__ __forceinline__ s16x4 vtr(lds_cptr p){ return __builtin_bit_cast(s16x4,__builtin_amdgcn_ds_read_tr16_b64_v4i16((__attribute__((address_space(3))) v4i16_t*)p)); }
__device__ __forceinline__ float rowmax(const f32x16&p0,const f32x16&p1){
  float a=max3f(p0[0],p0[1],p1[0]),b=max3f(p0[2],p0[3],p1[1]);a=max3f(a,p1[2],p1[3]);
  #pragma unroll
  for(int r=4;r<16;r+=4){a=max3f(a,p0[r],p0[r+1]);b=max3f(b,p0[r+2],p0[r+3]);a=max3f(a,p1[r],p1[r+1]);b=max3f(b,p1[r+2],p1[r+3]);}
  const float m=max2f(a,b);
  auto rr=__builtin_amdgcn_permlane32_swap(__float_as_uint(m),__float_as_uint(m),false,false);
  return max2f(__uint_as_float(rr[0]),__uint_as_float(rr[1]));
}
__device__ __forceinline__ void pv(f32x16*o,int vb,bf16x8 pa0,bf16x8 pa1,bf16x8 pa2,bf16x8 pa3){
  #pragma unroll
  for(int d0=0;d0<2;++d0){s16x4 lo[4],hi[4];
    #pragma unroll
    for(int ks=0;ks<4;++ks){
      asm volatile("ds_read_b64_tr_b16 %0,%1 offset:%c2":"=&v"(lo[ks]):"v"(vb),"i"(d0*4096+ks*1024):"memory");
      asm volatile("ds_read_b64_tr_b16 %0,%1 offset:%c2":"=&v"(hi[ks]):"v"(vb),"i"(d0*4096+ks*1024+512):"memory");}
    asm volatile("s_waitcnt lgkmcnt(0)":::"memory");SBAR();
    #define PK(k) (bf16x8){lo[k][0],lo[k][1],lo[k][2],lo[k][3],hi[k][0],hi[k][1],hi[k][2],hi[k][3]}
    o[d0]=__builtin_amdgcn_mfma_f32_32x32x16_bf16(pa0,PK(0),o[d0],0,0,0);
    o[d0]=__builtin_amdgcn_mfma_f32_32x32x16_bf16(pa1,PK(1),o[d0],0,0,0);
    o[d0]=__builtin_amdgcn_mfma_f32_32x32x16_bf16(pa2,PK(2),o[d0],0,0,0);
    o[d0]=__builtin_amdgcn_mfma_f32_32x32x16_bf16(pa3,PK(3),o[d0],0,0,0);
    #undef PK
  }
}

#ifndef ATTN_STORE16
#define ATTN_STORE16(p,v) (*(u32x4*)(p)=(v))
#endif
template<int THRL> __device__ __forceinline__ void attn_unit(int b,int h,int qb,const bf16*Q,const bf16*__restrict__ K,const bf16*__restrict__ V,bf16*O,const float*cum,float M0,char*shm){
  int tid=threadIdx.x; asm volatile("":"+v"(tid));
  const int lane=tid&63,r32=lane&31,hi=lane>>5; const int wid=__builtin_amdgcn_readfirstlane(tid>>6);
  const long rowbase=(long)b*SEQ; const int q0=qb*QB;
  const bf16*Qw=Q+(rowbase+q0+wid*QBLK)*PITCH+h*D;
  const bf16*Kh=K+rowbase*PITCH+h*D,*Vh=V+rowbase*PITCH+h*D;
  const unsigned lds0=(unsigned)(uintptr_t)shm;
  float*wsf=(float*)(shm+LDS_WS)+wid*64;
  const bf16*ksrc=Kh+(long)lane*PITCH+wid*8;
  const bf16*vsrc=Vh+(long)(16*(wid&3)+(lane>>2))*PITCH+(wid>>2)*32+(lane&3)*8;
  const unsigned kdst=lds0+LDS_K+wid*1024, vdst=lds0+LDS_V+wid*1024;
  #define DMA_K(t,slot) glds16(ksrc+(long)(t)*KVBLK*PITCH,(unsigned)__builtin_amdgcn_readfirstlane(kdst+(slot)))
  #define DMA_V(t,slot) glds16(vsrc+(long)(t)*KVBLK*PITCH,(unsigned)__builtin_amdgcn_readfirstlane(vdst+(slot)))
  const int vb0=(int)(lds0+LDS_V)+((lane>>4)&1)*32+(lane&3)*8+(4*hi+((lane&15)>>2))*64;
  const char*Kbase=shm+LDS_K; bf16x8 kf[8];
  const lds_cptr shm3=(lds_cptr)shm; const lds_cptr kp0=shm3+LDS_K+hi*1024+r32*16; const lds_cptr vp0=shm3+LDS_V+((lane>>4)&1)*32+(lane&3)*8+(4*hi+((lane&15)>>2))*64;
  const int NT=(q0+QB)/KVBLK;
  const float*chp=cum+((long)b*NHEAD+h)*SEQ;
  { const f32x4g*src4=(const f32x4g*)chp; __attribute__((address_space(3))) f32x4g*dst4=(__attribute__((address_space(3))) f32x4g*)(shm3+LDS_C);
    for(int i=tid;i<NT*16;i+=NW*64)dst4[i]=src4[i]; }
  const float cqm=chp[q0+wid*QBLK+r32]-M0;
  asm volatile("s_waitcnt vmcnt(0) lgkmcnt(0)":::"memory");
  const lds_cptr cb0=shm3+LDS_C+hi*16;
  #define CBIAS(C0,C1,t) do{ const lds_cptr cp_=cb0+(t)*256; \
    _Pragma("unroll") for(int j_=0;j_<4;++j_){ const f32x4g c_=*(const __attribute__((address_space(3))) f32x4g*)(cp_+j_*32); \
      C0[4*j_]=cqm-c_[0];C0[4*j_+1]=cqm-c_[1];C0[4*j_+2]=cqm-c_[2];C0[4*j_+3]=cqm-c_[3]; } \
    _Pragma("unroll") for(int j_=0;j_<4;++j_){ const f32x4g c_=*(const __attribute__((address_space(3))) f32x4g*)(cp_+128+j_*32); \
      C1[4*j_]=cqm-c_[0];C1[4*j_+1]=cqm-c_[1];C1[4*j_+2]=cqm-c_[2];C1[4*j_+3]=cqm-c_[3]; } }while(0)
  DMA_K(0,0);DMA_V(0,0);DMA_K(1,SLOTB);
  bf16x8 qr[4];
  #pragma unroll
  for(int d0=0;d0<4;++d0)qr[d0]=*reinterpret_cast<const bf16x8*>(&Qw[(long)r32*PITCH+d0*16+hi*8]);
  float l_reg=0.f;f32x16 o[2];o[0]=f32x16{};o[1]=f32x16{};
  const int qrel=wid*QBLK+r32;
  #define CMASK(P0,P1,t) do{int jb_=(t)-(NT-4); if(jb_>=0)cmask(P0,P1,jb_,qrel,hi);}while(0)
  f32x16 pA0,pA1,pB0,pB1;
  int sl_prev=0,sl_cur=0,sl_next=SLOTB;
  #define ROT() do{sl_prev=sl_cur;sl_cur=sl_next;sl_next=(sl_next==(NSLOT-1)*SLOTB)?0:sl_next+SLOTB;}while(0)
  DMA_K(2,2*SLOTB);
  WAIT_BAR(3);
  CBIAS(pA0,pA1,0);
  qkt(pA0,pA1,Kbase,qr,r32,hi);CMASK(pA0,pA1,0);
  _Pragma("unroll") for(int r=0;r<16;++r){pA0[r]=__builtin_amdgcn_exp2f(pA0[r]);pA1[r]=__builtin_amdgcn_exp2f(pA1[r]);}
  WAIT_BAR(0);
  DMA_K(3,0);DMA_V(1,SLOTB);
  ROT();
  kload8(kf,kp0+sl_cur);
  WAIT_BAR(2);
  s16x4 vlo[8],vhi[8]; u32x4 pw0,pw1,pw2,pw3;
  #define PKW(P,B) cvtpk_s(P[B],P[B+1])
  #define PAF(k) __builtin_bit_cast(bf16x8,pw##k)
  #define VFR(i) (bf16x8){vlo[i][0],vlo[i][1],vlo[i][2],vlo[i][3],vhi[i][0],vhi[i][1],vhi[i][2],vhi[i][3]}
  #define PIN(x) asm volatile("":"+v"(x))
  #define MX3(a,b,c) __builtin_fmaxf(__builtin_fmaxf((a),(b)),(c))
  #define GAPA(MF,A0,A1,A2,A3,W0,W1,PW) do{ MF; sacc+=A0; sacc+=A1; sacc+=A2; sacc+=A3; PIN(sacc); W0; W1; PIN(PW); SBAR(); }while(0)
  #define EX(v) __builtin_amdgcn_exp2f(v)
  #define GAPB(MF,X,B) do{ MF; X[B]=EX(X[B]); X[B+1]=EX(X[B+1]); X[B+2]=EX(X[B+2]); X[B+3]=EX(X[B+3]); PIN(X); SBAR(); }while(0)
  #define VRD(i) do{ vlo[i]=vtr(vp_+(((i)>>2)*4096+((i)&3)*1024)); vhi[i]=vtr(vp_+(((i)>>2)*4096+((i)&3)*1024+512)); }while(0)
  #define KRD(G,j) do{ if(G){ kload2(kf,kp0+sl_next,j); SBAR(); } }while(0)
  #define STEP(C0,C1,P0,P1,t,GK,GV,GL) do{ SBAR(); \
    CBIAS(C0,C1,t); SBAR(); \
    const lds_cptr vp_=vp0+sl_prev; \
    VRD(0); SBAR(); float sacc=(P0[0]+P0[1]); \
    GAPA(C0=__builtin_amdgcn_mfma_f32_32x32x16_bf16(kf[0],qr[0],C0,0,0,0), P0[2],P0[3],P0[4],P0[5],     pw0[0]=PKW(P0,0), pw0[1]=PKW(P0,2), pw0); \
    VRD(4); SBAR(); GAPA(C1=__builtin_amdgcn_mfma_f32_32x32x16_bf16(kf[1],qr[0],C1,0,0,0), P0[6],P0[7],P0[8],P0[9],     pw0[2]=PKW(P0,4), pw0[3]=PKW(P0,6), pw0); \
    VRD(1); SBAR(); GAPA(C0=__builtin_amdgcn_mfma_f32_32x32x16_bf16(kf[2],qr[1],C0,0,0,0),   P0[10],P0[11],P0[12],P0[13], pw1[0]=PKW(P0,8), pw1[1]=PKW(P0,10), pw1); \
    VRD(5); SBAR(); GAPA(C1=__builtin_amdgcn_mfma_f32_32x32x16_bf16(kf[3],qr[1],C1,0,0,0),   P0[14],P0[15],P1[0],P1[1],   pw1[2]=PKW(P0,12),pw1[3]=PKW(P0,14), pw1); \
    VRD(2); SBAR(); GAPA(C0=__builtin_amdgcn_mfma_f32_32x32x16_bf16(kf[4],qr[2],C0,0,0,0),   P1[2],P1[3],P1[4],P1[5],     pw2[0]=PKW(P1,0), pw2[1]=PKW(P1,2), pw2); \
    VRD(6); SBAR(); GAPA(C1=__builtin_amdgcn_mfma_f32_32x32x16_bf16(kf[5],qr[2],C1,0,0,0),   P1[6],P1[7],P1[8],P1[9],     pw2[2]=PKW(P1,4), pw2[3]=PKW(P1,6), pw2); \
    VRD(3); SBAR(); GAPA(C0=__builtin_amdgcn_mfma_f32_32x32x16_bf16(kf[6],qr[3],C0,0,0,0),   P1[10],P1[11],P1[12],P1[13], pw3[0]=PKW(P1,8), pw3[1]=PKW(P1,10), pw3); \
    VRD(7); SBAR(); GAPA(C1=__builtin_amdgcn_mfma_f32_32x32x16_bf16(kf[7],qr[3],C1,0,0,0),   P1[14],P1[15],0.f,0.f,       pw3[2]=PKW(P1,12),pw3[3]=PKW(P1,14), pw3); \
    l_reg+=sacc; \
    if(GK){DMA_K((t)+3,sl_cur);} if(GV){DMA_V((t)+1,sl_next);} \
    CMASK(C0,C1,t); \
    SBAR(); \
    GAPB(o[0]=__builtin_amdgcn_mfma_f32_32x32x16_bf16(PAF(0),VFR(0),o[0],0,0,0), C0,0); \
    GAPB(o[1]=__builtin_amdgcn_mfma_f32_32x32x16_bf16(PAF(0),VFR(4),o[1],0,0,0), C0,4); \
    KRD(GL,0); GAPB(o[0]=__builtin_amdgcn_mfma_f32_32x32x16_bf16(PAF(1),VFR(1),o[0],0,0,0), C0,8); \
    KRD(GL,1); GAPB(o[1]=__builtin_amdgcn_mfma_f32_32x32x16_bf16(PAF(1),VFR(5),o[1],0,0,0), C0,12); \
    KRD(GL,2); GAPB(o[0]=__builtin_amdgcn_mfma_f32_32x32x16_bf16(PAF(2),VFR(2),o[0],0,0,0), C1,0); \
    KRD(GL,3); GAPB(o[1]=__builtin_amdgcn_mfma_f32_32x32x16_bf16(PAF(2),VFR(6),o[1],0,0,0), C1,4); \
    GAPB(o[0]=__builtin_amdgcn_mfma_f32_32x32x16_bf16(PAF(3),VFR(3),o[0],0,0,0), C1,8); \
    GAPB(o[1]=__builtin_amdgcn_mfma_f32_32x32x16_bf16(PAF(3),VFR(7),o[1],0,0,0), C1,12); \
    }while(0)
  int t=1;
  #undef CMASK
  #define CMASK(P0,P1,t) do{}while(0)
  for(;t+5<NT;t+=2){
    STEP(pB0,pB1,pA0,pA1,t,true,true,true);     WAIT_BAR(2); ROT();
    STEP(pA0,pA1,pB0,pB1,t+1,true,true,true);   WAIT_BAR(2); ROT();
  }
  #undef CMASK
  #define CMASK(P0,P1,t) do{int jb_=(t)-(NT-4); if(jb_>=0)cmask(P0,P1,jb_,qrel,hi);}while(0)
  #define ENDW(tt) do{ if((tt)+3<NT){WAIT_BAR(2);} else if((tt)+2<NT){WAIT_BAR(1);} else {WAIT_BAR(0);} }while(0)
  for(;t+1<NT;t+=2){
    STEP(pB0,pB1,pA0,pA1,t,(t+3<NT),(t+1<NT),(t+1<NT));       ENDW(t);   ROT();
    STEP(pA0,pA1,pB0,pB1,t+1,(t+4<NT),(t+2<NT),(t+2<NT));     ENDW(t+1); ROT();
  }
  STEP(pB0,pB1,pA0,pA1,NT-1,false,false,false);
  { float sacc=pB0[0]+pB0[1]; _Pragma("unroll") for(int r=2;r<16;++r)sacc+=pB0[r]; _Pragma("unroll") for(int r=0;r<16;++r)sacc+=pB1[r]; l_reg+=sacc;
    pw0=(u32x4){PKW(pB0,0),PKW(pB0,2),PKW(pB0,4),PKW(pB0,6)};pw1=(u32x4){PKW(pB0,8),PKW(pB0,10),PKW(pB0,12),PKW(pB0,14)};pw2=(u32x4){PKW(pB1,0),PKW(pB1,2),PKW(pB1,4),PKW(pB1,6)};pw3=(u32x4){PKW(pB1,8),PKW(pB1,10),PKW(pB1,12),PKW(pB1,14)};
    SBAR(); pv(o,vb0+sl_cur,PAF(0),PAF(1),PAF(2),PAF(3)); }
  #undef PKW
  #undef PAF
  #undef VFR
  #undef PIN
  #undef MX3
  #undef GAPA
  #undef GAPB
  #undef EX
  #undef VRD
  #undef KRD
  #undef STEP
  #undef ENDW
  {auto rr=__builtin_amdgcn_permlane32_swap(__float_as_uint(l_reg),__float_as_uint(l_reg),false,false);l_reg=__uint_as_float(rr[0])+__uint_as_float(rr[1]);}
  if(hi==0)wsf[32+r32]=l_reg;asm volatile("s_waitcnt lgkmcnt(0)":::"memory");
  float rli[16];
  #pragma unroll
  for(int r=0;r<16;++r)rli[r]=__builtin_amdgcn_rcpf(wsf[32+crow(r,hi)]);
  bf16*Ow=O+(rowbase+q0+wid*QBLK)*PITCH+h*D;
  { bf16*stg=(bf16*)(shm+LDS_OST)+wid*2048;
    #pragma unroll
    for(int r=0;r<16;++r){const int orow=crow(r,hi);
      #pragma unroll
      for(int d0=0;d0<2;++d0)stg[orow*64+d0*32+r32]=__float2bfloat16(o[d0][r]*rli[r]);}
    asm volatile("s_waitcnt lgkmcnt(0)":::"memory");
    #pragma unroll
    for(int i=0;i<4;++i){const int row=i*8+(lane>>3),ch=lane&7; const u32x4 v=*(const u32x4*)(stg+row*64+ch*8); ATTN_STORE16(Ow+(long)row*PITCH+ch*8,v);} }
  asm volatile("s_waitcnt lgkmcnt(0)\n\ts_barrier":::"memory");
  #undef DMA_K
  #undef DMA_V
  #undef CMASK
  #undef CBIAS
  #undef ROT
}
constexpr int ATTN_LDS_BYTES=LDS_BYTES;
struct AttnTensors { const bf16* Q; const bf16* K; const bf16* V; bf16* O; const float* cum; float M0; };
struct AttnUnit { int bh; int qb; };
struct PairOrder {
  int vcu,G;
  __device__ __forceinline__ bool next(int i,AttnUnit&u)const{ const int p=vcu+(i>>1)*G; if(p>=256)return false; const int s=p&15; u.bh=p>>4; u.qb=(i&1)?s:31-s; return true; }
};
template<class Sched> __device__ __forceinline__ void attn_phase(char*lds,const AttnTensors&T,const Sched&S){
  AttnUnit u;
  for(int i=0;S.next(i,u);++i){ attn_unit<0>(u.bh/NHEAD,u.bh%NHEAD,u.qb,T.Q,T.K,T.V,T.O,T.cum,T.M0,lds); }
}
#undef SBAR
#undef WAIT_BAR
}
constexpr int NPH = FAST_MOE ? 11 : 9;
struct Args { const float* in[26]; float* out; unsigned char* ws; int ph_lo, ph_hi; };
__global__ void __launch_bounds__(NTHR, 2) mega(Args a) {
    extern __shared__ __attribute__((aligned(16))) unsigned char lds[];
    const int tid = threadIdx.x, lane = tid & 63, wave = __builtin_amdgcn_readfirstlane(tid >> 6);
    LAS unsigned char* L8 = (LAS unsigned char*)lds;
    LAS float* L = (LAS float*)lds;
    volatile LAS unsigned* MISC = (volatile LAS unsigned*)(L8 + MISC_OFF);
    for (int u = tid; u < (LDS_BYTES - LDSCTL_OFF) / 4; u += NTHR) ((LAS unsigned*)(L8 + LDSCTL_OFF))[u] = 0u;
    __syncthreads();
    unsigned char* ws = a.ws;
    unsigned* ctl = (unsigned*)(ws + WS_CTL);
    XcdBarrier bar; bar.bar = ctl + CW_BAR; bar.x = 0; bar.st = nullptr;
    if (!MK_SPLIT) bar = xcd_barrier_post(ctl + CW_BAR, MISC + 8);
#define WIN   ((bf16*)(opq(ws) + WS_WIN))
#define WBR   ((bf16*)(opq(ws) + WS_WBR))
#define WOUT  ((bf16*)(opq(ws) + WS_WOUT))
#define HB    ((bf16*)(opq(ws) + WS_HB))
#define FOX   ((bf16*)(opq(ws) + WS_FOX))
#define GLA   ((bf16*)(opq(ws) + WS_GLA))
#define SSM   ((bf16*)(opq(ws) + WS_SSM))
#define SML   ((float*)(opq(ws) + WS_SML))
#define CUM   ((float*)(opq(ws) + WS_CUM))
#define TOKE  ((int*)(opq(ws) + WS_TOKE))
#define TOKW  ((float*)(opq(ws) + WS_TOKW))
#define GATES ((bf16*)(opq(ws) + WS_GATES))
#define LRANK ((int*)(opq(ws) + WS_LRANK))
#define ROWTOK ((int*)(opq(ws) + WS_ROWTOK))
#define ROWW  ((float*)(opq(ws) + WS_ROWW))
#define CNTBLK ((int*)(opq(ws) + WS_CNTBLK))
#define W1E   ((bf16*)(opq(ws) + WS_W1E))
#define WDE   ((bf16*)(opq(ws) + WS_WDE))
#define HID   ((bf16*)(opq(ws) + WS_HID))
#define HS    ((bf16*)(opq(ws) + WS_HS))
#define GST   ((float*)(opq(ws) + WS_GST))
#define SST   ((float*)(opq(ws) + WS_SST))
#define GDEC  ((float*)(opq(ws) + WS_GDEC))
#define SDEC  ((float*)(opq(ws) + WS_SDEC))
    const int lo = a.ph_lo, hi = a.ph_hi;
#define IN(k) (lo <= (k) && (k) < hi)
#define SEAM(k) do { if (IN(k) && IN((k) + 1)) xcd_barrier(bar); } while (0)
    for (int l = 0; l < NLAYER; ++l) {
        const int pb = l * NPH;
        const float* xin = (l == 0) ? ((const float*)(const GAS float*)a.in[0]) : ((float*)(GAS float*)a.out);
        if (IN(pb + 0)) { ph_norm(xin, ((const float*)(const GAS float*)a.in[1]) + l * D_, HB, wave, lane);
            convert_small_weights(((const float*)(const GAS float*)a.in[2]) + (size_t)l * D_ * INC, ((const float*)(const GAS float*)a.in[15]) + (size_t)l * 3 * 512 * 1024, ((const float*)(const GAS float*)a.in[17]) + (size_t)l * D_ * D_, WIN, WBR, WOUT, L + wave * 2112, wave, lane); }
        SEAM(pb + 0);
        if (IN(pb + 1)) {
#if FAST_INPROJ
#if DUAL_INPROJ
            ph_inproj_simple(HB, ((const float*)(const GAS float*)a.in[2]) + (size_t)l * D_ * INC, ((const float*)(const GAS float*)a.in[3]) + l * 8, ((const float*)(const GAS float*)a.in[4]) + l * 64, ((const float*)(const GAS float*)a.in[5]) + l * 64, ((const float*)(const GAS float*)a.in[11]) + l * 8, ((const float*)(const GAS float*)a.in[16]) + l * 3072, FOX, GLA, SSM, SML, GATES, tid);
            xcd_barrier(bar);
#endif
            pg8::GridOrder S; S.init(T_, 7680, (int)gridDim.x, (int)blockIdx.x, HB, 1024, WIN, 1024);
            pg8::EpiInproj E{FOX, GLA, SSM, SML, GATES, ((const float*)(const GAS float*)a.in[4]) + l * 64, ((const float*)(const GAS float*)a.in[5]) + l * 64, ((const float*)(const GAS float*)a.in[3]) + l * 8, ((const float*)(const GAS float*)a.in[11]) + l * 8, ((const float*)(const GAS float*)a.in[16]) + l * 3072};
            pg8::gemm_phase(L8, 1024, 1024, S, E);
#else
            ph_inproj_simple(HB, ((const float*)(const GAS float*)a.in[2]) + (size_t)l * D_ * INC, ((const float*)(const GAS float*)a.in[3]) + l * 8, ((const float*)(const GAS float*)a.in[4]) + l * 64, ((const float*)(const GAS float*)a.in[5]) + l * 64, ((const float*)(const GAS float*)a.in[11]) + l * 8, ((const float*)(const GAS float*)a.in[16]) + l * 3072, FOX, GLA, SSM, SML, GATES, tid);
#endif
        }
        SEAM(pb + 1);
        if (IN(pb + 2)) { ph_cumsum(SML, CUM, L, tid);
#if FAST_MIX
            ph_local(SML, CUM, GLA, SSM, ((const float*)(const GAS float*)a.in[6]) + l * 16 * 256, ((const float*)(const GAS float*)a.in[7]) + l * 256, ((const float*)(const GAS float*)a.in[9]) + l * 4 * 768, ((const float*)(const GAS float*)a.in[10]) + l * 768, ((const float*)(const GAS float*)a.in[12]) + l * 8, GST, GDEC, SST, SDEC, L8, tid, wave, lane);
#endif
        }
        SEAM(pb + 2);
        if (IN(pb + 3)) {
#if FAST_MIX
            ph_scan(GST, GDEC, SST, SDEC, tid);
#else
            ph_mix_simple(FOX, CUM, GLA, SSM, SML, ((const float*)(const GAS float*)a.in[6]) + l * 16 * 256, ((const float*)(const GAS float*)a.in[7]) + l * 256, ((const float*)(const GAS float*)a.in[9]) + l * 4 * 768, ((const float*)(const GAS float*)a.in[10]) + l * 768, ((const float*)(const GAS float*)a.in[12]) + l * 8, ((const float*)(const GAS float*)a.in[13]) + l * 8, L, tid, wave, lane);
#endif
#if FAST_ATTN
            { const float gq = ((const float*)(const GAS float*)a.in[4])[l * 64 + lane], gk = ((const float*)(const GAS float*)a.in[5])[l * 64 + lane];
              float gm = fabsf(gq * gk);
#pragma unroll
              for (int o = 1; o < 64; o <<= 1) gm = fmaxf(gm, __shfl_xor(gm, o));
              const float M0 = 8.f * LOG2E * 1.01f * gm;
              const attn_body::AttnTensors AT{(const attn_body::bf16*)FOX, (const attn_body::bf16*)(FOX + 512), (const attn_body::bf16*)(FOX + 1024), (attn_body::bf16*)FOX, CUM, M0};
              const int G = (int)gridDim.x, bx = (int)blockIdx.x;
              const attn_body::PairOrder S{(G % 8 == 0) ? (bx % 8) * (G / 8) + bx / 8 : bx, G};
              attn_body::attn_phase((char*)lds, AT, S); }
#endif
        }
        SEAM(pb + 3);
        if (IN(pb + 4)) {
#if FAST_MIX
            ph_mixout(GLA, SSM, SML, ((const float*)(const GAS float*)a.in[6]) + l * 16 * 256, ((const float*)(const GAS float*)a.in[7]) + l * 256, ((const float*)(const GAS float*)a.in[8]) + l * 128, ((const float*)(const GAS float*)a.in[9]) + l * 4 * 768, ((const float*)(const GAS float*)a.in[10]) + l * 768, ((const float*)(const GAS float*)a.in[12]) + l * 8, ((const float*)(const GAS float*)a.in[13]) + l * 8, ((const float*)(const GAS float*)a.in[14]) + l * 512, GST, SST, L8, tid, wave, lane);
#else
            ph_post(GLA, SSM, ((const float*)(const GAS float*)a.in[8]) + l * 128, ((const float*)(const GAS float*)a.in[14]) + l * 512, wave, lane);
#endif
        }
        SEAM(pb + 4);
        if (IN(pb + 5)) {
#if FAST_MERGE
            pg8::MergeOrder S{(int)gridDim.x, (int)blockIdx.x, (const char*)opq(ws), (const char*)WBR};
            pg8::EpiMerge E{GATES, FOX + 512};
            pg8::gemm_phase(L8, 512, 1536, S, E);
#else
            ph_merge_simple(FOX, GLA, SSM, GATES, ((const float*)(const GAS float*)a.in[15]) + (size_t)l * 3 * 512 * 1024, tid);
#endif
        }
        SEAM(pb + 5);
        if (IN(pb + 6)) {
#if FAST_OUT
            pg8::GridOrder S; S.init(T_, 1024, (int)gridDim.x, (int)blockIdx.x, FOX + 512, 1536, WOUT, 1024);
            pg8::EpiResidual E{xin, ((float*)(GAS float*)a.out)};
            pg8::gemm_phase(L8, 1024, 1536, S, E);
#else
            ph_out_simple(FOX, ((const float*)(const GAS float*)a.in[17]) + (size_t)l * D_ * D_, xin, ((float*)(GAS float*)a.out), tid);
#endif
        }
        SEAM(pb + 6);
#if FAST_MOE
        if (IN(pb + 7)) {
            ph_norm2_route_blk(((float*)(GAS float*)a.out), ((const float*)(const GAS float*)a.in[18]) + l * D_, HB, ((const float*)(const GAS float*)a.in[19]) + l * D_ * 4, ((const float*)(const GAS float*)a.in[20]) + l * 4,
                               ((const float*)(const GAS float*)a.in[21]) + l * D_ * 16, ((const float*)(const GAS float*)a.in[22]) + l * 16, TOKE, TOKW, LRANK, CNTBLK, (LAS int*)(L8 + 73728), tid, wave, lane);
            convert_expert_weights(((const float*)(const GAS float*)a.in[23]) + (size_t)l * 16 * 1024 * 512, ((const float*)(const GAS float*)a.in[24]) + (size_t)l * 16 * 1024 * 512,
                                   ((const float*)(const GAS float*)a.in[25]) + (size_t)l * 16 * 512 * 1024, W1E, WDE, L + wave * 2112, wave, lane);
        }
        SEAM(pb + 7);
        if (IN(pb + 8)) ph_moe_scatter(HB, HS, TOKE, TOKW, LRANK, CNTBLK, ROWTOK, ROWW, (LAS int*)L8, (LAS int*)(L8 + 16384), (LAS int*)(L8 + LDS_TB), (LAS int*)(L8 + LDS_TOT), tid, wave, lane);
        SEAM(pb + 8);
        if (IN(pb + 9)) {
            pg8::MoeOrder S{(int)gridDim.x, (int)blockIdx.x, (const char*)HS, (size_t)256 * 1024 * 2, (const char*)W1E, (size_t)1024 * 1024 * 2, (size_t)256 * 1024 * 2, (const LAS int*)(L8 + LDS_TB)};
            pg8::EpiMoe1 E{HID};
            pg8::gemm_phase(L8, 1024, 1024, S, E);
        }
        SEAM(pb + 9);
        if (IN(pb + 10)) {
            pg8::MoeOrder S{(int)gridDim.x, (int)blockIdx.x, (const char*)HID, (size_t)256 * 512 * 2, (const char*)WDE, (size_t)1024 * 512 * 2, (size_t)256 * 512 * 2, (const LAS int*)(L8 + LDS_TB)};
            pg8::EpiMoe2 E{ROWTOK, ROWW, ((float*)(GAS float*)a.out)};
            pg8::gemm_phase(L8, 512, 512, S, E);
        }
        SEAM(pb + 10);
#else
        if (IN(pb + 7)) ph_norm2_route(((float*)(GAS float*)a.out), ((const float*)(const GAS float*)a.in[18]) + l * D_, HB, ((const float*)(const GAS float*)a.in[19]) + l * D_ * 4, ((const float*)(const GAS float*)a.in[20]) + l * 4, ((const float*)(const GAS float*)a.in[21]) + l * D_ * 16, ((const float*)(const GAS float*)a.in[22]) + l * 16, TOKE, TOKW, wave, lane);
        SEAM(pb + 7);
        if (IN(pb + 8)) ph_moe_simple(HB, TOKE, TOKW, ((const float*)(const GAS float*)a.in[23]) + (size_t)l * 16 * 1024 * 512, ((const float*)(const GAS float*)a.in[24]) + (size_t)l * 16 * 1024 * 512, ((const float*)(const GAS float*)a.in[25]) + (size_t)l * 16 * 512 * 1024, ((float*)(GAS float*)a.out), L, tid);
        SEAM(pb + 8);
#endif
    }
#undef IN
#undef SEAM
}

extern "C" void kernel_launch(void* const* d_in, const int* in_sizes, int n_in, void* d_out, int out_size, void* d_ws, size_t ws_size, hipStream_t stream) {
    static int grid = 0;
    if (grid == 0) {
        if (n_in != 26 || out_size != T_ * D_ || ws_size < WS_END) { fprintf(stderr, "kernel_launch: unexpected sizes\n"); grid = -1; return; }
        int dev = 0, cus = 0;
        if (hipGetDevice(&dev) != hipSuccess || hipDeviceGetAttribute(&cus, hipDeviceAttributeMultiprocessorCount, dev) != hipSuccess) { grid = -1; return; }
        if (hipFuncSetAttribute((const void*)mega, hipFuncAttributeMaxDynamicSharedMemorySize, LDS_BYTES) != hipSuccess) { grid = -1; return; }
        int per_cu = 0;
        (void)hipOccupancyMaxActiveBlocksPerMultiprocessor(&per_cu, (const void*)mega, NTHR, LDS_BYTES);
        (void)hipGetLastError();
        grid = cus;
    }
    if (grid < 0) return;
    if (hipMemsetAsync((char*)d_ws + WS_CTL, 0, CTL_ZERO_BYTES, stream) != hipSuccess) return;
    Args a{};
    for (int i = 0; i < 26; ++i) a.in[i] = (const float*)d_in[i];
    a.out = (float*)d_out; a.ws = (unsigned char*)d_ws;
#if MK_SPLIT
    for (int p = 0; p < NLAYER * NPH; ++p) { a.ph_lo = p; a.ph_hi = p + 1; hipLaunchKernelGGL(mega, dim3(grid), dim3(NTHR), LDS_BYTES, stream, a); }
#else
    a.ph_lo = 0; a.ph_hi = NLAYER * NPH;
    hipLaunchKernelGGL(mega, dim3(grid), dim3(NTHR), LDS_BYTES, stream, a);
#endif
}
```

```cpp
#include <hip/hip_runtime.h>
#include <hip/hip_bf16.h>
#include <cstdio>
#include <cstdint>

#ifndef FAST_INPROJ
#define FAST_INPROJ 1
#endif
#ifndef DUAL_INPROJ
#define DUAL_INPROJ 0
#endif
#ifndef EPI_SKIP
#define EPI_SKIP(pn) (false)
#endif
#ifndef FAST_MERGE
#define FAST_MERGE 1
#endif
#ifndef FAST_OUT
#define FAST_OUT 1
#endif
#ifndef FAST_MOE
#define FAST_MOE 1
#endif
#ifndef FAST_ATTN
#define FAST_ATTN 1
#endif
#ifndef FAST_MIX
#define FAST_MIX 1
#endif
#ifndef PROF_PHASE
#define PROF_PHASE -1
#endif
#ifndef REPEAT_PHASE
#define REPEAT_PHASE -1
#endif
#ifndef MK_SPLIT
#define MK_SPLIT 0
#endif

#define GAS __attribute__((address_space(1)))
#define LAS __attribute__((address_space(3)))
typedef unsigned short bf16;
typedef unsigned v4u __attribute__((ext_vector_type(4)));
typedef unsigned v2u __attribute__((ext_vector_type(2)));
typedef float f32x4 __attribute__((ext_vector_type(4)));

constexpr int T_ = 16384, S_ = 8192, D_ = 1024, NLAYER = 2, INC = 7456, NWAVES = 8, NTHR = 512;
constexpr float LOG2E = 1.4426950408889634f, EPS = 1e-6f;
constexpr int FOXP = 1536, GLAP = 1536, SSMP = 1536, SMLP = 32, GATP = 3072;
constexpr size_t MiB = 1u << 20;
constexpr size_t WS_CTL = 0, CTL_ZERO_BYTES = 1 * MiB;
constexpr size_t WS_WIN = 1 * MiB, WS_WBR = 16 * MiB, WS_WOUT = 19 * MiB;
constexpr size_t WS_HB = 21 * MiB, WS_SST = 53 * MiB, WS_FOX = 85 * MiB, WS_GLA = 133 * MiB, WS_SSM = 181 * MiB;
constexpr size_t WS_SML = 229 * MiB, WS_CUM = 231 * MiB, WS_TOKE = WS_CUM + 512 * 1024, WS_TOKW = WS_CUM + 640 * 1024, WS_LRANK = WS_CUM + 768 * 1024, WS_ROWTOK = WS_CUM + 896 * 1024,
                 WS_ROWW = WS_CUM + 1056 * 1024, WS_CNTBLK = WS_CUM + 1216 * 1024, WS_GATES = 233 * MiB, WS_END = 329 * MiB;
constexpr size_t WS_W1E = WS_GATES, WS_WDE = WS_GATES + 32 * MiB, WS_HID = WS_GATES + 48 * MiB, WS_HS = WS_FOX;
constexpr size_t WS_GST = WS_HB, WS_GDEC = WS_CUM + 1280 * 1024, WS_SDEC = WS_CUM + 1536 * 1024;
constexpr size_t WS_ROWOF = WS_CUM + 1600 * 1024, WS_YB = WS_HS;
constexpr int MOE_ROWS = 36864;
static_assert(WS_HID + (size_t)MOE_ROWS * 512 * 2 <= WS_END && WS_HS + (size_t)MOE_ROWS * 1024 * 2 <= WS_SSM + 48 * MiB, "MoE overlays");
constexpr int CW_BAR = 4096;
constexpr int RING_BYTES = 131072, LDSCTL_OFF = RING_BYTES, MISC_OFF = LDSCTL_OFF + 320, LDS_TB = LDSCTL_OFF + 512  , LDS_TOT = LDSCTL_OFF + 640  , LDS_BYTES = 147456;

__device__ __forceinline__ GAS unsigned char* opq(unsigned char* p) { GAS unsigned char* g = (GAS unsigned char*)p; asm volatile("" : "+s"(g)); return g; }
__device__ __forceinline__ float bf2f(unsigned u) { return __builtin_bit_cast(float, u << 16); }
__device__ __forceinline__ unsigned f2bf(float f) { unsigned u = __builtin_bit_cast(unsigned, f); return (u + 0x7fffu + ((u >> 16) & 1u)) >> 16; }
__device__ __forceinline__ unsigned pk2(float lo, float hi) { return f2bf(lo) | (f2bf(hi) << 16); }
__device__ __forceinline__ float silu_f(float x) { return x / (1.f + __expf(-x)); }
__device__ __forceinline__ float sigmoid_f(float x) { return 1.f / (1.f + __expf(-x)); }
__device__ __forceinline__ float softplus_f(float x) { return fmaxf(x, 0.f) + log1pf(__expf(-fabsf(x))); }
__device__ __forceinline__ float logsig_f(float x) { return fminf(x, 0.f) - log1pf(__expf(-fabsf(x))); }
__device__ __forceinline__ float wave_sum(float v) {
#pragma unroll
    for (int o = 1; o < 64; o <<= 1) v += __shfl_xor(v, o);
    return v;
}

#define XB_TMO      128
#define XB_XCNT(j)  (256  + 64 * (j))
#define XB_XSUB(j)  (1280 + 64 * (j))
#define XB_XGEN(j)  (2304 + 64 * (j))
#define XB_TOP      3328
#define XB_TOPGEN   3392
#define XCD_BAR_WORDS 3456
#define XB_SPIN_CAP (1u << 23)
__device__ __forceinline__ unsigned xb_ld(unsigned* p)              { return __hip_atomic_load(p, __ATOMIC_RELAXED, __HIP_MEMORY_SCOPE_AGENT); }
__device__ __forceinline__ unsigned xb_add(unsigned* p, unsigned v) { return __hip_atomic_fetch_add(p, v, __ATOMIC_RELAXED, __HIP_MEMORY_SCOPE_AGENT); }
__device__ __forceinline__ unsigned xb_xcc_id() { return (unsigned)__builtin_amdgcn_s_getreg((3 << 11) | 20) & 0xFu; }
#define XB_SPIN(cond, bar) do { unsigned _sp = 0; while (cond) { __builtin_amdgcn_s_sleep(1); \
    if ((++_sp & 255u) == 0u) { if (xb_ld(&(bar)[XB_TMO])) break; if (_sp > XB_SPIN_CAP) { atomicAdd(&(bar)[XB_TMO], 1u); break; } } } } while (0)
struct XcdBarrier { unsigned* bar; unsigned x; volatile LAS unsigned* st; };
__device__ __forceinline__ XcdBarrier xcd_barrier_post(unsigned* bar, volatile LAS unsigned* st) {
    XcdBarrier b; b.bar = bar; b.x = xb_xcc_id(); b.st = st;
    if (threadIdx.x == 0) (void)xb_add(&bar[XB_XCNT(b.x)], 1u);
    return b;
}
__device__ __forceinline__ void xcd_barrier_complete(unsigned* bar, unsigned x, unsigned& nloc, unsigned& nx) {
    const unsigned G = gridDim.x * gridDim.y * gridDim.z;
    unsigned sum, cnt, mine, sp = 0u;
    for (;;) {
        sum = 0u; cnt = 0u; mine = 0u;
#pragma unroll
        for (unsigned j = 0; j < 16; ++j) { const unsigned c = xb_ld(&bar[XB_XCNT(j)]); sum += c; cnt += (c > 0u) ? 1u : 0u; mine = (j == x) ? c : mine; }
        if (sum == G) break;
        __builtin_amdgcn_s_sleep(1);
        if ((++sp & 255u) == 0u) { if (xb_ld(&bar[XB_TMO])) break; if (sp > XB_SPIN_CAP) { atomicAdd(&bar[XB_TMO], 1u); break; } }
    }
    nloc = mine > 0u ? mine : 1u; nx = cnt > 0u ? cnt : 1u;
}
__device__ __forceinline__ void xcd_barrier(const XcdBarrier& b) {
    asm volatile("s_waitcnt vmcnt(0)" ::: "memory");
    __syncthreads();
    if (threadIdx.x == 0) {
        unsigned* bar = b.bar;
        __builtin_amdgcn_s_waitcnt(0);
        unsigned nloc = b.st[0], nx = b.st[1];
        if (nloc == 0u) { xcd_barrier_complete(bar, b.x, nloc, nx); b.st[0] = nloc; b.st[1] = nx; }
        const unsigned old = xb_add(&bar[XB_XSUB(b.x)], 1u);
        const unsigned gen = old / nloc;
        if (old + 1u == (gen + 1u) * nloc) {
            __builtin_amdgcn_fence(__ATOMIC_RELEASE, "agent");
            asm volatile("s_waitcnt vmcnt(0)" ::: "memory");
            const unsigned og = xb_add(&bar[XB_TOP], 1u);
            const unsigned tg = og / nx;
            if (og + 1u == (tg + 1u) * nx) xb_add(&bar[XB_TOPGEN], 1u);
            else XB_SPIN(xb_ld(&bar[XB_TOPGEN]) == tg, bar);
            __builtin_amdgcn_fence(__ATOMIC_ACQUIRE, "agent");
            xb_add(&bar[XB_XGEN(b.x)], 1u);
            asm volatile("s_waitcnt vmcnt(0)" ::: "memory");
        } else {
            XB_SPIN(xb_ld(&bar[XB_XGEN(b.x)]) == gen, bar);
            __builtin_amdgcn_fence(__ATOMIC_ACQUIRE, "agent");
            asm volatile("s_waitcnt vmcnt(0)" ::: "memory");
        }
    }
    __syncthreads();
}

__device__ __forceinline__ void ph_norm(const float* x, const float* gain, bf16* out, int wave, int lane) {
    asm volatile("" : "+s"(wave), "+v"(lane));
    const int gw = blockIdx.x * NWAVES + wave, NGW = gridDim.x * NWAVES;
    for (int m = gw; m < T_; m += NGW) {
        const f32x4* xr = (const f32x4*)(x + (size_t)m * D_) + lane;
        f32x4 v[4]; float s = 0.f;
#pragma unroll
        for (int j = 0; j < 4; ++j) { v[j] = xr[64 * j]; s += (v[j].x * v[j].x + v[j].y * v[j].y) + (v[j].z * v[j].z + v[j].w * v[j].w); }
        const float r = rsqrtf(wave_sum(s) * (1.f / D_) + EPS);
        v2u* o8 = (v2u*)(out + (size_t)m * D_) + lane;
#pragma unroll
        for (int j = 0; j < 4; ++j) { const f32x4 g = ((const f32x4*)gain)[lane + 64 * j]; v2u w; w.x = pk2(v[j].x * r * g.x, v[j].y * r * g.y); w.y = pk2(v[j].z * r * g.z, v[j].w * r * g.w); o8[64 * j] = w; }
    }
}

__device__ __forceinline__ void ph_norm_combine(float* xio, const bf16* Y, const int* rowof, const float* gain, bf16* out, int wave, int lane) {
    asm volatile("" : "+s"(wave), "+v"(lane));
    const int gw = blockIdx.x * NWAVES + wave, NGW = gridDim.x * NWAVES;
    for (int m = gw; m < T_; m += NGW) {
        f32x4* xr = (f32x4*)(xio + (size_t)m * D_) + lane;
        const int r0 = rowof[2 * m], r1 = rowof[2 * m + 1];
        const v2u* y0 = (const v2u*)(Y + (size_t)r0 * D_) + lane; const v2u* y1 = (const v2u*)(Y + (size_t)r1 * D_) + lane;
        f32x4 v[4]; float s = 0.f;
#pragma unroll
        for (int j = 0; j < 4; ++j) { const v2u a = y0[64 * j], b = y1[64 * j]; f32x4 x = xr[64 * j];
            x.x += bf2f(a.x & 0xffffu) + bf2f(b.x & 0xffffu); x.y += bf2f(a.x >> 16) + bf2f(b.x >> 16); x.z += bf2f(a.y & 0xffffu) + bf2f(b.y & 0xffffu); x.w += bf2f(a.y >> 16) + bf2f(b.y >> 16);
            v[j] = x; if (gain) xr[64 * j] = x; else xr[64 * j] = x;
            s += (x.x * x.x + x.y * x.y) + (x.z * x.z + x.w * x.w); }
        if (gain) {
            const float r = rsqrtf(wave_sum(s) * (1.f / D_) + EPS);
            v2u* o8 = (v2u*)(out + (size_t)m * D_) + lane;
#pragma unroll
            for (int j = 0; j < 4; ++j) { const f32x4 g = ((const f32x4*)gain)[lane + 64 * j]; v2u w; w.x = pk2(v[j].x * r * g.x, v[j].y * r * g.y); w.y = pk2(v[j].z * r * g.z, v[j].w * r * g.w); o8[64 * j] = w; }
        }
    }
}

__device__ __forceinline__ void ph_inproj_simple(const bf16* HB, const float* w_in, const float* f_bias, const float* qn, const float* kn, const float* dt_bias, const float* bgate,
                                                 bf16* FOX, bf16* GLA, bf16* SSM, float* SML, bf16* GATES, int tid) {
    asm volatile("" : "+v"(tid));
    const int r = tid >> 3, cg = tid & 7;
    constexpr int NTC = (INC + 63) / 64;
    for (int item = blockIdx.x; item < (T_ / 64) * NTC; item += gridDim.x) {
        const int tm = item / NTC, tn = item % NTC;
        const int row = tm * 64 + r, c0 = tn * 64 + cg * 8;
        float acc[8];
#pragma unroll
        for (int j = 0; j < 8; ++j) acc[j] = 0.f;
        if (c0 < INC) {
            const bf16* a = HB + (size_t)row * D_;
            const float* w = w_in + c0;
            for (int k8 = 0; k8 < D_ / 8; ++k8) {
                const v4u av = *(const v4u*)(a + 8 * k8);
                float af[8] = {bf2f(av.x & 0xffffu), bf2f(av.x >> 16), bf2f(av.y & 0xffffu), bf2f(av.y >> 16), bf2f(av.z & 0xffffu), bf2f(av.z >> 16), bf2f(av.w & 0xffffu), bf2f(av.w >> 16)};
#pragma unroll
                for (int kk = 0; kk < 8; ++kk) {
                    const f32x4 w0 = *(const f32x4*)(w + (size_t)(8 * k8 + kk) * INC), w1 = *(const f32x4*)(w + (size_t)(8 * k8 + kk) * INC + 4);
                    acc[0] += af[kk] * w0.x; acc[1] += af[kk] * w0.y; acc[2] += af[kk] * w0.z; acc[3] += af[kk] * w0.w;
                    acc[4] += af[kk] * w1.x; acc[5] += af[kk] * w1.y; acc[6] += af[kk] * w1.z; acc[7] += af[kk] * w1.w;
                }
            }
        }
        if (c0 < 1024) {
            float ss = 0.f;
#pragma unroll
            for (int j = 0; j < 8; ++j) ss += acc[j] * acc[j];
            ss += __shfl_xor(ss, 1); ss += __shfl_xor(ss, 2); ss += __shfl_xor(ss, 4);
            const float rs = rsqrtf(ss * (1.f / 64.f) + EPS);
            const bool isq = c0 < 512; const float* gain = isq ? qn : kn; const float sc = isq ? 0.125f * LOG2E : 1.f;
            float v[8];
#pragma unroll
            for (int j = 0; j < 8; ++j) v[j] = acc[j] * rs * gain[(c0 + j) & 63] * sc;
            v4u o; o.x = pk2(v[0], v[1]); o.y = pk2(v[2], v[3]); o.z = pk2(v[4], v[5]); o.w = pk2(v[6], v[7]);
            *(v4u*)(FOX + (size_t)row * FOXP + c0) = o;
        } else if (c0 < INC) {
#pragma unroll
            for (int j = 0; j < 8; ++j) {
                const int col = c0 + j; const float v = acc[j];
                if (col < 1536) FOX[(size_t)row * FOXP + col] = (bf16)f2bf(v);
                else if (col < 1544) SML[(size_t)row * SMLP + (col - 1536)] = logsig_f(v + f_bias[col - 1536]) * LOG2E;
                else if (col < 3080) GLA[(size_t)row * GLAP + (col - 1544)] = (bf16)f2bf(v);
                else if (col < 3096) SML[(size_t)row * SMLP + 8 + (col - 3080)] = v;
                else if (col < 4376) SSM[(size_t)row * SSMP + (col - 3096)] = (bf16)f2bf(v);
                else if (col < 4384) SML[(size_t)row * SMLP + 24 + (col - 4376)] = softplus_f(v + dt_bias[col - 4376]);
                else GATES[(size_t)row * GATP + (col - 4384)] = (bf16)f2bf(sigmoid_f(v + bgate[col - 4384]));
            }
        }
    }
}

__device__ __forceinline__ void ph_cumsum(const float* SML, float* CUM, LAS float* sh, int tid) {
    asm volatile("" : "+v"(tid));
    for (int seq = blockIdx.x; seq < 16; seq += gridDim.x) {
        const int b = seq >> 3, h = seq & 7;
        float loc[16]; float run = 0.f;
#pragma unroll
        for (int i = 0; i < 16; ++i) { run += SML[(size_t)(b * S_ + tid * 16 + i) * SMLP + h]; loc[i] = run; }
        const int lane_ = tid & 63, wave_ = tid >> 6;
        float inc = run;
#pragma unroll
        for (int o = 1; o < 64; o <<= 1) { const float t = __shfl_up(inc, o); if (lane_ >= o) inc += t; }
        __syncthreads();
        if (lane_ == 63) sh[512 + wave_] = inc;
        __syncthreads();
        float wp = 0.f;
#pragma unroll
        for (int w = 0; w < 8; ++w) wp += (w < wave_) ? sh[512 + w] : 0.f;
        sh[tid] = wp + inc - run;
        __syncthreads();
        const float ex = sh[tid];
#pragma unroll
        for (int i = 0; i < 16; ++i) CUM[(size_t)seq * S_ + tid * 16 + i] = ex + loc[i];
    }
}

__device__ __forceinline__ void attn_simple_wave(bf16* FOX, const float* CUM, int b, int h, int g, int lane) {
    const int t = g * 32 + (lane >> 1), hf = lane & 1;
    const size_t rowq = (size_t)(b * S_ + t) * FOXP + h * 64 + hf * 32;
    float q[32], o[32];
#pragma unroll
    for (int i = 0; i < 4; ++i) { const v4u w = *(const v4u*)(FOX + rowq + 8 * i);
        q[8 * i + 0] = bf2f(w.x & 0xffffu); q[8 * i + 1] = bf2f(w.x >> 16); q[8 * i + 2] = bf2f(w.y & 0xffffu); q[8 * i + 3] = bf2f(w.y >> 16);
        q[8 * i + 4] = bf2f(w.z & 0xffffu); q[8 * i + 5] = bf2f(w.z >> 16); q[8 * i + 6] = bf2f(w.w & 0xffffu); q[8 * i + 7] = bf2f(w.w >> 16); }
#pragma unroll
    for (int d = 0; d < 32; ++d) o[d] = 0.f;
    const float* cs = CUM + (size_t)(b * 8 + h) * S_;
    const float cq = cs[t];
    float m = -1e30f, l = 0.f;
    const int smax = g * 32 + 31;
#pragma unroll 1
    for (int s = 0; s <= smax; ++s) {
        const bf16* kp = FOX + (size_t)(b * S_ + s) * FOXP + 512 + h * 64 + hf * 32;
        float dot = 0.f;
#pragma unroll
        for (int i = 0; i < 4; ++i) { const v4u w = *(const v4u*)(kp + 8 * i);
            dot += q[8 * i + 0] * bf2f(w.x & 0xffffu) + q[8 * i + 1] * bf2f(w.x >> 16) + q[8 * i + 2] * bf2f(w.y & 0xffffu) + q[8 * i + 3] * bf2f(w.y >> 16)
                 + q[8 * i + 4] * bf2f(w.z & 0xffffu) + q[8 * i + 5] * bf2f(w.z >> 16) + q[8 * i + 6] * bf2f(w.w & 0xffffu) + q[8 * i + 7] * bf2f(w.w >> 16); }
        dot += __shfl_xor(dot, 1);
        float logit = dot + (cq - cs[s]);
        if (s > t) logit = -1e30f;
        const float mn = fmaxf(m, logit);
        const float sc = exp2f(m - mn), p = (s > t) ? 0.f : exp2f(logit - mn);
        l = l * sc + p; m = mn;
        const bf16* vp = kp + 512;
#pragma unroll
        for (int i = 0; i < 4; ++i) { const v4u w = *(const v4u*)(vp + 8 * i);
            o[8 * i + 0] = o[8 * i + 0] * sc + p * bf2f(w.x & 0xffffu); o[8 * i + 1] = o[8 * i + 1] * sc + p * bf2f(w.x >> 16);
            o[8 * i + 2] = o[8 * i + 2] * sc + p * bf2f(w.y & 0xffffu); o[8 * i + 3] = o[8 * i + 3] * sc + p * bf2f(w.y >> 16);
            o[8 * i + 4] = o[8 * i + 4] * sc + p * bf2f(w.z & 0xffffu); o[8 * i + 5] = o[8 * i + 5] * sc + p * bf2f(w.z >> 16);
            o[8 * i + 6] = o[8 * i + 6] * sc + p * bf2f(w.w & 0xffffu); o[8 * i + 7] = o[8 * i + 7] * sc + p * bf2f(w.w >> 16); }
    }
    const float rl = 1.f / l;
#pragma unroll
    for (int i = 0; i < 4; ++i) { v4u w; w.x = pk2(o[8 * i] * rl, o[8 * i + 1] * rl); w.y = pk2(o[8 * i + 2] * rl, o[8 * i + 3] * rl); w.z = pk2(o[8 * i + 4] * rl, o[8 * i + 5] * rl); w.w = pk2(o[8 * i + 6] * rl, o[8 * i + 7] * rl);
        *(v4u*)(FOX + rowq + 8 * i) = w; }
}

__device__ __forceinline__ void gla_simple_item(bf16* GLA, const float* SML, const float* w_lr, const float* b_gate, LAS float* L, int b, int h, int tid) {
    LAS float* qs = L; LAS float* ks = L + 4096; LAS float* ad = L + 8192; LAS float* vs = L + 12288; LAS float* ob = L + 20480; LAS float* red = L + 28672;
    const int v = tid & 127, dg = tid >> 7;
    float S[16];
#pragma unroll
    for (int i = 0; i < 16; ++i) S[i] = 0.f;
    for (int c = 0; c < S_ / 64; ++c) {
        const size_t row0 = (size_t)b * S_ + (size_t)c * 64;
        __syncthreads();
        for (int idx = tid; idx < 4096; idx += NTHR) { const int t = idx >> 6, d = idx & 63; const size_t row = row0 + t;
            qs[idx] = bf2f(GLA[row * GLAP + h * 64 + d]) * 0.125f; ks[idx] = bf2f(GLA[row * GLAP + 256 + h * 64 + d]);
            float z = b_gate[h * 64 + d];
#pragma unroll
            for (int j = 0; j < 16; ++j) z += SML[row * SMLP + 8 + j] * w_lr[j * 256 + h * 64 + d];
            ad[idx] = __expf(logsig_f(z) * (1.f / 16.f)); }
        for (int idx = tid; idx < 8192; idx += NTHR) { const int t = idx >> 7, vv = idx & 127; vs[idx] = bf2f(GLA[(row0 + t) * GLAP + 512 + h * 128 + vv]); }
        __syncthreads();
        for (int t = 0; t < 64; ++t) {
            const float vt = vs[t * 128 + v]; float part = 0.f;
#pragma unroll
            for (int i = 0; i < 16; ++i) { const int d = dg * 16 + i; S[i] = ad[t * 64 + d] * S[i] + ks[t * 64 + d] * vt; part += qs[t * 64 + d] * S[i]; }
            red[(t & 1) * 512 + dg * 128 + v] = part;
            __syncthreads();
            if (dg == 0) { const LAS float* rr = red + (t & 1) * 512; ob[t * 128 + v] = (rr[v] + rr[128 + v]) + (rr[256 + v] + rr[384 + v]); }
        }
        __syncthreads();
        for (int idx = tid; idx < 8192; idx += NTHR) { const int t = idx >> 7, vv = idx & 127; GLA[(row0 + t) * GLAP + 512 + h * 128 + vv] = (bf16)f2bf(ob[idx]); }
    }
}

__device__ __forceinline__ void ssd_simple_item(bf16* SSM, const float* SML, const float* conv_w, const float* conv_b, const float* a_log, const float* d_skip, LAS float* L, int b, int h, int tid) {
    LAS float* xs = L; LAS float* Bs = L + 4096; LAS float* Cs = L + 8192; LAS float* dts = L + 12288; LAS float* yb = L + 12352; LAS float* red = L + 16448;
    const int p = tid & 63, ng = tid >> 6, g = h >> 2;
    const float a = -__expf(a_log[h]), Dk = d_skip[h];
    float hs[8];
#pragma unroll
    for (int i = 0; i < 8; ++i) hs[i] = 0.f;
    for (int c = 0; c < S_ / 64; ++c) {
        const int s0 = c * 64;
        __syncthreads();
        for (int idx = tid; idx < 3 * 4096; idx += NTHR) { const int which = idx >> 12, t = (idx >> 6) & 63, n = idx & 63;
            const int ch = (which == 0) ? (h * 64 + n) : (which == 1 ? 512 + g * 64 + n : 640 + g * 64 + n);
            float acc = conv_b[ch];
#pragma unroll
            for (int j = 0; j < 4; ++j) { const int s = s0 + t - 3 + j; if (s >= 0) acc += conv_w[j * 768 + ch] * bf2f(SSM[((size_t)b * S_ + s) * SSMP + 512 + ch]); }
            L[idx] = silu_f(acc); }
        if (tid < 64) dts[tid] = SML[((size_t)b * S_ + s0 + tid) * SMLP + 24 + h];
        __syncthreads();
        for (int t = 0; t < 64; ++t) {
            const float dt = dts[t], dA = __expf(dt * a), xt = xs[t * 64 + p]; float part = 0.f;
#pragma unroll
            for (int i = 0; i < 8; ++i) { const int n = ng * 8 + i; hs[i] = dA * hs[i] + dt * Bs[t * 64 + n] * xt; part += Cs[t * 64 + n] * hs[i]; }
            red[(t & 1) * 512 + ng * 64 + p] = part;
            __syncthreads();
            if (ng == 0) { const LAS float* rr = red + (t & 1) * 512; float y = 0.f;
#pragma unroll
                for (int i = 0; i < 8; ++i) y += rr[i * 64 + p];
                yb[t * 64 + p] = y + Dk * xt; }
        }
        __syncthreads();
        for (int idx = tid; idx < 4096; idx += NTHR) { const int t = idx >> 6, pp = idx & 63; const size_t e = ((size_t)b * S_ + s0 + t) * SSMP + h * 64 + pp;
            const float z = bf2f(SSM[e]); SSM[e] = (bf16)f2bf(yb[idx] * silu_f(z)); }
    }
}

__device__ __forceinline__ void ph_mix_simple(bf16* FOX, const float* CUM, bf16* GLA, bf16* SSM, const float* SML, const float* w_lr, const float* b_gate,
                                              const float* conv_w, const float* conv_b, const float* a_log, const float* d_skip, LAS float* L, int tid, int wave, int lane) {
    asm volatile("" : "+v"(tid), "+s"(wave), "+v"(lane));
    for (int it = blockIdx.x; it < (FAST_ATTN ? 24 : 24 + 512); it += gridDim.x) {
        if (it < 8) gla_simple_item(GLA, SML, w_lr, b_gate, L, it >> 2, it & 3, tid);
        else if (it < 24) ssd_simple_item(SSM, SML, conv_w, conv_b, a_log, d_skip, L, (it - 8) >> 3, (it - 8) & 7, tid);
        else { const int wi = (it - 24) * 8 + wave; const int bh = wi >> 8, g = wi & 255; attn_simple_wave(FOX, CUM, bh >> 3, bh & 7, g, lane); }
        __syncthreads();
    }
}

__device__ __forceinline__ void ph_post(bf16* GLA, bf16* SSM, const float* gla_norm, const float* ssm_norm, int wave, int lane) {
    asm volatile("" : "+s"(wave), "+v"(lane));
    const int gw = blockIdx.x * NWAVES + wave, NGW = gridDim.x * NWAVES;
    for (int m = gw; m < T_; m += NGW) {
        {
            const v4u w = *(const v4u*)(GLA + (size_t)m * GLAP + 512 + 8 * lane), gr = *(const v4u*)(GLA + (size_t)m * GLAP + 1024 + 8 * lane);
            float o[8] = {bf2f(w.x & 0xffffu), bf2f(w.x >> 16), bf2f(w.y & 0xffffu), bf2f(w.y >> 16), bf2f(w.z & 0xffffu), bf2f(w.z >> 16), bf2f(w.w & 0xffffu), bf2f(w.w >> 16)};
            float gg[8] = {bf2f(gr.x & 0xffffu), bf2f(gr.x >> 16), bf2f(gr.y & 0xffffu), bf2f(gr.y >> 16), bf2f(gr.z & 0xffffu), bf2f(gr.z >> 16), bf2f(gr.w & 0xffffu), bf2f(gr.w >> 16)};
            float ss = 0.f;
#pragma unroll
            for (int j = 0; j < 8; ++j) ss += o[j] * o[j];
            ss += __shfl_xor(ss, 1); ss += __shfl_xor(ss, 2); ss += __shfl_xor(ss, 4); ss += __shfl_xor(ss, 8);
            const float rs = rsqrtf(ss * (1.f / 128.f) + EPS);
            float r[8];
#pragma unroll
            for (int j = 0; j < 8; ++j) r[j] = o[j] * rs * gla_norm[(8 * lane + j) & 127] * silu_f(gg[j]);
            v4u ov; ov.x = pk2(r[0], r[1]); ov.y = pk2(r[2], r[3]); ov.z = pk2(r[4], r[5]); ov.w = pk2(r[6], r[7]);
            *(v4u*)(GLA + (size_t)m * GLAP + 1024 + 8 * lane) = ov;
        }
        {
            const v4u w = *(const v4u*)(SSM + (size_t)m * SSMP + 8 * lane);
            float o[8] = {bf2f(w.x & 0xffffu), bf2f(w.x >> 16), bf2f(w.y & 0xffffu), bf2f(w.y >> 16), bf2f(w.z & 0xffffu), bf2f(w.z >> 16), bf2f(w.w & 0xffffu), bf2f(w.w >> 16)};
            float ss = 0.f;
#pragma unroll
            for (int j = 0; j < 8; ++j) ss += o[j] * o[j];
            ss += __shfl_xor(ss, 1); ss += __shfl_xor(ss, 2); ss += __shfl_xor(ss, 4); ss += __shfl_xor(ss, 8); ss += __shfl_xor(ss, 16);
            const float rs = rsqrtf(ss * (1.f / 256.f) + EPS);
            float r[8];
#pragma unroll
            for (int j = 0; j < 8; ++j) r[j] = o[j] * rs * ssm_norm[8 * lane + j];
            v4u ov; ov.x = pk2(r[0], r[1]); ov.y = pk2(r[2], r[3]); ov.z = pk2(r[4], r[5]); ov.w = pk2(r[6], r[7]);
            *(v4u*)(SSM + (size_t)m * SSMP + 8 * lane) = ov;
        }
    }
}

__device__ __forceinline__ void ph_merge_simple(bf16* FOX, const bf16* GLA, const bf16* SSM, const bf16* GATES, const float* w_branch, int tid) {
    asm volatile("" : "+v"(tid));
    const int r = tid >> 3, cg = tid & 7;
    for (int item = blockIdx.x; item < (T_ / 64) * 16; item += gridDim.x) {
        const int tm = item >> 4, tn = item & 15; const int row = tm * 64 + r, d0 = tn * 64 + cg * 8;
        float macc[8];
#pragma unroll
        for (int j = 0; j < 8; ++j) macc[j] = 0.f;
#pragma unroll 1
        for (int r3 = 0; r3 < 3; ++r3) {
            const bf16* a = (r3 == 0) ? FOX + (size_t)row * FOXP : (r3 == 1 ? GLA + (size_t)row * GLAP + 1024 : SSM + (size_t)row * SSMP);
            const float* w = w_branch + (size_t)r3 * 512 * 1024 + d0;
            float acc[8];
#pragma unroll
            for (int j = 0; j < 8; ++j) acc[j] = 0.f;
            for (int k8 = 0; k8 < 64; ++k8) {
                const v4u av = *(const v4u*)(a + 8 * k8);
                float af[8] = {bf2f(av.x & 0xffffu), bf2f(av.x >> 16), bf2f(av.y & 0xffffu), bf2f(av.y >> 16), bf2f(av.z & 0xffffu), bf2f(av.z >> 16), bf2f(av.w & 0xffffu), bf2f(av.w >> 16)};
#pragma unroll
                for (int kk = 0; kk < 8; ++kk) {
                    const f32x4 w0 = *(const f32x4*)(w + (size_t)(8 * k8 + kk) * 1024), w1 = *(const f32x4*)(w + (size_t)(8 * k8 + kk) * 1024 + 4);
                    acc[0] += af[kk] * w0.x; acc[1] += af[kk] * w0.y; acc[2] += af[kk] * w0.z; acc[3] += af[kk] * w0.w;
                    acc[4] += af[kk] * w1.x; acc[5] += af[kk] * w1.y; acc[6] += af[kk] * w1.z; acc[7] += af[kk] * w1.w;
                }
            }
            const v4u gv = *(const v4u*)(GATES + (size_t)row * GATP + r3 * 1024 + d0);
            macc[0] += bf2f(gv.x & 0xffffu) * acc[0]; macc[1] += bf2f(gv.x >> 16) * acc[1]; macc[2] += bf2f(gv.y & 0xffffu) * acc[2]; macc[3] += bf2f(gv.y >> 16) * acc[3];
            macc[4] += bf2f(gv.z & 0xffffu) * acc[4]; macc[5] += bf2f(gv.z >> 16) * acc[5]; macc[6] += bf2f(gv.w & 0xffffu) * acc[6]; macc[7] += bf2f(gv.w >> 16) * acc[7];
        }
        v4u o; o.x = pk2(macc[0], macc[1]); o.y = pk2(macc[2], macc[3]); o.z = pk2(macc[4], macc[5]); o.w = pk2(macc[6], macc[7]);
        *(v4u*)(FOX + (size_t)row * FOXP + 512 + d0) = o;
    }
}

__device__ __forceinline__ void ph_out_simple(const bf16* FOX, const float* w_out, const float* xold, float* xnew, int tid) {
    asm volatile("" : "+v"(tid));
    const int r = tid >> 3, cg = tid & 7;
    for (int item = blockIdx.x; item < (T_ / 64) * 16; item += gridDim.x) {
        const int tm = item >> 4, tn = item & 15; const int row = tm * 64 + r, d0 = tn * 64 + cg * 8;
        const bf16* a = FOX + (size_t)row * FOXP + 512; const float* w = w_out + d0;
        float acc[8];
#pragma unroll
        for (int j = 0; j < 8; ++j) acc[j] = 0.f;
        for (int k8 = 0; k8 < 128; ++k8) {
            const v4u av = *(const v4u*)(a + 8 * k8);
            float af[8] = {bf2f(av.x & 0xffffu), bf2f(av.x >> 16), bf2f(av.y & 0xffffu), bf2f(av.y >> 16), bf2f(av.z & 0xffffu), bf2f(av.z >> 16), bf2f(av.w & 0xffffu), bf2f(av.w >> 16)};
#pragma unroll
            for (int kk = 0; kk < 8; ++kk) {
                const f32x4 w0 = *(const f32x4*)(w + (size_t)(8 * k8 + kk) * 1024), w1 = *(const f32x4*)(w + (size_t)(8 * k8 + kk) * 1024 + 4);
                acc[0] += af[kk] * w0.x; acc[1] += af[kk] * w0.y; acc[2] += af[kk] * w0.z; acc[3] += af[kk] * w0.w;
                acc[4] += af[kk] * w1.x; acc[5] += af[kk] * w1.y; acc[6] += af[kk] * w1.z; acc[7] += af[kk] * w1.w;
            }
        }
        const f32x4 x0 = *(const f32x4*)(xold + (size_t)row * D_ + d0), x1 = *(const f32x4*)(xold + (size_t)row * D_ + d0 + 4);
        *(f32x4*)(xnew + (size_t)row * D_ + d0) = (f32x4){x0.x + acc[0], x0.y + acc[1], x0.z + acc[2], x0.w + acc[3]};
        *(f32x4*)(xnew + (size_t)row * D_ + d0 + 4) = (f32x4){x1.x + acc[4], x1.y + acc[5], x1.z + acc[6], x1.w + acc[7]};
    }
}

__device__ __forceinline__ void ph_norm2_route(const float* x, const float* gain, bf16* out, const float* wg, const float* bg, const float* we, const float* be, int* tok_e, float* tok_w, int wave, int lane) {
    asm volatile("" : "+s"(wave), "+v"(lane));
    const int gw = blockIdx.x * NWAVES + wave, NGW = gridDim.x * NWAVES;
    for (int m = gw; m < T_; m += NGW) {
        const f32x4* xr = (const f32x4*)(x + (size_t)m * D_) + lane;
        f32x4 v[4]; float s = 0.f;
#pragma unroll
        for (int j = 0; j < 4; ++j) { v[j] = xr[64 * j]; s += (v[j].x * v[j].x + v[j].y * v[j].y) + (v[j].z * v[j].z + v[j].w * v[j].w); }
        const float r = rsqrtf(wave_sum(s) * (1.f / D_) + EPS);
        v2u* o8 = (v2u*)(out + (size_t)m * D_) + lane;
        float gl[4] = {0.f, 0.f, 0.f, 0.f}; float hn[16];
#pragma unroll
        for (int j = 0; j < 4; ++j) { const f32x4 g = ((const f32x4*)gain)[lane + 64 * j];
            const float h0 = v[j].x * r * g.x, h1 = v[j].y * r * g.y, h2 = v[j].z * r * g.z, h3 = v[j].w * r * g.w;
            v2u w; w.x = pk2(h0, h1); w.y = pk2(h2, h3); o8[64 * j] = w;
            hn[4 * j] = h0; hn[4 * j + 1] = h1; hn[4 * j + 2] = h2; hn[4 * j + 3] = h3;
#pragma unroll
            for (int i = 0; i < 4; ++i) { const int k = 4 * (lane + 64 * j) + i; const f32x4 a = *(const f32x4*)(wg + (size_t)k * 4);
                gl[0] += hn[4 * j + i] * a.x; gl[1] += hn[4 * j + i] * a.y; gl[2] += hn[4 * j + i] * a.z; gl[3] += hn[4 * j + i] * a.w; } }
#pragma unroll
        for (int i = 0; i < 4; ++i) gl[i] = wave_sum(gl[i]) + bg[i];
        int gs = 0; float gm = gl[0];
#pragma unroll
        for (int i = 1; i < 4; ++i) if (gl[i] > gm) { gm = gl[i]; gs = i; }
        float gsum = 0.f;
#pragma unroll
        for (int i = 0; i < 4; ++i) gsum += __expf(gl[i] - gm);
        const float g_w = 1.f / gsum;
        gs = __builtin_amdgcn_readfirstlane(gs);
        float el[4] = {0.f, 0.f, 0.f, 0.f};
#pragma unroll
        for (int j = 0; j < 4; ++j)
#pragma unroll
            for (int i = 0; i < 4; ++i) { const int k = 4 * (lane + 64 * j) + i; const f32x4 c = *(const f32x4*)(we + (size_t)k * 16 + 4 * gs);
                el[0] += hn[4 * j + i] * c.x; el[1] += hn[4 * j + i] * c.y; el[2] += hn[4 * j + i] * c.z; el[3] += hn[4 * j + i] * c.w; }
#pragma unroll
        for (int i = 0; i < 4; ++i) el[i] = wave_sum(el[i]) + be[4 * gs + i];
        int i0 = 0; float m0 = el[0];
#pragma unroll
        for (int i = 1; i < 4; ++i) if (el[i] > m0) { m0 = el[i]; i0 = i; }
        int i1 = -1; float m1 = -3.0e38f;
#pragma unroll
        for (int i = 0; i < 4; ++i) if (i != i0 && el[i] > m1) { m1 = el[i]; i1 = i; }
        const float p1 = __expf(m1 - m0);
        const float w0 = g_w / (1.f + p1), w1 = g_w * p1 / (1.f + p1);
        if (lane == 0) { tok_e[2 * m] = gs * 4 + i0; tok_e[2 * m + 1] = gs * 4 + i1; tok_w[2 * m] = w0; tok_w[2 * m + 1] = w1; }
    }
}

__device__ __forceinline__ void ph_moe_simple(const bf16* HB, const int* tok_e, const float* tok_w, const float* wgate, const float* wup, const float* wdown, float* x, LAS float* L, int tid) {
    asm volatile("" : "+v"(tid));
    LAS float* hrow = L; LAS float* hid = L + 1024;
    for (int m = blockIdx.x; m < T_; m += gridDim.x) {
        __syncthreads();
        hrow[tid] = bf2f(HB[(size_t)m * D_ + tid]); hrow[tid + 512] = bf2f(HB[(size_t)m * D_ + tid + 512]);
        float y0 = 0.f, y1 = 0.f;
#pragma unroll 1
        for (int sl = 0; sl < 2; ++sl) {
            const int e = tok_e[2 * m + sl]; const float wt = tok_w[2 * m + sl];
            __syncthreads();
            const float* G = wgate + (size_t)e * 1024 * 512 + tid; const float* U = wup + (size_t)e * 1024 * 512 + tid;
            float g = 0.f, u = 0.f;
#pragma unroll 8
            for (int k = 0; k < 1024; ++k) { const float hk = hrow[k]; g += hk * G[(size_t)k * 512]; u += hk * U[(size_t)k * 512]; }
            hid[tid] = silu_f(g) * u;
            __syncthreads();
            const float* Dn = wdown + (size_t)e * 512 * 1024 + tid;
            float a0 = 0.f, a1 = 0.f;
#pragma unroll 8
            for (int j = 0; j < 512; ++j) { const float hj = hid[j]; a0 += hj * Dn[(size_t)j * 1024]; a1 += hj * Dn[(size_t)j * 1024 + 512]; }
            y0 += wt * a0; y1 += wt * a1;
        }
        x[(size_t)m * D_ + tid] += y0; x[(size_t)m * D_ + tid + 512] += y1;
    }
}


namespace pg8 {
typedef short bf16x8 __attribute__((ext_vector_type(8)));
constexpr int BM = 256, BK = 64, HALF = 128, HTB = HALF * BK * 2, STAGE_BYTES = 8 * HTB, NXCD = 8, WGM = 8;
__host__ __device__ __forceinline__ int lds_byte(int r, int c) { const int st = (r >> 4) * 2 + (c >> 5), rr = r & 15, cc = c & 31, ob = rr * 64 + cc * 2; return st * 1024 + (ob ^ (((ob >> 9) & 1) << 5)); }
__host__ __device__ __forceinline__ void stage_rc(int b, int& R, int& C) { const int st = b / 1024, sb = b % 1024, swz = sb ^ (((sb >> 9) & 1) << 5); R = (st >> 1) * 16 + swz / 64; C = (st & 1) * 32 + (swz % 64) / 2; }
__host__ __device__ __forceinline__ int perm32(int rho) { const int n = rho >> 4, i = rho & 15; return 8 * (i >> 2) + 4 * n + (i & 3); }
struct Unit { int pm, pn, aux; };
struct GridOrder {
    int nM, nN, nwg, G, c; const char* A; const char* B; size_t tsA, tsB;
    __device__ __forceinline__ void init(int M, int N, int G_, int c_, const void* A_, int lda, const void* B_, int ldb) { nM = M / BM; nN = N / BM; nwg = nM * nN; G = G_; c = c_; A = (const char*)A_; B = (const char*)B_; tsA = (size_t)BM * lda * 2; tsB = (size_t)BM * ldb * 2; }
    __device__ __forceinline__ bool next(int i, Unit& u) const {
        const long L = (long)i * G + c; if (L >= nwg) return false;
        int wgid = (int)L; { const int q = nwg / NXCD, r = nwg % NXCD, xcd = wgid % NXCD, off = wgid / NXCD; wgid = (xcd < r ? xcd * (q + 1) : r * (q + 1) + (xcd - r) * q) + off; }
        const int nig = WGM * nN, gid = wgid / nig, fm = gid * WGM, gsz = (nM - fm) < WGM ? (nM - fm) : WGM;
        u.pm = fm + ((wgid % nig) % gsz); u.pn = (wgid % nig) / gsz; u.aux = 0; return true;
    }
    __device__ __forceinline__ const char* abase(const Unit& u) const { return A + (size_t)u.pm * tsA; }
    __device__ __forceinline__ const char* bbase(const Unit& u) const { return B + (size_t)u.pn * tsB; }
};
template <class Epi, class Sched>
__device__ __forceinline__ void gemm_phase(LAS unsigned char* lds, const int K, const int lda, const Sched& S, const Epi& E) {
    int tid = threadIdx.x; asm volatile("" : "+v"(tid));
    const int wid = __builtin_amdgcn_readfirstlane(tid >> 6), lane = tid & 63, wr = wid >> 2, wc = wid & 3, fr = lane & 15, fq = lane >> 4;
    const int nt = K / BK;
    unsigned voffA[2], voffB[2];
#pragma unroll
    for (int i = 0; i < 2; ++i) { int R, C; stage_rc(tid * 16 + i * 8192, R, C); const int Rb = (R & ~31) + perm32(R & 31);
        voffA[i] = (unsigned)(R * lda + C) * 2u; voffB[i] = (unsigned)(Rb * K + C) * 2u; }
    const size_t kstep = (size_t)(BK * 2);
    const size_t hstepA = (size_t)HALF * lda * 2, hstepB = (size_t)HALF * K * 2;
    const unsigned ldsw = (unsigned)wid * 1024u;
    const int aoff = lds_byte(wr * 64 + fr, fq * 8), boff = lds_byte(wc * 32 + fr, fq * 8);
#define PG8_SA(b, h) (((b) * 2 + (h)) * HTB)
#define PG8_SB(b, h) ((4 + (b) * 2 + (h)) * HTB)
#define PG8_STAGE(bufoff, gbase, voff) do { _Pragma("unroll") for (int _i = 0; _i < 2; ++_i) \
        __builtin_amdgcn_global_load_lds((const unsigned*)((const char*)(gbase) + (voff)[_i]), (LAS unsigned*)(lds + (bufoff) + ldsw + _i * 8192), 16, 0, 0); } while (0)
#define PG8_LDA(dst, b, h) do { _Pragma("unroll") for (int m = 0; m < 4; ++m) _Pragma("unroll") for (int k = 0; k < 2; ++k) dst[m][k] = *(const LAS bf16x8*)(lds + PG8_SA(b, h) + aoff + m * 2048 + k * 1024); } while (0)
#define PG8_LDB(dst, b, h) do { _Pragma("unroll") for (int n = 0; n < 2; ++n) _Pragma("unroll") for (int k = 0; k < 2; ++k) dst[n][k] = *(const LAS bf16x8*)(lds + PG8_SB(b, h) + boff + n * 2048 + k * 1024); } while (0)
#define PG8_MMA(ai, bj, At, Bt) do { __builtin_amdgcn_s_setprio(1); _Pragma("unroll") for (int m = 0; m < 4; ++m) _Pragma("unroll") for (int n = 0; n < 2; ++n) _Pragma("unroll") for (int k = 0; k < 2; ++k) \
        acc[ai][bj][m][n] = __builtin_amdgcn_mfma_f32_16x16x32_bf16(Bt[n][k], At[m][k], acc[ai][bj][m][n], 0, 0, 0); __builtin_amdgcn_s_setprio(0); } while (0)
#define PG8_WAIT_V(n) asm volatile("s_waitcnt vmcnt(" #n ")" ::: "memory")
#define PG8_WAIT_L(n) asm volatile("s_waitcnt lgkmcnt(" #n ")" ::: "memory")
#define PG8_BAR __builtin_amdgcn_s_barrier()
#define PG8_SCHED __builtin_amdgcn_sched_barrier(0)
    Unit cur, nxt; int ui = 0;
    if (!S.next(0, cur)) return;
    f32x4 acc[2][2][4][2];
#pragma unroll
    for (int a = 0; a < 2; ++a)
#pragma unroll
        for (int b = 0; b < 2; ++b)
#pragma unroll
            for (int m = 0; m < 4; ++m)
#pragma unroll
                for (int n = 0; n < 2; ++n) acc[a][b][m][n] = (f32x4){0.f, 0.f, 0.f, 0.f};
    bf16x8 At[4][2], B0[2][2], B1[2][2];
    const char* cA = S.abase(cur); const char* cB = S.bbase(cur);
    PG8_STAGE(PG8_SB(0, 0), cB, voffB); PG8_STAGE(PG8_SB(0, 1), cB + hstepB, voffB); PG8_STAGE(PG8_SA(0, 0), cA, voffA); PG8_STAGE(PG8_SA(0, 1), cA + hstepA, voffA);
    if (wr == 1) PG8_BAR;
    PG8_WAIT_V(2); PG8_BAR;
    PG8_STAGE(PG8_SB(1, 0), cB + kstep, voffB); PG8_STAGE(PG8_SA(1, 0), cA + kstep, voffA); PG8_STAGE(PG8_SB(1, 1), cB + hstepB + kstep, voffB);
    PG8_WAIT_V(6); PG8_BAR;
    for (;;) {
        const bool has_next = S.next(ui + 1, nxt);
        const char* nA = has_next ? S.abase(nxt) : cA; const char* nB = has_next ? S.bbase(nxt) : cB;
        for (int t = 0; t < nt; t += 2) {
            const bool last = (t == nt - 2);
            const char* a1 = cA + (size_t)(t + 1) * kstep;
            const char* a2 = last ? nA : cA + (size_t)(t + 2) * kstep; const char* b2 = last ? nB : cB + (size_t)(t + 2) * kstep;
            const char* a3 = a2 + kstep; const char* b3 = b2 + kstep;
            PG8_LDB(B0, 0, 0); PG8_LDB(B1, 0, 1); PG8_SCHED; PG8_LDA(At, 0, 0); PG8_STAGE(PG8_SA(1, 1), a1 + hstepA, voffA);
            PG8_WAIT_V(8); PG8_WAIT_L(0); PG8_BAR; PG8_MMA(0, 0, At, B0); PG8_MMA(0, 1, At, B1); PG8_BAR; PG8_SCHED;
            PG8_LDA(At, 0, 1); PG8_STAGE(PG8_SB(0, 0), b2, voffB); PG8_STAGE(PG8_SB(0, 1), b2 + hstepB, voffB); PG8_STAGE(PG8_SA(0, 0), a2, voffA);
            PG8_WAIT_V(8); PG8_WAIT_L(0); PG8_BAR; PG8_MMA(1, 0, At, B0); PG8_MMA(1, 1, At, B1); PG8_BAR; PG8_SCHED;
            PG8_LDB(B0, 1, 0); PG8_LDB(B1, 1, 1); PG8_SCHED; PG8_LDA(At, 1, 0); PG8_STAGE(PG8_SA(0, 1), a2 + hstepA, voffA);
            PG8_WAIT_V(8); PG8_WAIT_L(0); PG8_BAR; PG8_MMA(0, 0, At, B0); PG8_MMA(0, 1, At, B1); PG8_BAR; PG8_SCHED;
            PG8_LDA(At, 1, 1); PG8_STAGE(PG8_SB(1, 0), b3, voffB); PG8_STAGE(PG8_SB(1, 1), b3 + hstepB, voffB); PG8_STAGE(PG8_SA(1, 0), a3, voffA);
            PG8_WAIT_V(8); PG8_WAIT_L(0); PG8_BAR; PG8_MMA(1, 0, At, B0); PG8_MMA(1, 1, At, B1); PG8_BAR; PG8_SCHED;
        }
        if (wr == 0) PG8_BAR;
        E(acc, cur, wr, wc, fr, fq);
        if (!has_next) break;
#pragma unroll
        for (int a = 0; a < 2; ++a)
#pragma unroll
            for (int b = 0; b < 2; ++b)
#pragma unroll
                for (int m = 0; m < 4; ++m)
#pragma unroll
                    for (int n = 0; n < 2; ++n) acc[a][b][m][n] = (f32x4){0.f, 0.f, 0.f, 0.f};
        cur = nxt; cA = nA; cB = nB; ++ui;
        if (wr == 1) PG8_BAR;
    }
    PG8_WAIT_V(0);
    PG8_BAR;
#undef PG8_SA
#undef PG8_SB
#undef PG8_STAGE
#undef PG8_LDA
#undef PG8_LDB
#undef PG8_MMA
#undef PG8_WAIT_V
#undef PG8_WAIT_L
#undef PG8_BAR
#undef PG8_SCHED
}
typedef float f32x2_t __attribute__((ext_vector_type(2))); typedef __bf16 bf16x2_t __attribute__((ext_vector_type(2)));
__device__ __forceinline__ unsigned cvt_pk_bf16(float lo, float hi) { f32x2_t v = {lo, hi}; bf16x2_t b = __builtin_convertvector(v, bf16x2_t); return __builtin_bit_cast(unsigned, b); }
__device__ __forceinline__ v4u pack8(const f32x4 a, const f32x4 b) { v4u w; w.x = cvt_pk_bf16(a[0], a[1]); w.y = cvt_pk_bf16(a[2], a[3]); w.z = cvt_pk_bf16(b[0], b[1]); w.w = cvt_pk_bf16(b[2], b[3]); return w; }

struct EpiInproj {
    bf16* FOX; bf16* GLA; bf16* SSM; float* SML; bf16* GATES; const float *qn, *kn, *f_bias, *dt_bias, *bgate;
    __device__ __forceinline__ void operator()(const f32x4 (&acc)[2][2][4][2], const Unit& u, int wr, int wc, int fr, int fq) const {
        asm volatile("" : "+v"(fr), "+v"(fq), "+s"(wr), "+s"(wc));
        const int pn = u.pn; const size_t row0 = (size_t)u.pm * BM + wr * 64 + fr;
        if (EPI_SKIP(pn)) return;
        if (pn < 4) {
            const bool isq = pn < 2; const float* gain = isq ? qn : kn; const float sc = isq ? 0.125f * LOG2E : 1.f;
            f32x4 g[2][2];
#pragma unroll
            for (int bj = 0; bj < 2; ++bj)
#pragma unroll
                for (int n = 0; n < 2; ++n) g[bj][n] = *(const f32x4*)(gain + 32 * bj + 8 * fq + 4 * n);
            bf16* dst = FOX + (isq ? 0 : 512) + (pn & 1) * 256 + 64 * wc + 8 * fq;
#pragma unroll
            for (int ai = 0; ai < 2; ++ai)
#pragma unroll
                for (int m = 0; m < 4; ++m) {
                    float ss = 0.f;
#pragma unroll
                    for (int bj = 0; bj < 2; ++bj)
#pragma unroll
                        for (int n = 0; n < 2; ++n) { const f32x4 x = acc[ai][bj][m][n]; ss += (x[0] * x[0] + x[1] * x[1]) + (x[2] * x[2] + x[3] * x[3]); }
                    ss += __shfl_xor(ss, 16); ss += __shfl_xor(ss, 32);
                    const float rs = rsqrtf(ss * (1.f / 64.f) + EPS) * sc;
                    bf16* rp = dst + (row0 + ai * HALF + m * 16) * FOXP;
#pragma unroll
                    for (int bj = 0; bj < 2; ++bj) *(v4u*)(rp + 32 * bj) = pack8(acc[ai][bj][m][0] * rs * g[bj][0], acc[ai][bj][m][1] * rs * g[bj][1]);
                }
        } else if (pn == 17) {
            if (wc == 0) {
                f32x4 b0 = (f32x4){0.f, 0.f, 0.f, 0.f}, b1 = b0;
                if (fq == 0) { b0 = *(const f32x4*)(f_bias); b1 = *(const f32x4*)(f_bias + 4); }
                if (fq == 3) { b0 = *(const f32x4*)(dt_bias); b1 = *(const f32x4*)(dt_bias + 4); }
#pragma unroll
                for (int ai = 0; ai < 2; ++ai)
#pragma unroll
                    for (int m = 0; m < 4; ++m) {
                        f32x4 v0 = acc[ai][0][m][0] + b0, v1 = acc[ai][0][m][1] + b1;
                        if (fq == 0) {
#pragma unroll
                            for (int i = 0; i < 4; ++i) { v0[i] = logsig_f(v0[i]) * LOG2E; v1[i] = logsig_f(v1[i]) * LOG2E; } }
                        if (fq == 3) {
#pragma unroll
                            for (int i = 0; i < 4; ++i) { v0[i] = softplus_f(v0[i]); v1[i] = softplus_f(v1[i]); } }
                        float* rp = SML + (row0 + ai * HALF + m * 16) * SMLP + 8 * fq;
                        *(f32x4*)rp = v0; *(f32x4*)(rp + 4) = v1;
                    }
            }
        } else if (pn >= 18) {
            const int colt = (pn - 18) * 256 + 32 * wc + 8 * fq;
#pragma unroll
            for (int bj = 0; bj < 2; ++bj) {
                const f32x4 b0 = *(const f32x4*)(bgate + colt + bj * HALF), b1 = *(const f32x4*)(bgate + colt + bj * HALF + 4);
#pragma unroll
                for (int ai = 0; ai < 2; ++ai)
#pragma unroll
                    for (int m = 0; m < 4; ++m) {
                        f32x4 v0 = acc[ai][bj][m][0] + b0, v1 = acc[ai][bj][m][1] + b1;
#pragma unroll
                        for (int i = 0; i < 4; ++i) { v0[i] = __builtin_amdgcn_rcpf(1.f + __expf(-v0[i])); v1[i] = __builtin_amdgcn_rcpf(1.f + __expf(-v1[i])); }
                        *(v4u*)(GATES + (row0 + ai * HALF + m * 16) * GATP + colt + bj * HALF) = pack8(v0, v1);
                    }
            }
        } else {
            bf16* dst = (pn < 6) ? FOX + 1024 + (pn - 4) * 256 : (pn < 12 ? GLA + (pn - 6) * 256 : SSM + (pn - 12) * 256);
            dst += 32 * wc + 8 * fq;
#pragma unroll
            for (int ai = 0; ai < 2; ++ai)
#pragma unroll
                for (int m = 0; m < 4; ++m) { bf16* rp = dst + (row0 + ai * HALF + m * 16) * 1536;
#pragma unroll
                    for (int bj = 0; bj < 2; ++bj) *(v4u*)(rp + bj * HALF) = pack8(acc[ai][bj][m][0], acc[ai][bj][m][1]); }
        }
    }
};
struct EpiResidual {
    const float* xold; float* xnew;
    __device__ __forceinline__ void operator()(const f32x4 (&acc)[2][2][4][2], const Unit& u, int wr, int wc, int fr, int fq) const {
        asm volatile("" : "+v"(fr), "+v"(fq), "+s"(wr), "+s"(wc));
        const size_t row0 = (size_t)u.pm * BM + wr * 64 + fr; const int col0 = u.pn * BM + 32 * wc + 8 * fq;
#pragma unroll
        for (int ai = 0; ai < 2; ++ai)
#pragma unroll
            for (int m = 0; m < 4; ++m) { const size_t off = (row0 + ai * HALF + m * 16) * D_ + col0;
#pragma unroll
                for (int bj = 0; bj < 2; ++bj) { const f32x4 x0 = *(const f32x4*)(xold + off + bj * HALF), x1 = *(const f32x4*)(xold + off + bj * HALF + 4);
                    *(f32x4*)(xnew + off + bj * HALF) = x0 + acc[ai][bj][m][0]; *(f32x4*)(xnew + off + bj * HALF + 4) = x1 + acc[ai][bj][m][1]; } }
    }
};
struct MergeOrder {
    int G, c; const char* ws; const char* B;
    __device__ __forceinline__ bool next(int i, Unit& u) const { const int q = i / 3; const int tile = c + q * G; if (tile >= 256) return false; u.pm = tile >> 2; u.pn = tile & 3; u.aux = i - 3 * q; return true; }
    __device__ __forceinline__ const char* abase(const Unit& u) const { return ws + WS_FOX + (size_t)u.aux * (48 * MiB) + (size_t)(u.aux & 1) * 2048 + (size_t)u.pm * BM * 1536 * 2; }
    __device__ __forceinline__ const char* bbase(const Unit& u) const { return B + ((size_t)u.aux * 1024 + (size_t)u.pn * BM) * 512 * 2; }
};
static_assert(WS_GLA - WS_FOX == 48 * MiB && WS_SSM - WS_GLA == 48 * MiB, "MergeOrder::abase");
struct EpiMerge {
    const bf16* GATES; bf16* MB;
    __device__ __forceinline__ void operator()(const f32x4 (&acc)[2][2][4][2], const Unit& u, int wr, int wc, int fr, int fq) const {
        asm volatile("" : "+v"(fr), "+v"(fq), "+s"(wr), "+s"(wc));
        const size_t row0 = (size_t)u.pm * BM + wr * 64 + fr; const int col0 = u.pn * BM + 32 * wc + 8 * fq; const int r = u.aux;
#pragma unroll
        for (int ai = 0; ai < 2; ++ai)
#pragma unroll
            for (int m = 0; m < 4; ++m) { const size_t row = row0 + ai * HALF + m * 16;
#pragma unroll
                for (int bj = 0; bj < 2; ++bj) {
                    const v4u gv = *(const v4u*)(GATES + row * GATP + r * 1024 + col0 + bj * HALF);
                    f32x4 v0 = acc[ai][bj][m][0], v1 = acc[ai][bj][m][1];
                    v0[0] *= bf2f(gv.x & 0xffffu); v0[1] *= bf2f(gv.x >> 16); v0[2] *= bf2f(gv.y & 0xffffu); v0[3] *= bf2f(gv.y >> 16);
                    v1[0] *= bf2f(gv.z & 0xffffu); v1[1] *= bf2f(gv.z >> 16); v1[2] *= bf2f(gv.w & 0xffffu); v1[3] *= bf2f(gv.w >> 16);
                    bf16* mp = MB + row * FOXP + col0 + bj * HALF;
                    if (r > 0) { const v4u pv = *(const v4u*)mp;
                        v0[0] += bf2f(pv.x & 0xffffu); v0[1] += bf2f(pv.x >> 16); v0[2] += bf2f(pv.y & 0xffffu); v0[3] += bf2f(pv.y >> 16);
                        v1[0] += bf2f(pv.z & 0xffffu); v1[1] += bf2f(pv.z >> 16); v1[2] += bf2f(pv.w & 0xffffu); v1[3] += bf2f(pv.w >> 16); }
                    *(v4u*)mp = pack8(v0, v1);
                } }
    }
};
}

__device__ __forceinline__ int inproj_src_col(int p) {
    const int tile = p >> 8, q = p & 255;
    if (tile < 4) { const int base = (tile < 2 ? 0 : 512) + (tile & 1) * 256; return base + 64 * ((q >> 5) & 3) + 32 * (q >> 7) + (q & 31); }
    if (tile < 6) return 1024 + (tile - 4) * 256 + q;
    if (tile < 12) return 1544 + (tile - 6) * 256 + q;
    if (tile < 17) return 3096 + (tile - 12) * 256 + q;
    if (tile == 17) return q < 8 ? 1536 + q : (q < 24 ? 3080 + (q - 8) : (q < 32 ? 4376 + (q - 24) : -1));
    return 4384 + (tile - 18) * 256 + q;
}
__device__ __forceinline__ void transpose_item(const float* W, int ldw, int src, bf16* WT, int K, int p0, int k0, LAS float* scr, int lane) {
#pragma unroll 8
    for (int i = 0; i < 32; ++i) { const int kk = 2 * i + (lane >> 5); scr[kk * 33 + (lane & 31)] = (src >= 0) ? W[(size_t)(k0 + kk) * ldw + src] : 0.f; }
    asm volatile("s_waitcnt lgkmcnt(0)" ::: "memory");
    const int c = lane & 7;
#pragma unroll
    for (int j = 0; j < 4; ++j) { const int n = (lane >> 3) + 8 * j; const LAS float* sp = scr + (8 * c) * 33 + n;
        v4u o; o.x = pk2(sp[0 * 33], sp[1 * 33]); o.y = pk2(sp[2 * 33], sp[3 * 33]); o.z = pk2(sp[4 * 33], sp[5 * 33]); o.w = pk2(sp[6 * 33], sp[7 * 33]);
        *(v4u*)(WT + (size_t)(p0 + n) * K + k0 + 8 * c) = o; }
    asm volatile("s_waitcnt lgkmcnt(0)" ::: "memory");
}
__device__ __forceinline__ void convert_small_weights(const float* w_in, const float* w_branch, const float* w_out, bf16* WIN, bf16* WBR, bf16* WOUT, LAS float* scr, int wave, int lane) {
    asm volatile("" : "+s"(wave), "+v"(lane));
    const int gw = blockIdx.x * NWAVES + wave, NGW = gridDim.x * NWAVES;
    constexpr int I_IN = 16 * 240, I_BR = 8 * 32, I_OUT = 16 * 32;
    for (int it = gw; it < I_IN + 3 * I_BR + I_OUT; it += NGW) {
        int r = it;
        if (r < I_IN) { const int kb = r / 240, pb = r % 240; transpose_item(w_in, INC, inproj_src_col(pb * 32 + (lane & 31)), WIN, 1024, pb * 32, kb * 64, scr, lane); continue; } r -= I_IN;
        if (r < 3 * I_BR) { const int br = r / I_BR, q = r % I_BR, kb = q / 32, pb = q % 32; transpose_item(w_branch + (size_t)br * 512 * 1024, 1024, pb * 32 + (lane & 31), WBR + (size_t)br * 1024 * 512, 512, pb * 32, kb * 64, scr, lane); continue; } r -= 3 * I_BR;
        { const int kb = r / 32, pb = r % 32; transpose_item(w_out, 1024, pb * 32 + (lane & 31), WOUT, 1024, pb * 32, kb * 64, scr, lane); }
    }
}

__device__ __forceinline__ void ph_norm2_route_blk(const float* x, const float* gain, bf16* out, const float* wg, const float* bg, const float* we, const float* be,
                                                   int* tok_e, float* tok_w, int* lrank, int* cntblk, LAS int* sE, int tid, int wave, int lane) {
    asm volatile("" : "+v"(tid), "+s"(wave), "+v"(lane));
    LAS int* sR = sE + 128;
    for (int blk = blockIdx.x; blk < 256; blk += gridDim.x) {
        __syncthreads();
#pragma unroll 1
        for (int i = 0; i < 8; ++i) {
            const int m = blk * 64 + wave * 8 + i;
            const f32x4* xr = (const f32x4*)(x + (size_t)m * D_) + lane;
            f32x4 v[4]; float s = 0.f;
#pragma unroll
            for (int j = 0; j < 4; ++j) { v[j] = xr[64 * j]; s += (v[j].x * v[j].x + v[j].y * v[j].y) + (v[j].z * v[j].z + v[j].w * v[j].w); }
            const float r = rsqrtf(wave_sum(s) * (1.f / D_) + EPS);
            v2u* o8 = (v2u*)(out + (size_t)m * D_) + lane;
            float gl[4] = {0.f, 0.f, 0.f, 0.f}; float hn[16];
#pragma unroll
            for (int j = 0; j < 4; ++j) { const f32x4 g = ((const f32x4*)gain)[lane + 64 * j];
                const float h0 = v[j].x * r * g.x, h1 = v[j].y * r * g.y, h2 = v[j].z * r * g.z, h3 = v[j].w * r * g.w;
                v2u w; w.x = pk2(h0, h1); w.y = pk2(h2, h3); o8[64 * j] = w;
                hn[4 * j] = h0; hn[4 * j + 1] = h1; hn[4 * j + 2] = h2; hn[4 * j + 3] = h3;
#pragma unroll
                for (int q = 0; q < 4; ++q) { const int k = 4 * (lane + 64 * j) + q; const f32x4 a = *(const f32x4*)(wg + (size_t)k * 4);
                    gl[0] += hn[4 * j + q] * a.x; gl[1] += hn[4 * j + q] * a.y; gl[2] += hn[4 * j + q] * a.z; gl[3] += hn[4 * j + q] * a.w; } }
#pragma unroll
            for (int q = 0; q < 4; ++q) gl[q] = wave_sum(gl[q]) + bg[q];
            int gs = 0; float gm = gl[0];
#pragma unroll
            for (int q = 1; q < 4; ++q) if (gl[q] > gm) { gm = gl[q]; gs = q; }
            float gsum = 0.f;
#pragma unroll
            for (int q = 0; q < 4; ++q) gsum += __expf(gl[q] - gm);
            const float g_w = 1.f / gsum;
            gs = __builtin_amdgcn_readfirstlane(gs);
            float el[4] = {0.f, 0.f, 0.f, 0.f};
#pragma unroll
            for (int j = 0; j < 4; ++j)
#pragma unroll
                for (int q = 0; q < 4; ++q) { const int k = 4 * (lane + 64 * j) + q; const f32x4 c = *(const f32x4*)(we + (size_t)k * 16 + 4 * gs);
                    el[0] += hn[4 * j + q] * c.x; el[1] += hn[4 * j + q] * c.y; el[2] += hn[4 * j + q] * c.z; el[3] += hn[4 * j + q] * c.w; }
#pragma unroll
            for (int q = 0; q < 4; ++q) el[q] = wave_sum(el[q]) + be[4 * gs + q];
            int i0 = 0; float m0 = el[0];
#pragma unroll
            for (int q = 1; q < 4; ++q) if (el[q] > m0) { m0 = el[q]; i0 = q; }
            int i1 = -1; float m1 = -3.0e38f;
#pragma unroll
            for (int q = 0; q < 4; ++q) if (q != i0 && el[q] > m1) { m1 = el[q]; i1 = q; }
            const float p1 = __expf(m1 - m0);
            if (lane == 0) { const int e0 = gs * 4 + i0, e1 = gs * 4 + i1; tok_e[2 * m] = e0; tok_e[2 * m + 1] = e1; tok_w[2 * m] = g_w / (1.f + p1); tok_w[2 * m + 1] = g_w * p1 / (1.f + p1);
                sE[(wave * 8 + i) * 2] = e0; sE[(wave * 8 + i) * 2 + 1] = e1; }
        }
        __syncthreads();
        if (tid < 16) { int cnt = 0; for (int a = 0; a < 128; ++a) if (sE[a] == tid) { sR[a] = cnt; ++cnt; } cntblk[blk * 16 + tid] = cnt; }
        __syncthreads();
        if (tid < 128) lrank[blk * 128 + tid] = sR[tid];
    }
}
__device__ __forceinline__ void convert_expert_weights(const float* wgate, const float* wup, const float* wdown, bf16* W1, bf16* WD, LAS float* scr, int wave, int lane) {
    asm volatile("" : "+s"(wave), "+v"(lane));
    const int gw = blockIdx.x * NWAVES + wave, NGW = gridDim.x * NWAVES;
    for (int it = gw; it < 16 * 768; it += NGW) {
        const int e = it / 768; int r = it - e * 768;
        if (r < 512) { const int kb = r >> 5, pb = r & 31, t = pb >> 3, sub = pb & 7; const float* src = ((sub < 4) ? wgate : wup) + (size_t)e * 1024 * 512;
            transpose_item(src, 512, 128 * t + (sub & 3) * 32 + (lane & 31), W1 + (size_t)e * 1024 * 1024, 1024, pb * 32, kb * 64, scr, lane); }
        else { r -= 512; const int kb = r >> 5, pb = r & 31; transpose_item(wdown + (size_t)e * 512 * 1024, 1024, pb * 32 + (lane & 31), WD + (size_t)e * 1024 * 512, 512, pb * 32, kb * 64, scr, lane); }
    }
}
__device__ __forceinline__ void ph_moe_scatter(const bf16* HB, bf16* HS, const int* tok_e, const float* tok_w, const int* lrank, const int* cntblk, int* rowtok, float* roww, int* rowof,
                                               LAS int* sPre, LAS int* sRow, LAS int* sTb, LAS int* sTot, int tid, int wave, int lane) {
    asm volatile("" : "+v"(tid), "+s"(wave), "+v"(lane));
    __syncthreads();
    { LAS int* sCnt = sPre + 4096; LAS int* sSeg = sPre + 8192;
#pragma unroll
      for (int i = 0; i < 8; ++i) sCnt[tid + i * NTHR] = cntblk[tid + i * NTHR];
      __syncthreads();
      const int e = tid & 15, seg = tid >> 4; int loc = 0;
#pragma unroll
      for (int j = 0; j < 8; ++j) loc += sCnt[(seg * 8 + j) * 16 + e];
      sSeg[seg * 16 + e] = loc;
      __syncthreads();
      if (tid < 16) { int run = 0; for (int sg = 0; sg < 32; ++sg) { const int t = sSeg[sg * 16 + tid]; sSeg[sg * 16 + tid] = run; run += t; } sTot[tid] = run; }
      __syncthreads();
      int run = sSeg[seg * 16 + e];
#pragma unroll
      for (int j = 0; j < 8; ++j) { sPre[(seg * 8 + j) * 16 + e] = run; run += sCnt[(seg * 8 + j) * 16 + e]; } }
    __syncthreads();
    if (tid == 0) { int t = 0; for (int e = 0; e < 16; ++e) { sTb[e] = t; t += (sTot[e] + 255) >> 8; } sTb[16] = t; }
    __syncthreads();
    for (int e = blockIdx.x; e < 16; e += gridDim.x) { const int r1 = sTb[e + 1] * 256; for (int r = sTb[e] * 256 + sTot[e] + tid; r < r1; r += NTHR) { rowtok[r] = -1; roww[r] = 0.f; } }
    for (int blk = blockIdx.x; blk < 256; blk += gridDim.x) {
        __syncthreads();
        if (tid < 128) { const int t = blk * 64 + (tid >> 1); const int e = tok_e[2 * t + (tid & 1)];
            const int row = sTb[e] * 256 + sPre[blk * 16 + e] + lrank[blk * 128 + tid]; rowtok[row] = t; roww[row] = tok_w[2 * t + (tid & 1)]; rowof[2 * t + (tid & 1)] = row; sRow[tid] = row; }
        __syncthreads();
        for (int a = wave; a < 128; a += NWAVES) { const int t = blk * 64 + (a >> 1); const int row = sRow[a];
            const v4u* src = (const v4u*)(HB + (size_t)t * D_); v4u* dst = (v4u*)(HS + (size_t)row * D_); const v4u a0 = src[lane], a1 = src[lane + 64]; dst[lane] = a0; dst[lane + 64] = a1; }
    }
}
namespace pg8 {
struct MoeOrder {
    int G, c; const char* A; size_t tsA; const char* B; size_t strideE, tsB; const LAS int* tb;
    __device__ __forceinline__ bool next(int i, Unit& u) const {
        const int uu = c + i * G; const int TT = __builtin_amdgcn_readfirstlane(tb[16]); if (uu >= 4 * TT) return false;
        const int grt = uu >> 2; u.pm = grt; u.pn = uu & 3; int e = 0;
#pragma unroll
        for (int k = 1; k < 16; ++k) e += (grt >= __builtin_amdgcn_readfirstlane(tb[k])) ? 1 : 0;
        u.aux = e; return true; }
    __device__ __forceinline__ const char* abase(const Unit& u) const { return A + (size_t)u.pm * tsA; }
    __device__ __forceinline__ const char* bbase(const Unit& u) const { return B + (size_t)u.aux * strideE + (size_t)u.pn * tsB; }
};
struct EpiMoe1 {
    bf16* HID;
    __device__ __forceinline__ void operator()(const f32x4 (&acc)[2][2][4][2], const Unit& u, int wr, int wc, int fr, int fq) const {
        asm volatile("" : "+v"(fr), "+v"(fq), "+s"(wr), "+s"(wc));
        const size_t row0 = (size_t)u.pm * BM + wr * 64 + fr; const int col = u.pn * 128 + 32 * wc + 8 * fq;
#pragma unroll
        for (int ai = 0; ai < 2; ++ai)
#pragma unroll
            for (int m = 0; m < 4; ++m) {
                f32x4 h0, h1;
#pragma unroll
                for (int i = 0; i < 4; ++i) { const float g0 = acc[ai][0][m][0][i], g1 = acc[ai][0][m][1][i];
                    h0[i] = g0 * __builtin_amdgcn_rcpf(1.f + __expf(-g0)) * acc[ai][1][m][0][i]; h1[i] = g1 * __builtin_amdgcn_rcpf(1.f + __expf(-g1)) * acc[ai][1][m][1][i]; }
                *(v4u*)(HID + (row0 + ai * HALF + m * 16) * 512 + col) = pack8(h0, h1);
            }
    }
};
struct EpiMoe2 {
    const float* roww; bf16* Y;
    __device__ __forceinline__ void operator()(const f32x4 (&acc)[2][2][4][2], const Unit& u, int wr, int wc, int fr, int fq) const {
        asm volatile("" : "+v"(fr), "+v"(fq), "+s"(wr), "+s"(wc));
        const size_t row0 = (size_t)u.pm * BM + wr * 64 + fr; const int col0 = u.pn * BM + 32 * wc + 8 * fq;
#pragma unroll
        for (int ai = 0; ai < 2; ++ai)
#pragma unroll
            for (int m = 0; m < 4; ++m) { const size_t grow = row0 + ai * HALF + m * 16; const float w = roww[grow];
#pragma unroll
                for (int bj = 0; bj < 2; ++bj) *(v4u*)(Y + grow * D_ + col0 + bj * HALF) = pack8(acc[ai][bj][m][0] * w, acc[ai][bj][m][1] * w); }
    }
};
}

namespace mm {
typedef short bf16x8 __attribute__((ext_vector_type(8)));
constexpr int LD = 72;
__device__ __forceinline__ bf16x8 frag(const LAS bf16* M, int r0, int k0, int lane) { return *(const LAS bf16x8*)(M + (r0 + (lane & 15)) * LD + k0 + 8 * (lane >> 4)); }
__device__ __forceinline__ bf16x8 frag_g(const float* M, int r0, int k0, int lane) {
    const float* p = M + (size_t)(r0 + (lane & 15)) * 64 + k0 + 8 * (lane >> 4); const f32x4 a = *(const f32x4*)p, b = *(const f32x4*)(p + 4);
    const v4u w = pg8::pack8(a, b); return __builtin_bit_cast(bf16x8, w); }
__device__ __forceinline__ f32x4 mma(bf16x8 xf, bf16x8 yf, f32x4 acc) { return __builtin_amdgcn_mfma_f32_16x16x32_bf16(xf, yf, acc, 0, 0, 0); }
__device__ __forceinline__ float wave_incl_scan(float v, int lane) {
#pragma unroll
    for (int o = 1; o < 64; o <<= 1) { const float t = __shfl_up(v, o); if (lane >= o) v += t; }
    return v; }
}
constexpr int GST_CH = 8192, SST_CH = 4096;

__device__ __forceinline__ void gla_bcum(const float* SML, const float* w_lr, const float* b_gate, LAS float* BC, LAS float* BL, size_t row0, int h, int wave, int lane) {
    const float* gp = SML + (row0 + lane) * SMLP + 8;
    const f32x4 g0 = *(const f32x4*)gp, g1 = *(const f32x4*)(gp + 4), g2 = *(const f32x4*)(gp + 8), g3 = *(const f32x4*)(gp + 12);
    const float gl[16] = {g0[0], g0[1], g0[2], g0[3], g1[0], g1[1], g1[2], g1[3], g2[0], g2[1], g2[2], g2[3], g3[0], g3[1], g3[2], g3[3]};
#pragma unroll
    for (int dd = 0; dd < 8; ++dd) { const int d = wave * 8 + dd, col = h * 64 + d;
        float z = b_gate[col];
#pragma unroll
        for (int j = 0; j < 16; ++j) z += gl[j] * w_lr[j * 256 + col];
        const float bc = mm::wave_incl_scan(logsig_f(z) * (1.f / 16.f), lane);
        BC[lane * 64 + d] = bc; if (lane == 63) BL[d] = bc; }
}
__device__ __forceinline__ void gla_stage_vt(const bf16* GLA, LAS bf16* VT, size_t row0, int h, int tid) {
#pragma unroll
    for (int j = 0; j < 2; ++j) { const int idx = tid + j * NTHR, s = idx >> 4, vg = idx & 15;
        const v4u w = *(const v4u*)(GLA + (row0 + s) * GLAP + 512 + h * 128 + vg * 8); LAS bf16* o = VT + (vg * 8) * mm::LD + s;
        o[0] = (bf16)(w.x & 0xffffu); o[mm::LD] = (bf16)(w.x >> 16); o[2 * mm::LD] = (bf16)(w.y & 0xffffu); o[3 * mm::LD] = (bf16)(w.y >> 16);
        o[4 * mm::LD] = (bf16)(w.z & 0xffffu); o[5 * mm::LD] = (bf16)(w.z >> 16); o[6 * mm::LD] = (bf16)(w.w & 0xffffu); o[7 * mm::LD] = (bf16)(w.w >> 16); }
}
__device__ __forceinline__ void gla_local_unit(const bf16* GLA, const float* SML, const float* w_lr, const float* b_gate, float* GST, float* GDEC, LAS unsigned char* L8, int bh, int c, int tid, int wave, int lane) {
    LAS float* BC = (LAS float*)L8; LAS float* BL = (LAS float*)(L8 + 16384); LAS bf16* KE = (LAS bf16*)(L8 + 16640); LAS bf16* VT = (LAS bf16*)(L8 + 25856);
    const int b = bh >> 2, h = bh & 3; const size_t row0 = (size_t)b * S_ + (size_t)c * 64;
    __syncthreads();
    gla_bcum(SML, w_lr, b_gate, BC, BL, row0, h, wave, lane);
    __syncthreads();
    { const int s = tid >> 3, dg = tid & 7; const v4u w = *(const v4u*)(GLA + (row0 + s) * GLAP + 256 + h * 64 + dg * 8);
      const float kf[8] = {bf2f(w.x & 0xffffu), bf2f(w.x >> 16), bf2f(w.y & 0xffffu), bf2f(w.y >> 16), bf2f(w.z & 0xffffu), bf2f(w.z >> 16), bf2f(w.w & 0xffffu), bf2f(w.w >> 16)};
#pragma unroll
      for (int i = 0; i < 8; ++i) { const int d = dg * 8 + i; KE[d * mm::LD + s] = (bf16)f2bf(kf[i] * __expf(BL[d] - BC[s * 64 + d])); } }
    gla_stage_vt(GLA, VT, row0, h, tid);
    if (tid < 64) GDEC[((size_t)bh * 128 + c) * 64 + tid] = __expf(BL[tid]);
    __syncthreads();
    f32x4 acc[4];
#pragma unroll
    for (int i = 0; i < 4; ++i) acc[i] = (f32x4){0.f, 0.f, 0.f, 0.f};
#pragma unroll
    for (int kk = 0; kk < 64; kk += 32) { const mm::bf16x8 yf = mm::frag(VT, wave * 16, kk, lane);
#pragma unroll
        for (int dt = 0; dt < 4; ++dt) acc[dt] = mm::mma(mm::frag(KE, dt * 16, kk, lane), yf, acc[dt]); }
    float* dst = GST + ((size_t)bh * 128 + c) * GST_CH + (size_t)(wave * 16 + (lane & 15)) * 64 + 4 * (lane >> 4);
#pragma unroll
    for (int dt = 0; dt < 4; ++dt) *(f32x4*)(dst + dt * 16) = acc[dt];
}
__device__ __forceinline__ void gla_out_unit(bf16* GLA, const float* SML, const float* w_lr, const float* b_gate, const float* GST, const float* gla_norm, LAS unsigned char* L8, int bh, int c, int tid, int wave, int lane) {
    LAS float* BC = (LAS float*)L8; LAS float* BL = (LAS float*)(L8 + 16384); LAS bf16* QD = (LAS bf16*)(L8 + 16640); LAS bf16* KD = (LAS bf16*)(L8 + 25856);
    LAS bf16* VT = (LAS bf16*)(L8 + 35072); LAS bf16* AL = (LAS bf16*)(L8 + 53504); LAS float* RED = (LAS float*)(L8 + 62720);
    const int b = bh >> 2, h = bh & 3; const size_t row0 = (size_t)b * S_ + (size_t)c * 64;
    __syncthreads();
    gla_bcum(SML, w_lr, b_gate, BC, BL, row0, h, wave, lane);
    __syncthreads();
    { const int s = tid >> 3, dg = tid & 7; const v4u wq = *(const v4u*)(GLA + (row0 + s) * GLAP + h * 64 + dg * 8), wk = *(const v4u*)(GLA + (row0 + s) * GLAP + 256 + h * 64 + dg * 8);
      const float qf[8] = {bf2f(wq.x & 0xffffu), bf2f(wq.x >> 16), bf2f(wq.y & 0xffffu), bf2f(wq.y >> 16), bf2f(wq.z & 0xffffu), bf2f(wq.z >> 16), bf2f(wq.w & 0xffffu), bf2f(wq.w >> 16)};
      const float kf[8] = {bf2f(wk.x & 0xffffu), bf2f(wk.x >> 16), bf2f(wk.y & 0xffffu), bf2f(wk.y >> 16), bf2f(wk.z & 0xffffu), bf2f(wk.z >> 16), bf2f(wk.w & 0xffffu), bf2f(wk.w >> 16)};
      float qd[8], kd[8];
#pragma unroll
      for (int i = 0; i < 8; ++i) { const float bc = BC[s * 64 + dg * 8 + i]; qd[i] = qf[i] * 0.125f * __expf(bc); kd[i] = kf[i] * __expf(-bc); }
      v4u o; o.x = pk2(qd[0], qd[1]); o.y = pk2(qd[2], qd[3]); o.z = pk2(qd[4], qd[5]); o.w = pk2(qd[6], qd[7]); *(LAS v4u*)(QD + s * mm::LD + dg * 8) = o;
      o.x = pk2(kd[0], kd[1]); o.y = pk2(kd[2], kd[3]); o.z = pk2(kd[4], kd[5]); o.w = pk2(kd[6], kd[7]); *(LAS v4u*)(KD + s * mm::LD + dg * 8) = o; }
    gla_stage_vt(GLA, VT, row0, h, tid);
    __syncthreads();
#pragma unroll
    for (int ii = 0; ii < 2; ++ii) { const int id = wave + 8 * ii, tt = id >> 2, st = id & 3;
        f32x4 a = (f32x4){0.f, 0.f, 0.f, 0.f};
        if (st <= tt) {
#pragma unroll
            for (int kk = 0; kk < 64; kk += 32) a = mm::mma(mm::frag(KD, st * 16, kk, lane), mm::frag(QD, tt * 16, kk, lane), a); }
        const int t = tt * 16 + (lane & 15), s0 = st * 16 + 4 * (lane >> 4);
        v2u w; w.x = pk2(s0 <= t ? a[0] : 0.f, s0 + 1 <= t ? a[1] : 0.f); w.y = pk2(s0 + 2 <= t ? a[2] : 0.f, s0 + 3 <= t ? a[3] : 0.f);
        *(LAS v2u*)(AL + t * mm::LD + s0) = w; }
    __syncthreads();
    const int tt = wave & 3, vh = wave >> 2;
    const float* Sc = GST + ((size_t)bh * 128 + c) * GST_CH;
    f32x4 acc[4];
#pragma unroll
    for (int i = 0; i < 4; ++i) acc[i] = (f32x4){0.f, 0.f, 0.f, 0.f};
#pragma unroll
    for (int kk = 0; kk < 64; kk += 32) { const mm::bf16x8 yq = mm::frag(QD, tt * 16, kk, lane), ya = mm::frag(AL, tt * 16, kk, lane);
#pragma unroll
        for (int j = 0; j < 4; ++j) { acc[j] = mm::mma(mm::frag_g(Sc, (vh * 4 + j) * 16, kk, lane), yq, acc[j]); acc[j] = mm::mma(mm::frag(VT, (vh * 4 + j) * 16, kk, lane), ya, acc[j]); } }
    float ss = 0.f;
#pragma unroll
    for (int j = 0; j < 4; ++j) ss += (acc[j][0] * acc[j][0] + acc[j][1] * acc[j][1]) + (acc[j][2] * acc[j][2] + acc[j][3] * acc[j][3]);
    ss += __shfl_xor(ss, 16); ss += __shfl_xor(ss, 32);
    const int t = tt * 16 + (lane & 15);
    if (lane < 16) RED[vh * 64 + t] = ss;
    __syncthreads();
    const float rs = rsqrtf((RED[t] + RED[64 + t]) * (1.f / 128.f) + EPS);
#pragma unroll
    for (int j = 0; j < 4; ++j) { const int v = (vh * 4 + j) * 16 + 4 * (lane >> 4);
        const f32x4 gn = *(const f32x4*)(gla_norm + v); bf16* gp = GLA + (row0 + t) * GLAP + 1024 + h * 128 + v; const v2u gr = *(const v2u*)gp;
        v2u o; o.x = pk2(acc[j][0] * rs * gn[0] * silu_f(bf2f(gr.x & 0xffffu)), acc[j][1] * rs * gn[1] * silu_f(bf2f(gr.x >> 16)));
        o.y = pk2(acc[j][2] * rs * gn[2] * silu_f(bf2f(gr.y & 0xffffu)), acc[j][3] * rs * gn[3] * silu_f(bf2f(gr.y >> 16))); *(v2u*)gp = o; }
}
__device__ __forceinline__ void ssd_acs(const float* SML, const float* a_log, LAS float* ACS, LAS float* DT, LAS float* AL4, size_t row0, int g, int wave, int lane) {
    if (wave < 4) { const float dt = SML[(row0 + lane) * SMLP + 24 + 4 * g + wave]; const float a = -__expf(a_log[4 * g + wave]);
        const float v = mm::wave_incl_scan(dt * a, lane); ACS[lane * 4 + wave] = v; DT[lane * 4 + wave] = dt; if (lane == 63) AL4[wave] = v; }
}
__device__ __forceinline__ void ssd_conv8(const bf16* SSM, const float* conv_w, const float* conv_b, int b, int s, int ch0, float (&out)[8]) {
    const f32x4 b0 = *(const f32x4*)(conv_b + ch0), b1 = *(const f32x4*)(conv_b + ch0 + 4);
    float acc[8] = {b0[0], b0[1], b0[2], b0[3], b1[0], b1[1], b1[2], b1[3]};
#pragma unroll
    for (int j = 0; j < 4; ++j) { const int sp = s - 3 + j;
        if (sp >= 0) { const v4u w = *(const v4u*)(SSM + ((size_t)b * S_ + sp) * SSMP + 512 + ch0);
            const f32x4 w0 = *(const f32x4*)(conv_w + j * 768 + ch0), w1 = *(const f32x4*)(conv_w + j * 768 + ch0 + 4);
            acc[0] += w0[0] * bf2f(w.x & 0xffffu); acc[1] += w0[1] * bf2f(w.x >> 16); acc[2] += w0[2] * bf2f(w.y & 0xffffu); acc[3] += w0[3] * bf2f(w.y >> 16);
            acc[4] += w1[0] * bf2f(w.z & 0xffffu); acc[5] += w1[1] * bf2f(w.z >> 16); acc[6] += w1[2] * bf2f(w.w & 0xffffu); acc[7] += w1[3] * bf2f(w.w >> 16); } }
#pragma unroll
    for (int i = 0; i < 8; ++i) out[i] = silu_f(acc[i]);
}
__device__ __forceinline__ void ssd_local_unit(const bf16* SSM, const float* SML, const float* conv_w, const float* conv_b, const float* a_log, float* SST, float* SDEC, LAS unsigned char* L8, int bg, int c, int tid, int wave, int lane) {
    LAS float* ACS = (LAS float*)L8; LAS float* DT = (LAS float*)(L8 + 1024); LAS float* AL4 = (LAS float*)(L8 + 2048); LAS bf16* XE = (LAS bf16*)(L8 + 2304); LAS bf16* BT = (LAS bf16*)(L8 + 39168);
    const int b = bg >> 1, g = bg & 1; const size_t row0 = (size_t)b * S_ + (size_t)c * 64;
    __syncthreads();
    ssd_acs(SML, a_log, ACS, DT, AL4, row0, g, wave, lane);
    __syncthreads();
#pragma unroll 1
    for (int it = tid; it < 64 * 40; it += NTHR) { const int t = it / 40, cg = it - t * 40; float v[8];
        if (cg < 32) { ssd_conv8(SSM, conv_w, conv_b, b, c * 64 + t, g * 256 + cg * 8, v); const int hh = cg >> 3, p0 = (cg & 7) * 8;
            const float sc = DT[t * 4 + hh] * __expf(AL4[hh] - ACS[t * 4 + hh]); LAS bf16* o = XE + (hh * 64 + p0) * mm::LD + t;
#pragma unroll
            for (int i = 0; i < 8; ++i) o[i * mm::LD] = (bf16)f2bf(v[i] * sc); }
        else { ssd_conv8(SSM, conv_w, conv_b, b, c * 64 + t, 512 + g * 64 + (cg - 32) * 8, v); LAS bf16* o = BT + ((cg - 32) * 8) * mm::LD + t;
#pragma unroll
            for (int i = 0; i < 8; ++i) o[i * mm::LD] = (bf16)f2bf(v[i]); } }
    if (tid < 4) SDEC[((size_t)(b * 8 + 4 * g + tid)) * 128 + c] = __expf(AL4[tid]);
    __syncthreads();
    const int hh = wave >> 1;
    f32x4 acc[2][4];
#pragma unroll
    for (int j = 0; j < 2; ++j)
#pragma unroll
        for (int n = 0; n < 4; ++n) acc[j][n] = (f32x4){0.f, 0.f, 0.f, 0.f};
#pragma unroll
    for (int kk = 0; kk < 64; kk += 32)
#pragma unroll
        for (int j = 0; j < 2; ++j) { const mm::bf16x8 yf = mm::frag(XE + hh * 64 * mm::LD, ((wave & 1) * 2 + j) * 16, kk, lane);
#pragma unroll
            for (int n = 0; n < 4; ++n) acc[j][n] = mm::mma(mm::frag(BT, n * 16, kk, lane), yf, acc[j][n]); }
    float* dst = SST + ((size_t)(b * 8 + 4 * g + hh) * 128 + c) * SST_CH + 4 * (lane >> 4);
#pragma unroll
    for (int j = 0; j < 2; ++j) { const int p = ((wave & 1) * 2 + j) * 16 + (lane & 15);
#pragma unroll
        for (int n = 0; n < 4; ++n) *(f32x4*)(dst + (size_t)p * 64 + n * 16) = acc[j][n]; }
}
__device__ __forceinline__ void ssd_out_unit(bf16* SSM, const float* SML, const float* conv_w, const float* conv_b, const float* a_log, const float* d_skip, const float* ssm_norm, const float* SST,
                                             LAS unsigned char* L8, int bg, int c, int tid, int wave, int lane) {
    LAS float* ACS = (LAS float*)L8; LAS float* DT = (LAS float*)(L8 + 1024); LAS float* AL4 = (LAS float*)(L8 + 2048); LAS bf16* XT = (LAS bf16*)(L8 + 2304);
    LAS bf16* BM = (LAS bf16*)(L8 + 39168); LAS bf16* CM = (LAS bf16*)(L8 + 48384); LAS bf16* SCL = (LAS bf16*)(L8 + 57600); LAS float* RED = (LAS float*)(L8 + 94464);
    const int b = bg >> 1, g = bg & 1; const size_t row0 = (size_t)b * S_ + (size_t)c * 64;
    __syncthreads();
    ssd_acs(SML, a_log, ACS, DT, AL4, row0, g, wave, lane);
#pragma unroll 1
    for (int it = tid; it < 64 * 48; it += NTHR) { const int t = it / 48, cg = it - t * 48; float v[8];
        if (cg < 32) { ssd_conv8(SSM, conv_w, conv_b, b, c * 64 + t, g * 256 + cg * 8, v); LAS bf16* o = XT + ((cg >> 3) * 64 + (cg & 7) * 8) * mm::LD + t;
#pragma unroll
            for (int i = 0; i < 8; ++i) o[i * mm::LD] = (bf16)f2bf(v[i]); }
        else { const bool isb = cg < 40; const int n0 = (cg - (isb ? 32 : 40)) * 8; ssd_conv8(SSM, conv_w, conv_b, b, c * 64 + t, (isb ? 512 : 640) + g * 64 + n0, v);
            v4u o; o.x = pk2(v[0], v[1]); o.y = pk2(v[2], v[3]); o.z = pk2(v[4], v[5]); o.w = pk2(v[6], v[7]); *(LAS v4u*)((isb ? BM : CM) + t * mm::LD + n0) = o; } }
    __syncthreads();
#pragma unroll
    for (int ii = 0; ii < 2; ++ii) { const int id = wave + 8 * ii, tt = id >> 2, st = id & 3;
        f32x4 a = (f32x4){0.f, 0.f, 0.f, 0.f};
        if (st <= tt) {
#pragma unroll
            for (int kk = 0; kk < 64; kk += 32) a = mm::mma(mm::frag(BM, st * 16, kk, lane), mm::frag(CM, tt * 16, kk, lane), a); }
        const int t = tt * 16 + (lane & 15), s0 = st * 16 + 4 * (lane >> 4);
#pragma unroll
        for (int hh = 0; hh < 4; ++hh) { const float at = ACS[t * 4 + hh]; float sc[4];
#pragma unroll
            for (int r = 0; r < 4; ++r) sc[r] = (s0 + r <= t) ? a[r] * __expf(at - ACS[(s0 + r) * 4 + hh]) * DT[(s0 + r) * 4 + hh] : 0.f;
            v2u w; w.x = pk2(sc[0], sc[1]); w.y = pk2(sc[2], sc[3]); *(LAS v2u*)(SCL + (hh * 64 + t) * mm::LD + s0) = w; } }
    __syncthreads();
    const int hh = wave >> 1, head = 4 * g + hh;
    const float* Sc = SST + ((size_t)(b * 8 + head) * 128 + c) * SST_CH;
    f32x4 acc[2][4];
#pragma unroll
    for (int j = 0; j < 2; ++j)
#pragma unroll
        for (int n = 0; n < 4; ++n) acc[j][n] = (f32x4){0.f, 0.f, 0.f, 0.f};
#pragma unroll
    for (int kk = 0; kk < 64; kk += 32) { mm::bf16x8 xf[4];
#pragma unroll
        for (int n = 0; n < 4; ++n) xf[n] = mm::frag_g(Sc, n * 16, kk, lane);
#pragma unroll
        for (int j = 0; j < 2; ++j) { const mm::bf16x8 yf = mm::frag(CM, ((wave & 1) * 2 + j) * 16, kk, lane);
#pragma unroll
            for (int n = 0; n < 4; ++n) acc[j][n] = mm::mma(xf[n], yf, acc[j][n]); } }
#pragma unroll
    for (int j = 0; j < 2; ++j) { const float e = __expf(ACS[(((wave & 1) * 2 + j) * 16 + (lane & 15)) * 4 + hh]);
#pragma unroll
        for (int n = 0; n < 4; ++n) acc[j][n] *= e; }
#pragma unroll
    for (int kk = 0; kk < 64; kk += 32)
#pragma unroll
        for (int j = 0; j < 2; ++j) { const mm::bf16x8 yf = mm::frag(SCL + hh * 64 * mm::LD, ((wave & 1) * 2 + j) * 16, kk, lane);
#pragma unroll
            for (int n = 0; n < 4; ++n) acc[j][n] = mm::mma(mm::frag(XT + hh * 64 * mm::LD, n * 16, kk, lane), yf, acc[j][n]); }
    const float Dk = d_skip[head];
#pragma unroll
    for (int j = 0; j < 2; ++j) { const int t = ((wave & 1) * 2 + j) * 16 + (lane & 15); float ss = 0.f;
#pragma unroll
        for (int n = 0; n < 4; ++n) { const int p = n * 16 + 4 * (lane >> 4); const v2u zz = *(const v2u*)(SSM + (row0 + t) * SSMP + head * 64 + p);
            const float zf[4] = {bf2f(zz.x & 0xffffu), bf2f(zz.x >> 16), bf2f(zz.y & 0xffffu), bf2f(zz.y >> 16)};
#pragma unroll
            for (int r = 0; r < 4; ++r) { const float xs = bf2f(XT[(hh * 64 + p + r) * mm::LD + t]); const float y = (acc[j][n][r] + Dk * xs) * silu_f(zf[r]); acc[j][n][r] = y; ss += y * y; } }
        ss += __shfl_xor(ss, 16); ss += __shfl_xor(ss, 32);
        if (lane < 16) RED[hh * 64 + t] = ss; }
    __syncthreads();
#pragma unroll
    for (int j = 0; j < 2; ++j) { const int t = ((wave & 1) * 2 + j) * 16 + (lane & 15);
        const float rs = rsqrtf(((RED[t] + RED[64 + t]) + (RED[128 + t] + RED[192 + t])) * (1.f / 256.f) + EPS);
#pragma unroll
        for (int n = 0; n < 4; ++n) { const int p = n * 16 + 4 * (lane >> 4); const f32x4 gn = *(const f32x4*)(ssm_norm + g * 256 + hh * 64 + p);
            v2u o; o.x = pk2(acc[j][n][0] * rs * gn[0], acc[j][n][1] * rs * gn[1]); o.y = pk2(acc[j][n][2] * rs * gn[2], acc[j][n][3] * rs * gn[3]);
            *(v2u*)(SSM + (row0 + t) * SSMP + head * 64 + p) = o; } }
}
__device__ __forceinline__ void ph_scan(float* GST, const float* GDEC, float* SST, const float* SDEC, int tid) {
    asm volatile("" : "+v"(tid));
    for (int e = blockIdx.x * NTHR + tid; e < 131072; e += gridDim.x * NTHR) {
        const bool isg = e < 65536; const int ee = isg ? e : e - 65536;
        const int bh = isg ? (ee >> 13) : (ee >> 12), el = isg ? (ee & 8191) : (ee & 4095), chs = isg ? GST_CH : SST_CH;
        float* base = (isg ? GST : SST) + (size_t)bh * 128 * chs + el; const float* dec = isg ? GDEC + (size_t)bh * 128 * 64 + (el & 63) : SDEC + (size_t)bh * 128; const int dst = isg ? 64 : 1;
        float S = 0.f;
#pragma unroll 1
        for (int c0 = 0; c0 < 128; c0 += 8) { float kv[8], dc[8];
#pragma unroll
            for (int i = 0; i < 8; ++i) { kv[i] = base[(size_t)(c0 + i) * chs]; dc[i] = dec[(size_t)(c0 + i) * dst]; }
#pragma unroll
            for (int i = 0; i < 8; ++i) { base[(size_t)(c0 + i) * chs] = S; S = dc[i] * S + kv[i]; } }
    }
}
__device__ __forceinline__ void ph_local(const float* SML, float* CUM, const bf16* GLA, const bf16* SSM, const float* w_lr, const float* b_gate, const float* conv_w, const float* conv_b, const float* a_log,
                                         float* GST, float* GDEC, float* SST, float* SDEC, LAS unsigned char* L8, int tid, int wave, int lane) {
    asm volatile("" : "+v"(tid), "+s"(wave), "+v"(lane));
    for (int u = blockIdx.x; u < 1024 + 512; u += gridDim.x) {
        if (u < 1024) gla_local_unit(GLA, SML, w_lr, b_gate, GST, GDEC, L8, u >> 7, u & 127, tid, wave, lane);
        else ssd_local_unit(SSM, SML, conv_w, conv_b, a_log, SST, SDEC, L8, (u - 1024) >> 7, (u - 1024) & 127, tid, wave, lane);
    }
}
__device__ __forceinline__ void ph_mixout(bf16* GLA, bf16* SSM, const float* SML, const float* w_lr, const float* b_gate, const float* gla_norm, const float* conv_w, const float* conv_b, const float* a_log, const float* d_skip,
                                          const float* ssm_norm, const float* GST, const float* SST, LAS unsigned char* L8, int tid, int wave, int lane) {
    asm volatile("" : "+v"(tid), "+s"(wave), "+v"(lane));
    for (int u = blockIdx.x; u < 1024 + 512; u += gridDim.x) {
        if (u < 1024) gla_out_unit(GLA, SML, w_lr, b_gate, GST, gla_norm, L8, u >> 7, u & 127, tid, wave, lane);
        else ssd_out_unit(SSM, SML, conv_w, conv_b, a_log, d_skip, ssm_norm, SST, L8, (u - 1024) >> 7, (u - 1024) & 127, tid, wave, lane);
    }
}

namespace attn_body {
using bf16=__hip_bfloat16;
using bf16x8=__attribute__((ext_vector_type(8)))short;
using s16x4=__attribute__((ext_vector_type(4)))short;
using f32x16=__attribute__((ext_vector_type(16)))float;
using u32x4=__attribute__((ext_vector_type(4)))unsigned;
using f32x4g=__attribute__((ext_vector_type(4)))float;
constexpr int BATCH=2,NHEAD=8,SEQ=8192,D=64,PITCH=1536;
constexpr int NW=8,QBLK=32,QB=QBLK*NW,KVBLK=64,NQB=SEQ/QB;
constexpr int ATTN_PITCH=PITCH, ATTN_UNIT_ROWS=QB;
__device__ __forceinline__ int crow(int r,int hi){return (r&3)+8*(r>>2)+4*hi;}
#define SBAR() __builtin_amdgcn_sched_barrier(0)
__device__ __forceinline__ void cmask(f32x16&p0,f32x16&p1,int jb,int qrel,int hi){
  const float NEG=-INFINITY; int kb=64*jb+4*hi;
  #pragma unroll
  for(int r=0;r<16;++r){int kv=kb+(r&3)+8*(r>>2); if(kv>qrel)p0[r]=NEG; if(kv+32>qrel)p1[r]=NEG;}
}

constexpr int NSLOT=3, SLOTB=8192;
constexpr int LDS_K=0, LDS_V=NSLOT*SLOTB, LDS_WS=2*NSLOT*SLOTB, LDS_OST=LDS_WS+NW*64*4, LDS_C=LDS_OST+NW*4096, LDS_BYTES=LDS_C+SEQ*4;
constexpr float C2=0.125f*1.4426950408889634f;
__device__ __forceinline__ void glds16(const void*gsrc,unsigned lds_dst){unsigned keep;
  asm volatile("s_mov_b32 %0, m0\n\ts_mov_b32 m0, %2\n\ts_nop 0\n\tglobal_load_lds_dwordx4 %1, off\n\ts_mov_b32 m0, %0":"=&s"(keep):"v"(gsrc),"s"(lds_dst):"memory");}
__device__ __forceinline__ float max3f(float a,float b,float c){float r;asm("v_max3_f32 %0, %1, %2, %3":"=v"(r):"v"(a),"v"(b),"v"(c));return r;}
__device__ __forceinline__ float max2f(float a,float b){float r;asm("v_max_f32_e32 %0, %1, %2":"=v"(r):"v"(a),"v"(b));return r;}
__device__ __forceinline__ float fadd_s(float a,float b){float r;asm("v_add_f32_e32 %0, %1, %2":"=v"(r):"v"(a),"v"(b));return r;}
__device__ __forceinline__ float fsub_s(float a,float b){float r;asm("v_sub_f32_e32 %0, %1, %2":"=v"(r):"v"(a),"v"(b));return r;}
typedef float f32x2_t __attribute__((ext_vector_type(2))); typedef __bf16 bf16x2_t __attribute__((ext_vector_type(2)));
__device__ __forceinline__ unsigned cvtpk_s(float lo,float hi){f32x2_t v={lo,hi};bf16x2_t b=__builtin_convertvector(v,bf16x2_t);return __builtin_bit_cast(unsigned,b);}
#define WAIT_BAR(N) asm volatile("s_waitcnt vmcnt(" #N ") lgkmcnt(0)\n\ts_barrier":::"memory")

__device__ __forceinline__ void qkt(f32x16&p0,f32x16&p1,const char*Kslot,const bf16x8*qr,int r32,int hi){
  const char*kb=Kslot+hi*1024+r32*16;
  #pragma unroll
  for(int d0=0;d0<4;++d0){
    const bf16x8 b0=*reinterpret_cast<const bf16x8*>(kb+d0*2048);
    const bf16x8 b1=*reinterpret_cast<const bf16x8*>(kb+d0*2048+512);
    {p0=__builtin_amdgcn_mfma_f32_32x32x16_bf16(b0,qr[d0],p0,0,0,0);p1=__builtin_amdgcn_mfma_f32_32x32x16_bf16(b1,qr[d0],p1,0,0,0);}}
}
typedef __attribute__((address_space(3))) const char* lds_cptr;
typedef short v4i16_t __attribute__((ext_vector_type(4)));
__device__ __forceinline__ void kload8(bf16x8*kf,lds_cptr kp){
  kf[0]=*(const __attribute__((address_space(3))) bf16x8*)(kp);      kf[1]=*(const __attribute__((address_space(3))) bf16x8*)(kp+512);
  kf[2]=*(const __attribute__((address_space(3))) bf16x8*)(kp+2048); kf[3]=*(const __attribute__((address_space(3))) bf16x8*)(kp+2560);
  kf[4]=*(const __attribute__((address_space(3))) bf16x8*)(kp+4096); kf[5]=*(const __attribute__((address_space(3))) bf16x8*)(kp+4608);
  kf[6]=*(const __attribute__((address_space(3))) bf16x8*)(kp+6144); kf[7]=*(const __attribute__((address_space(3))) bf16x8*)(kp+6656);
}
__device__ __forceinline__ void kload2(bf16x8*kf,lds_cptr kp,int j){ kf[2*j]=*(const __attribute__((address_space(3))) bf16x8*)(kp+j*2048); kf[2*j+1]=*(const __attribute__((address_space(3))) bf16x8*)(kp+j*2048+512); }
__device__ __forceinline__ s16x4 vtr(lds_cptr p){ return __builtin_bit_cast(s16x4,__builtin_amdgcn_ds_read_tr16_b64_v4i16((__attribute__((address_space(3))) v4i16_t*)p)); }
__device__ __forceinline__ float rowmax(const f32x16&p0,const f32x16&p1){
  float a=max3f(p0[0],p0[1],p1[0]),b=max3f(p0[2],p0[3],p1[1]);a=max3f(a,p1[2],p1[3]);
  #pragma unroll
  for(int r=4;r<16;r+=4){a=max3f(a,p0[r],p0[r+1]);b=max3f(b,p0[r+2],p0[r+3]);a=max3f(a,p1[r],p1[r+1]);b=max3f(b,p1[r+2],p1[r+3]);}
  const float m=max2f(a,b);
  auto rr=__builtin_amdgcn_permlane32_swap(__float_as_uint(m),__float_as_uint(m),false,false);
  return max2f(__uint_as_float(rr[0]),__uint_as_float(rr[1]));
}
__device__ __forceinline__ void pv(f32x16*o,int vb,bf16x8 pa0,bf16x8 pa1,bf16x8 pa2,bf16x8 pa3){
  #pragma unroll
  for(int d0=0;d0<2;++d0){s16x4 lo[4],hi[4];
    #pragma unroll
    for(int ks=0;ks<4;++ks){
      asm volatile("ds_read_b64_tr_b16 %0,%1 offset:%c2":"=&v"(lo[ks]):"v"(vb),"i"(d0*4096+ks*1024):"memory");
      asm volatile("ds_read_b64_tr_b16 %0,%1 offset:%c2":"=&v"(hi[ks]):"v"(vb),"i"(d0*4096+ks*1024+512):"memory");}
    asm volatile("s_waitcnt lgkmcnt(0)":::"memory");SBAR();
    #define PK(k) (bf16x8){lo[k][0],lo[k][1],lo[k][2],lo[k][3],hi[k][0],hi[k][1],hi[k][2],hi[k][3]}
    o[d0]=__builtin_amdgcn_mfma_f32_32x32x16_bf16(pa0,PK(0),o[d0],0,0,0);
    o[d0]=__builtin_amdgcn_mfma_f32_32x32x16_bf16(pa1,PK(1),o[d0],0,0,0);
    o[d0]=__builtin_amdgcn_mfma_f32_32x32x16_bf16(pa2,PK(2),o[d0],0,0,0);
    o[d0]=__builtin_amdgcn_mfma_f32_32x32x16_bf16(pa3,PK(3),o[d0],0,0,0);
    #undef PK
  }
}

#ifndef ATTN_STORE16
#define ATTN_STORE16(p,v) (*(u32x4*)(p)=(v))
#endif
template<int THRL> __device__ __forceinline__ void attn_unit(int b,int h,int qb,const bf16*Q,const bf16*__restrict__ K,const bf16*__restrict__ V,bf16*O,const float*cum,float M0,char*shm){
  int tid=threadIdx.x; asm volatile("":"+v"(tid));
  const int lane=tid&63,r32=lane&31,hi=lane>>5; const int wid=__builtin_amdgcn_readfirstlane(tid>>6);
  const long rowbase=(long)b*SEQ; const int q0=qb*QB;
  const bf16*Qw=Q+(rowbase+q0+wid*QBLK)*PITCH+h*D;
  const bf16*Kh=K+rowbase*PITCH+h*D,*Vh=V+rowbase*PITCH+h*D;
  const unsigned lds0=(unsigned)(uintptr_t)shm;
  float*wsf=(float*)(shm+LDS_WS)+wid*64;
  const bf16*ksrc=Kh+(long)lane*PITCH+wid*8;
  const bf16*vsrc=Vh+(long)(16*(wid&3)+(lane>>2))*PITCH+(wid>>2)*32+(lane&3)*8;
  const unsigned kdst=lds0+LDS_K+wid*1024, vdst=lds0+LDS_V+wid*1024;
  #define DMA_K(t,slot) glds16(ksrc+(long)(t)*KVBLK*PITCH,(unsigned)__builtin_amdgcn_readfirstlane(kdst+(slot)))
  #define DMA_V(t,slot) glds16(vsrc+(long)(t)*KVBLK*PITCH,(unsigned)__builtin_amdgcn_readfirstlane(vdst+(slot)))
  const int vb0=(int)(lds0+LDS_V)+((lane>>4)&1)*32+(lane&3)*8+(4*hi+((lane&15)>>2))*64;
  const char*Kbase=shm+LDS_K; bf16x8 kf[8];
  const lds_cptr shm3=(lds_cptr)shm; const lds_cptr kp0=shm3+LDS_K+hi*1024+r32*16; const lds_cptr vp0=shm3+LDS_V+((lane>>4)&1)*32+(lane&3)*8+(4*hi+((lane&15)>>2))*64;
  const int NT=(q0+QB)/KVBLK;
  const float*chp=cum+((long)b*NHEAD+h)*SEQ;
  { const f32x4g*src4=(const f32x4g*)chp; __attribute__((address_space(3))) f32x4g*dst4=(__attribute__((address_space(3))) f32x4g*)(shm3+LDS_C);
    for(int i=tid;i<NT*16;i+=NW*64)dst4[i]=src4[i]; }
  const float cqm=chp[q0+wid*QBLK+r32]-M0;
  asm volatile("s_waitcnt vmcnt(0) lgkmcnt(0)":::"memory");
  const lds_cptr cb0=shm3+LDS_C+hi*16;
  #define CBIAS(C0,C1,t) do{ const lds_cptr cp_=cb0+(t)*256; \
    _Pragma("unroll") for(int j_=0;j_<4;++j_){ const f32x4g c_=*(const __attribute__((address_space(3))) f32x4g*)(cp_+j_*32); \
      C0[4*j_]=cqm-c_[0];C0[4*j_+1]=cqm-c_[1];C0[4*j_+2]=cqm-c_[2];C0[4*j_+3]=cqm-c_[3]; } \
    _Pragma("unroll") for(int j_=0;j_<4;++j_){ const f32x4g c_=*(const __attribute__((address_space(3))) f32x4g*)(cp_+128+j_*32); \
      C1[4*j_]=cqm-c_[0];C1[4*j_+1]=cqm-c_[1];C1[4*j_+2]=cqm-c_[2];C1[4*j_+3]=cqm-c_[3]; } }while(0)
  DMA_K(0,0);DMA_V(0,0);DMA_K(1,SLOTB);
  bf16x8 qr[4];
  #pragma unroll
  for(int d0=0;d0<4;++d0)qr[d0]=*reinterpret_cast<const bf16x8*>(&Qw[(long)r32*PITCH+d0*16+hi*8]);
  float l_reg=0.f;f32x16 o[2];o[0]=f32x16{};o[1]=f32x16{};
  const int qrel=wid*QBLK+r32;
  #define CMASK(P0,P1,t) do{int jb_=(t)-(NT-4); if(jb_>=0)cmask(P0,P1,jb_,qrel,hi);}while(0)
  f32x16 pA0,pA1,pB0,pB1;
  int sl_prev=0,sl_cur=0,sl_next=SLOTB;
  #define ROT() do{sl_prev=sl_cur;sl_cur=sl_next;sl_next=(sl_next==(NSLOT-1)*SLOTB)?0:sl_next+SLOTB;}while(0)
  DMA_K(2,2*SLOTB);
  WAIT_BAR(3);
  CBIAS(pA0,pA1,0);
  qkt(pA0,pA1,Kbase,qr,r32,hi);CMASK(pA0,pA1,0);
  _Pragma("unroll") for(int r=0;r<16;++r){pA0[r]=__builtin_amdgcn_exp2f(pA0[r]);pA1[r]=__builtin_amdgcn_exp2f(pA1[r]);}
  WAIT_BAR(0);
  DMA_K(3,0);DMA_V(1,SLOTB);
  ROT();
  kload8(kf,kp0+sl_cur);
  WAIT_BAR(2);
  s16x4 vlo[8],vhi[8]; u32x4 pw0,pw1,pw2,pw3;
  #define PKW(P,B) cvtpk_s(P[B],P[B+1])
  #define PAF(k) __builtin_bit_cast(bf16x8,pw##k)
  #define VFR(i) (bf16x8){vlo[i][0],vlo[i][1],vlo[i][2],vlo[i][3],vhi[i][0],vhi[i][1],vhi[i][2],vhi[i][3]}
  #define PIN(x) asm volatile("":"+v"(x))
  #define MX3(a,b,c) __builtin_fmaxf(__builtin_fmaxf((a),(b)),(c))
  #define GAPA(MF,A0,A1,A2,A3,W0,W1,PW) do{ MF; sacc+=A0; sacc+=A1; sacc+=A2; sacc+=A3; PIN(sacc); W0; W1; PIN(PW); SBAR(); }while(0)
  #define EX(v) __builtin_amdgcn_exp2f(v)
  #define GAPB(MF,X,B) do{ MF; X[B]=EX(X[B]); X[B+1]=EX(X[B+1]); X[B+2]=EX(X[B+2]); X[B+3]=EX(X[B+3]); PIN(X); SBAR(); }while(0)
  #define VRD(i) do{ vlo[i]=vtr(vp_+(((i)>>2)*4096+((i)&3)*1024)); vhi[i]=vtr(vp_+(((i)>>2)*4096+((i)&3)*1024+512)); }while(0)
  #define KRD(G,j) do{ if(G){ kload2(kf,kp0+sl_next,j); SBAR(); } }while(0)
  #define STEP(C0,C1,P0,P1,t,GK,GV,GL) do{ SBAR(); \
    CBIAS(C0,C1,t); SBAR(); \
    const lds_cptr vp_=vp0+sl_prev; \
    VRD(0); SBAR(); float sacc=(P0[0]+P0[1]); \
    GAPA(C0=__builtin_amdgcn_mfma_f32_32x32x16_bf16(kf[0],qr[0],C0,0,0,0), P0[2],P0[3],P0[4],P0[5],     pw0[0]=PKW(P0,0), pw0[1]=PKW(P0,2), pw0); \
    VRD(4); SBAR(); GAPA(C1=__builtin_amdgcn_mfma_f32_32x32x16_bf16(kf[1],qr[0],C1,0,0,0), P0[6],P0[7],P0[8],P0[9],     pw0[2]=PKW(P0,4), pw0[3]=PKW(P0,6), pw0); \
    VRD(1); SBAR(); GAPA(C0=__builtin_amdgcn_mfma_f32_32x32x16_bf16(kf[2],qr[1],C0,0,0,0),   P0[10],P0[11],P0[12],P0[13], pw1[0]=PKW(P0,8), pw1[1]=PKW(P0,10), pw1); \
    VRD(5); SBAR(); GAPA(C1=__builtin_amdgcn_mfma_f32_32x32x16_bf16(kf[3],qr[1],C1,0,0,0),   P0[14],P0[15],P1[0],P1[1],   pw1[2]=PKW(P0,12),pw1[3]=PKW(P0,14), pw1); \
    VRD(2); SBAR(); GAPA(C0=__builtin_amdgcn_mfma_f32_32x32x16_bf16(kf[4],qr[2],C0,0,0,0),   P1[2],P1[3],P1[4],P1[5],     pw2[0]=PKW(P1,0), pw2[1]=PKW(P1,2), pw2); \
    VRD(6); SBAR(); GAPA(C1=__builtin_amdgcn_mfma_f32_32x32x16_bf16(kf[5],qr[2],C1,0,0,0),   P1[6],P1[7],P1[8],P1[9],     pw2[2]=PKW(P1,4), pw2[3]=PKW(P1,6), pw2); \
    VRD(3); SBAR(); GAPA(C0=__builtin_amdgcn_mfma_f32_32x32x16_bf16(kf[6],qr[3],C0,0,0,0),   P1[10],P1[11],P1[12],P1[13], pw3[0]=PKW(P1,8), pw3[1]=PKW(P1,10), pw3); \
    VRD(7); SBAR(); GAPA(C1=__builtin_amdgcn_mfma_f32_32x32x16_bf16(kf[7],qr[3],C1,0,0,0),   P1[14],P1[15],0.f,0.f,       pw3[2]=PKW(P1,12),pw3[3]=PKW(P1,14), pw3); \
    l_reg+=sacc; \
    if(GK){DMA_K((t)+3,sl_cur);} if(GV){DMA_V((t)+1,sl_next);} \
    CMASK(C0,C1,t); \
    SBAR(); \
    GAPB(o[0]=__builtin_amdgcn_mfma_f32_32x32x16_bf16(PAF(0),VFR(0),o[0],0,0,0), C0,0); \
    GAPB(o[1]=__builtin_amdgcn_mfma_f32_32x32x16_bf16(PAF(0),VFR(4),o[1],0,0,0), C0,4); \
    KRD(GL,0); GAPB(o[0]=__builtin_amdgcn_mfma_f32_32x32x16_bf16(PAF(1),VFR(1),o[0],0,0,0), C0,8); \
    KRD(GL,1); GAPB(o[1]=__builtin_amdgcn_mfma_f32_32x32x16_bf16(PAF(1),VFR(5),o[1],0,0,0), C0,12); \
    KRD(GL,2); GAPB(o[0]=__builtin_amdgcn_mfma_f32_32x32x16_bf16(PAF(2),VFR(2),o[0],0,0,0), C1,0); \
    KRD(GL,3); GAPB(o[1]=__builtin_amdgcn_mfma_f32_32x32x16_bf16(PAF(2),VFR(6),o[1],0,0,0), C1,4); \
    GAPB(o[0]=__builtin_amdgcn_mfma_f32_32x32x16_bf16(PAF(3),VFR(3),o[0],0,0,0), C1,8); \
    GAPB(o[1]=__builtin_amdgcn_mfma_f32_32x32x16_bf16(PAF(3),VFR(7),o[1],0,0,0), C1,12); \
    }while(0)
  int t=1;
  #undef CMASK
  #define CMASK(P0,P1,t) do{}while(0)
  for(;t+5<NT;t+=2){
    STEP(pB0,pB1,pA0,pA1,t,true,true,true);     WAIT_BAR(2); ROT();
    STEP(pA0,pA1,pB0,pB1,t+1,true,true,true);   WAIT_BAR(2); ROT();
  }
  #undef CMASK
  #define CMASK(P0,P1,t) do{int jb_=(t)-(NT-4); if(jb_>=0)cmask(P0,P1,jb_,qrel,hi);}while(0)
  #define ENDW(tt) do{ if((tt)+3<NT){WAIT_BAR(2);} else if((tt)+2<NT){WAIT_BAR(1);} else {WAIT_BAR(0);} }while(0)
  for(;t+1<NT;t+=2){
    STEP(pB0,pB1,pA0,pA1,t,(t+3<NT),(t+1<NT),(t+1<NT));       ENDW(t);   ROT();
    STEP(pA0,pA1,pB0,pB1,t+1,(t+4<NT),(t+2<NT),(t+2<NT));     ENDW(t+1); ROT();
  }
  STEP(pB0,pB1,pA0,pA1,NT-1,false,false,false);
  { float sacc=pB0[0]+pB0[1]; _Pragma("unroll") for(int r=2;r<16;++r)sacc+=pB0[r]; _Pragma("unroll") for(int r=0;r<16;++r)sacc+=pB1[r]; l_reg+=sacc;
    pw0=(u32x4){PKW(pB0,0),PKW(pB0,2),PKW(pB0,4),PKW(pB0,6)};pw1=(u32x4){PKW(pB0,8),PKW(pB0,10),PKW(pB0,12),PKW(pB0,14)};pw2=(u32x4){PKW(pB1,0),PKW(pB1,2),PKW(pB1,4),PKW(pB1,6)};pw3=(u32x4){PKW(pB1,8),PKW(pB1,10),PKW(pB1,12),PKW(pB1,14)};
    SBAR(); pv(o,vb0+sl_cur,PAF(0),PAF(1),PAF(2),PAF(3)); }
  #undef PKW
  #undef PAF
  #undef VFR
  #undef PIN
  #undef MX3
  #undef GAPA
  #undef GAPB
  #undef EX
  #undef VRD
  #undef KRD
  #undef STEP
  #undef ENDW
  {auto rr=__builtin_amdgcn_permlane32_swap(__float_as_uint(l_reg),__float_as_uint(l_reg),false,false);l_reg=__uint_as_float(rr[0])+__uint_as_float(rr[1]);}
  if(hi==0)wsf[32+r32]=l_reg;asm volatile("s_waitcnt lgkmcnt(0)":::"memory");
  float rli[16];
  #pragma unroll
  for(int r=0;r<16;++r)rli[r]=__builtin_amdgcn_rcpf(wsf[32+crow(r,hi)]);
  bf16*Ow=O+(rowbase+q0+wid*QBLK)*PITCH+h*D;
  { bf16*stg=(bf16*)(shm+LDS_OST)+wid*2048;
    #pragma unroll
    for(int r=0;r<16;++r){const int orow=crow(r,hi);
      #pragma unroll
      for(int d0=0;d0<2;++d0)stg[orow*64+d0*32+r32]=__float2bfloat16(o[d0][r]*rli[r]);}
    asm volatile("s_waitcnt lgkmcnt(0)":::"memory");
    #pragma unroll
    for(int i=0;i<4;++i){const int row=i*8+(lane>>3),ch=lane&7; const u32x4 v=*(const u32x4*)(stg+row*64+ch*8); ATTN_STORE16(Ow+(long)row*PITCH+ch*8,v);} }
  asm volatile("s_waitcnt lgkmcnt(0)\n\ts_barrier":::"memory");
  #undef DMA_K
  #undef DMA_V
  #undef CMASK
  #undef CBIAS
  #undef ROT
}
constexpr int ATTN_LDS_BYTES=LDS_BYTES;
struct AttnTensors { const bf16* Q; const bf16* K; const bf16* V; bf16* O; const float* cum; float M0; };
struct AttnUnit { int bh; int qb; };
struct PairOrder {
  int vcu,G;
  __device__ __forceinline__ bool next(int i,AttnUnit&u)const{ const int p=vcu+(i>>1)*G; if(p>=256)return false; const int s=p&15; u.bh=p>>4; u.qb=(i&1)?s:31-s; return true; }
};
template<class Sched> __device__ __forceinline__ void attn_phase(char*lds,const AttnTensors&T,const Sched&S){
  AttnUnit u;
  for(int i=0;S.next(i,u);++i){ attn_unit<0>(u.bh/NHEAD,u.bh%NHEAD,u.qb,T.Q,T.K,T.V,T.O,T.cum,T.M0,lds); }
}
#undef SBAR
#undef WAIT_BAR
}
constexpr int NPH = FAST_MOE ? 11 : 9;
struct Args { const float* in[26]; float* out; unsigned char* ws; int ph_lo, ph_hi; };
__global__ void __launch_bounds__(NTHR, 2) mega(Args a) {
    extern __shared__ __attribute__((aligned(16))) unsigned char lds[];
    const int tid = threadIdx.x, lane = tid & 63, wave = __builtin_amdgcn_readfirstlane(tid >> 6);
    LAS unsigned char* L8 = (LAS unsigned char*)lds;
    LAS float* L = (LAS float*)lds;
    volatile LAS unsigned* MISC = (volatile LAS unsigned*)(L8 + MISC_OFF);
    for (int u = tid; u < (LDS_BYTES - LDSCTL_OFF) / 4; u += NTHR) ((LAS unsigned*)(L8 + LDSCTL_OFF))[u] = 0u;
    __syncthreads();
    unsigned char* ws = a.ws;
    unsigned* ctl = (unsigned*)(ws + WS_CTL);
    XcdBarrier bar; bar.bar = ctl + CW_BAR; bar.x = 0; bar.st = nullptr;
    if (!MK_SPLIT) bar = xcd_barrier_post(ctl + CW_BAR, MISC + 8);
#define WIN   ((bf16*)(opq(ws) + WS_WIN))
#define WBR   ((bf16*)(opq(ws) + WS_WBR))
#define WOUT  ((bf16*)(opq(ws) + WS_WOUT))
#define HB    ((bf16*)(opq(ws) + WS_HB))
#define FOX   ((bf16*)(opq(ws) + WS_FOX))
#define GLA   ((bf16*)(opq(ws) + WS_GLA))
#define SSM   ((bf16*)(opq(ws) + WS_SSM))
#define SML   ((float*)(opq(ws) + WS_SML))
#define CUM   ((float*)(opq(ws) + WS_CUM))
#define TOKE  ((int*)(opq(ws) + WS_TOKE))
#define TOKW  ((float*)(opq(ws) + WS_TOKW))
#define GATES ((bf16*)(opq(ws) + WS_GATES))
#define LRANK ((int*)(opq(ws) + WS_LRANK))
#define ROWTOK ((int*)(opq(ws) + WS_ROWTOK))
#define ROWW  ((float*)(opq(ws) + WS_ROWW))
#define CNTBLK ((int*)(opq(ws) + WS_CNTBLK))
#define W1E   ((bf16*)(opq(ws) + WS_W1E))
#define WDE   ((bf16*)(opq(ws) + WS_WDE))
#define HID   ((bf16*)(opq(ws) + WS_HID))
#define HS    ((bf16*)(opq(ws) + WS_HS))
#define YB    ((bf16*)(opq(ws) + WS_YB))
#define ROWOF ((int*)(opq(ws) + WS_ROWOF))
#define GST   ((float*)(opq(ws) + WS_GST))
#define SST   ((float*)(opq(ws) + WS_SST))
#define GDEC  ((float*)(opq(ws) + WS_GDEC))
#define SDEC  ((float*)(opq(ws) + WS_SDEC))
    const int lo = a.ph_lo, hi = a.ph_hi;
#define IN(k) (lo <= (k) && (k) < hi)
#define PH_BEGIN(k) if (IN(pb + (k))) for (int rep_ = 0; rep_ < ((k) == REPEAT_PHASE ? 2 : 1); ++rep_) { if (rep_) xcd_barrier(bar);
#if PROF_PHASE >= 0
    unsigned long long tacc = 0ull, tprev = __builtin_amdgcn_s_memrealtime();
#define SEAM(k) do { if (IN(k) && IN((k) + 1)) xcd_barrier(bar); { const unsigned long long tn_ = __builtin_amdgcn_s_memrealtime(); if (((k) % NPH) == PROF_PHASE || PROF_PHASE == 99) tacc += tn_ - tprev; tprev = tn_; } } while (0)
#else
#define SEAM(k) do { if (IN(k) && IN((k) + 1)) xcd_barrier(bar); } while (0)
#endif
    for (int l = 0; l < NLAYER; ++l) {
        const int pb = l * NPH;
        const float* xin = (l == 0) ? ((const float*)(const GAS float*)a.in[0]) : ((float*)(GAS float*)a.out);
        PH_BEGIN(0) if (l == 0) ph_norm(xin, ((const float*)(const GAS float*)a.in[1]) + l * D_, HB, wave, lane);
            else ph_norm_combine(((float*)(GAS float*)a.out), YB, ROWOF, ((const float*)(const GAS float*)a.in[1]) + l * D_, HB, wave, lane);
            convert_small_weights(((const float*)(const GAS float*)a.in[2]) + (size_t)l * D_ * INC, ((const float*)(const GAS float*)a.in[15]) + (size_t)l * 3 * 512 * 1024, ((const float*)(const GAS float*)a.in[17]) + (size_t)l * D_ * D_, WIN, WBR, WOUT, L + wave * 2112, wave, lane); }
        SEAM(pb + 0);
        PH_BEGIN(1)
#if FAST_INPROJ
#if DUAL_INPROJ
            ph_inproj_simple(HB, ((const float*)(const GAS float*)a.in[2]) + (size_t)l * D_ * INC, ((const float*)(const GAS float*)a.in[3]) + l * 8, ((const float*)(const GAS float*)a.in[4]) + l * 64, ((const float*)(const GAS float*)a.in[5]) + l * 64, ((const float*)(const GAS float*)a.in[11]) + l * 8, ((const float*)(const GAS float*)a.in[16]) + l * 3072, FOX, GLA, SSM, SML, GATES, tid);
            xcd_barrier(bar);
#endif
            pg8::GridOrder S; S.init(T_, 7680, (int)gridDim.x, (int)blockIdx.x, HB, 1024, WIN, 1024);
            pg8::EpiInproj E{FOX, GLA, SSM, SML, GATES, ((const float*)(const GAS float*)a.in[4]) + l * 64, ((const float*)(const GAS float*)a.in[5]) + l * 64, ((const float*)(const GAS float*)a.in[3]) + l * 8, ((const float*)(const GAS float*)a.in[11]) + l * 8, ((const float*)(const GAS float*)a.in[16]) + l * 3072};
            pg8::gemm_phase(L8, 1024, 1024, S, E);
#else
            ph_inproj_simple(HB, ((const float*)(const GAS float*)a.in[2]) + (size_t)l * D_ * INC, ((const float*)(const GAS float*)a.in[3]) + l * 8, ((const float*)(const GAS float*)a.in[4]) + l * 64, ((const float*)(const GAS float*)a.in[5]) + l * 64, ((const float*)(const GAS float*)a.in[11]) + l * 8, ((const float*)(const GAS float*)a.in[16]) + l * 3072, FOX, GLA, SSM, SML, GATES, tid);
#endif
        }
        SEAM(pb + 1);
        PH_BEGIN(2) ph_cumsum(SML, CUM, L, tid);
#if FAST_MIX
            ph_local(SML, CUM, GLA, SSM, ((const float*)(const GAS float*)a.in[6]) + l * 16 * 256, ((const float*)(const GAS float*)a.in[7]) + l * 256, ((const float*)(const GAS float*)a.in[9]) + l * 4 * 768, ((const float*)(const GAS float*)a.in[10]) + l * 768, ((const float*)(const GAS float*)a.in[12]) + l * 8, GST, GDEC, SST, SDEC, L8, tid, wave, lane);
#endif
        }
        SEAM(pb + 2);
        PH_BEGIN(3)
#if FAST_MIX
            ph_scan(GST, GDEC, SST, SDEC, tid);
#else
            ph_mix_simple(FOX, CUM, GLA, SSM, SML, ((const float*)(const GAS float*)a.in[6]) + l * 16 * 256, ((const float*)(const GAS float*)a.in[7]) + l * 256, ((const float*)(const GAS float*)a.in[9]) + l * 4 * 768, ((const float*)(const GAS float*)a.in[10]) + l * 768, ((const float*)(const GAS float*)a.in[12]) + l * 8, ((const float*)(const GAS float*)a.in[13]) + l * 8, L, tid, wave, lane);
#endif
#if FAST_ATTN
            { const float gq = ((const float*)(const GAS float*)a.in[4])[l * 64 + lane], gk = ((const float*)(const GAS float*)a.in[5])[l * 64 + lane];
              float gm = fabsf(gq * gk);
#pragma unroll
              for (int o = 1; o < 64; o <<= 1) gm = fmaxf(gm, __shfl_xor(gm, o));
              const float M0 = 8.f * LOG2E * 1.01f * gm;
              const attn_body::AttnTensors AT{(const attn_body::bf16*)FOX, (const attn_body::bf16*)(FOX + 512), (const attn_body::bf16*)(FOX + 1024), (attn_body::bf16*)FOX, CUM, M0};
              const int G = (int)gridDim.x, bx = (int)blockIdx.x;
              const attn_body::PairOrder S{(G % 8 == 0) ? (bx % 8) * (G / 8) + bx / 8 : bx, G};
              attn_body::attn_phase((char*)lds, AT, S); }
#endif
        }
        SEAM(pb + 3);
        PH_BEGIN(4)
#if FAST_MIX
            ph_mixout(GLA, SSM, SML, ((const float*)(const GAS float*)a.in[6]) + l * 16 * 256, ((const float*)(const GAS float*)a.in[7]) + l * 256, ((const float*)(const GAS float*)a.in[8]) + l * 128, ((const float*)(const GAS float*)a.in[9]) + l * 4 * 768, ((const float*)(const GAS float*)a.in[10]) + l * 768, ((const float*)(const GAS float*)a.in[12]) + l * 8, ((const float*)(const GAS float*)a.in[13]) + l * 8, ((const float*)(const GAS float*)a.in[14]) + l * 512, GST, SST, L8, tid, wave, lane);
#else
            ph_post(GLA, SSM, ((const float*)(const GAS float*)a.in[8]) + l * 128, ((const float*)(const GAS float*)a.in[14]) + l * 512, wave, lane);
#endif
        }
        SEAM(pb + 4);
        PH_BEGIN(5)
#if FAST_MERGE
            pg8::MergeOrder S{(int)gridDim.x, (int)blockIdx.x, (const char*)opq(ws), (const char*)WBR};
            pg8::EpiMerge E{GATES, FOX + 512};
            pg8::gemm_phase(L8, 512, 1536, S, E);
#else
            ph_merge_simple(FOX, GLA, SSM, GATES, ((const float*)(const GAS float*)a.in[15]) + (size_t)l * 3 * 512 * 1024, tid);
#endif
        }
        SEAM(pb + 5);
        PH_BEGIN(6)
#if FAST_OUT
            pg8::GridOrder S; S.init(T_, 1024, (int)gridDim.x, (int)blockIdx.x, FOX + 512, 1536, WOUT, 1024);
            pg8::EpiResidual E{xin, ((float*)(GAS float*)a.out)};
            pg8::gemm_phase(L8, 1024, 1536, S, E);
#else
            ph_out_simple(FOX, ((const float*)(const GAS float*)a.in[17]) + (size_t)l * D_ * D_, xin, ((float*)(GAS float*)a.out), tid);
#endif
        }
        SEAM(pb + 6);
#if FAST_MOE
        PH_BEGIN(7)
            ph_norm2_route_blk(((float*)(GAS float*)a.out), ((const float*)(const GAS float*)a.in[18]) + l * D_, HB, ((const float*)(const GAS float*)a.in[19]) + l * D_ * 4, ((const float*)(const GAS float*)a.in[20]) + l * 4,
                               ((const float*)(const GAS float*)a.in[21]) + l * D_ * 16, ((const float*)(const GAS float*)a.in[22]) + l * 16, TOKE, TOKW, LRANK, CNTBLK, (LAS int*)(L8 + 73728), tid, wave, lane);
            convert_expert_weights(((const float*)(const GAS float*)a.in[23]) + (size_t)l * 16 * 1024 * 512, ((const float*)(const GAS float*)a.in[24]) + (size_t)l * 16 * 1024 * 512,
                                   ((const float*)(const GAS float*)a.in[25]) + (size_t)l * 16 * 512 * 1024, W1E, WDE, L + wave * 2112, wave, lane);
        }
        SEAM(pb + 7);
        PH_BEGIN(8) ph_moe_scatter(HB, HS, TOKE, TOKW, LRANK, CNTBLK, ROWTOK, ROWW, ROWOF, (LAS int*)L8, (LAS int*)(L8 + 40960), (LAS int*)(L8 + LDS_TB), (LAS int*)(L8 + LDS_TOT), tid, wave, lane); }
        SEAM(pb + 8);
        PH_BEGIN(9)
            pg8::MoeOrder S{(int)gridDim.x, (int)blockIdx.x, (const char*)HS, (size_t)256 * 1024 * 2, (const char*)W1E, (size_t)1024 * 1024 * 2, (size_t)256 * 1024 * 2, (const LAS int*)(L8 + LDS_TB)};
            pg8::EpiMoe1 E{HID};
            pg8::gemm_phase(L8, 1024, 1024, S, E);
        }
        SEAM(pb + 9);
        PH_BEGIN(10)
            pg8::MoeOrder S{(int)gridDim.x, (int)blockIdx.x, (const char*)HID, (size_t)256 * 512 * 2, (const char*)WDE, (size_t)1024 * 512 * 2, (size_t)256 * 512 * 2, (const LAS int*)(L8 + LDS_TB)};
            pg8::EpiMoe2 E{ROWW, YB};
            pg8::gemm_phase(L8, 512, 512, S, E);
        }
        SEAM(pb + 10);
#else
        if (IN(pb + 7)) ph_norm2_route(((float*)(GAS float*)a.out), ((const float*)(const GAS float*)a.in[18]) + l * D_, HB, ((const float*)(const GAS float*)a.in[19]) + l * D_ * 4, ((const float*)(const GAS float*)a.in[20]) + l * 4, ((const float*)(const GAS float*)a.in[21]) + l * D_ * 16, ((const float*)(const GAS float*)a.in[22]) + l * 16, TOKE, TOKW, wave, lane);
        SEAM(pb + 7);
        if (IN(pb + 8)) ph_moe_simple(HB, TOKE, TOKW, ((const float*)(const GAS float*)a.in[23]) + (size_t)l * 16 * 1024 * 512, ((const float*)(const GAS float*)a.in[24]) + (size_t)l * 16 * 1024 * 512, ((const float*)(const GAS float*)a.in[25]) + (size_t)l * 16 * 512 * 1024, ((float*)(GAS float*)a.out), L, tid);
        SEAM(pb + 8);
#endif
    }
    if (IN(NLAYER * NPH)) ph_norm_combine(((float*)(GAS float*)a.out), YB, ROWOF, nullptr, nullptr, wave, lane);
#if PROF_PHASE >= 0
    if (blockIdx.x == 0 && tid == 0) ((float*)(GAS float*)a.out)[0] = (float)tacc * 1.0e4f;
#endif
#undef IN
#undef SEAM
}

extern "C" void kernel_launch(void* const* d_in, const int* in_sizes, int n_in, void* d_out, int out_size, void* d_ws, size_t ws_size, hipStream_t stream) {
    static int grid = 0;
    if (grid == 0) {
        if (n_in != 26 || out_size != T_ * D_ || ws_size < WS_END) { fprintf(stderr, "kernel_launch: unexpected sizes\n"); grid = -1; return; }
        int dev = 0, cus = 0;
        if (hipGetDevice(&dev) != hipSuccess || hipDeviceGetAttribute(&cus, hipDeviceAttributeMultiprocessorCount, dev) != hipSuccess) { grid = -1; return; }
        if (hipFuncSetAttribute((const void*)mega, hipFuncAttributeMaxDynamicSharedMemorySize, LDS_BYTES) != hipSuccess) { grid = -1; return; }
        int per_cu = 0;
        (void)hipOccupancyMaxActiveBlocksPerMultiprocessor(&per_cu, (const void*)mega, NTHR, LDS_BYTES);
        (void)hipGetLastError();
        grid = cus;
    }
    if (grid < 0) return;
    if (hipMemsetAsync((char*)d_ws + WS_CTL, 0, CTL_ZERO_BYTES, stream) != hipSuccess) return;
    Args a{};
    for (int i = 0; i < 26; ++i) a.in[i] = (const float*)d_in[i];
    a.out = (float*)d_out; a.ws = (unsigned char*)d_ws;
#if MK_SPLIT
    for (int p = 0; p < NLAYER * NPH + 1; ++p) { a.ph_lo = p; a.ph_hi = p + 1; hipLaunchKernelGGL(mega, dim3(grid), dim3(NTHR), LDS_BYTES, stream, a); }
#else
    a.ph_lo = 0; a.ph_hi = NLAYER * NPH + 1;
    hipLaunchKernelGGL(mega, dim3(grid), dim3(NTHR), LDS_BYTES, stream, a);
#endif
}
```

```cpp
#include <hip/hip_runtime.h>
#include <hip/hip_bf16.h>
#include <cstdio>
#include <cstdint>

#ifndef FAST_INPROJ
#define FAST_INPROJ 1
#endif
#ifndef DUAL_INPROJ
#define DUAL_INPROJ 0
#endif
#ifndef EPI_SKIP
#define EPI_SKIP(pn) (false)
#endif
#ifndef FAST_MERGE
#define FAST_MERGE 1
#endif
#ifndef FAST_OUT
#define FAST_OUT 1
#endif
#ifndef FAST_MOE
#define FAST_MOE 1
#endif
#ifndef FAST_ATTN
#define FAST_ATTN 1
#endif
#ifndef FAST_MIX
#define FAST_MIX 1
#endif
#ifndef PROF_PHASE
#define PROF_PHASE -1
#endif
#ifndef REPEAT_PHASE
#define REPEAT_PHASE -1
#endif
#ifndef MK_SPLIT
#define MK_SPLIT 0
#endif

#define GAS __attribute__((address_space(1)))
#define LAS __attribute__((address_space(3)))
typedef unsigned short bf16;
typedef unsigned v4u __attribute__((ext_vector_type(4)));
typedef unsigned v2u __attribute__((ext_vector_type(2)));
typedef float f32x4 __attribute__((ext_vector_type(4)));

constexpr int T_ = 16384, S_ = 8192, D_ = 1024, NLAYER = 2, INC = 7456, NWAVES = 8, NTHR = 512;
constexpr float LOG2E = 1.4426950408889634f, EPS = 1e-6f;
constexpr int FOXP = 1536, GLAP = 1536, SSMP = 1536, SMLP = 32, GATP = 3072;
constexpr size_t MiB = 1u << 20;
constexpr size_t WS_CTL = 0, CTL_ZERO_BYTES = 1 * MiB;
constexpr size_t WS_WIN = 1 * MiB, WS_WBR = 16 * MiB, WS_WOUT = 19 * MiB;
constexpr size_t WS_HB = 21 * MiB, WS_SST = 53 * MiB, WS_FOX = 85 * MiB, WS_GLA = 133 * MiB, WS_SSM = 181 * MiB;
constexpr size_t WS_SML = 229 * MiB, WS_CUM = 231 * MiB, WS_TOKE = WS_CUM + 512 * 1024, WS_TOKW = WS_CUM + 640 * 1024, WS_LRANK = WS_CUM + 768 * 1024, WS_ROWTOK = WS_CUM + 896 * 1024,
                 WS_ROWW = WS_CUM + 1056 * 1024, WS_CNTBLK = WS_CUM + 1216 * 1024, WS_GATES = 233 * MiB, WS_END = 329 * MiB;
constexpr size_t WS_W1E = WS_GATES, WS_WDE = WS_GATES + 32 * MiB, WS_HID = WS_GATES + 48 * MiB, WS_HS = WS_FOX;
constexpr size_t WS_GST = WS_HB, WS_SSTB = WS_HB + 16 * MiB, WS_XC = WS_SST, WS_GDEC = WS_CUM + 1280 * 1024, WS_SDEC = WS_CUM + 1536 * 1024;
constexpr size_t WS_ROWOF = WS_CUM + 1600 * 1024, WS_YB = WS_HS;
constexpr int MOE_ROWS = 36864;
static_assert(WS_HID + (size_t)MOE_ROWS * 512 * 2 <= WS_END && WS_HS + (size_t)MOE_ROWS * 1024 * 2 <= WS_SSM + 48 * MiB, "MoE overlays");
constexpr int CW_BAR = 4096;
constexpr int RING_BYTES = 131072, LDSCTL_OFF = RING_BYTES, MISC_OFF = LDSCTL_OFF + 320, LDS_TB = LDSCTL_OFF + 512  , LDS_TOT = LDSCTL_OFF + 640  , LDS_BYTES = 147456;

__device__ __forceinline__ GAS unsigned char* opq(unsigned char* p) { GAS unsigned char* g = (GAS unsigned char*)p; asm volatile("" : "+s"(g)); return g; }
__device__ __forceinline__ float bf2f(unsigned u) { return __builtin_bit_cast(float, u << 16); }
__device__ __forceinline__ unsigned f2bf(float f) { unsigned u = __builtin_bit_cast(unsigned, f); return (u + 0x7fffu + ((u >> 16) & 1u)) >> 16; }
__device__ __forceinline__ unsigned pk2(float lo, float hi) { return f2bf(lo) | (f2bf(hi) << 16); }
__device__ __forceinline__ float silu_f(float x) { return x / (1.f + __expf(-x)); }
__device__ __forceinline__ float sigmoid_f(float x) { return 1.f / (1.f + __expf(-x)); }
__device__ __forceinline__ float softplus_f(float x) { return fmaxf(x, 0.f) + log1pf(__expf(-fabsf(x))); }
__device__ __forceinline__ float logsig_f(float x) { return fminf(x, 0.f) - log1pf(__expf(-fabsf(x))); }
__device__ __forceinline__ float wave_sum(float v) {
#pragma unroll
    for (int o = 1; o < 64; o <<= 1) v += __shfl_xor(v, o);
    return v;
}

#define XB_TMO      128
#define XB_XCNT(j)  (256  + 64 * (j))
#define XB_XSUB(j)  (1280 + 64 * (j))
#define XB_XGEN(j)  (2304 + 64 * (j))
#define XB_TOP      3328
#define XB_TOPGEN   3392
#define XCD_BAR_WORDS 3456
#define XB_SPIN_CAP (1u << 23)
__device__ __forceinline__ unsigned xb_ld(unsigned* p)              { return __hip_atomic_load(p, __ATOMIC_RELAXED, __HIP_MEMORY_SCOPE_AGENT); }
__device__ __forceinline__ unsigned xb_add(unsigned* p, unsigned v) { return __hip_atomic_fetch_add(p, v, __ATOMIC_RELAXED, __HIP_MEMORY_SCOPE_AGENT); }
__device__ __forceinline__ unsigned xb_xcc_id() { return (unsigned)__builtin_amdgcn_s_getreg((3 << 11) | 20) & 0xFu; }
#define XB_SPIN(cond, bar) do { unsigned _sp = 0; while (cond) { __builtin_amdgcn_s_sleep(1); \
    if ((++_sp & 255u) == 0u) { if (xb_ld(&(bar)[XB_TMO])) break; if (_sp > XB_SPIN_CAP) { atomicAdd(&(bar)[XB_TMO], 1u); break; } } } } while (0)
struct XcdBarrier { unsigned* bar; unsigned x; volatile LAS unsigned* st; };
__device__ __forceinline__ XcdBarrier xcd_barrier_post(unsigned* bar, volatile LAS unsigned* st) {
    XcdBarrier b; b.bar = bar; b.x = xb_xcc_id(); b.st = st;
    if (threadIdx.x == 0) (void)xb_add(&bar[XB_XCNT(b.x)], 1u);
    return b;
}
__device__ __forceinline__ void xcd_barrier_complete(unsigned* bar, unsigned x, unsigned& nloc, unsigned& nx) {
    const unsigned G = gridDim.x * gridDim.y * gridDim.z;
    unsigned sum, cnt, mine, sp = 0u;
    for (;;) {
        sum = 0u; cnt = 0u; mine = 0u;
#pragma unroll
        for (unsigned j = 0; j < 16; ++j) { const unsigned c = xb_ld(&bar[XB_XCNT(j)]); sum += c; cnt += (c > 0u) ? 1u : 0u; mine = (j == x) ? c : mine; }
        if (sum == G) break;
        __builtin_amdgcn_s_sleep(1);
        if ((++sp & 255u) == 0u) { if (xb_ld(&bar[XB_TMO])) break; if (sp > XB_SPIN_CAP) { atomicAdd(&bar[XB_TMO], 1u); break; } }
    }
    nloc = mine > 0u ? mine : 1u; nx = cnt > 0u ? cnt : 1u;
}
__device__ __forceinline__ void xcd_barrier(const XcdBarrier& b) {
    asm volatile("s_waitcnt vmcnt(0)" ::: "memory");
    __syncthreads();
    if (threadIdx.x == 0) {
        unsigned* bar = b.bar;
        __builtin_amdgcn_s_waitcnt(0);
        unsigned nloc = b.st[0], nx = b.st[1];
        if (nloc == 0u) { xcd_barrier_complete(bar, b.x, nloc, nx); b.st[0] = nloc; b.st[1] = nx; }
        const unsigned old = xb_add(&bar[XB_XSUB(b.x)], 1u);
        const unsigned gen = old / nloc;
        if (old + 1u == (gen + 1u) * nloc) {
            __builtin_amdgcn_fence(__ATOMIC_RELEASE, "agent");
            asm volatile("s_waitcnt vmcnt(0)" ::: "memory");
            const unsigned og = xb_add(&bar[XB_TOP], 1u);
            const unsigned tg = og / nx;
            if (og + 1u == (tg + 1u) * nx) xb_add(&bar[XB_TOPGEN], 1u);
            else XB_SPIN(xb_ld(&bar[XB_TOPGEN]) == tg, bar);
            __builtin_amdgcn_fence(__ATOMIC_ACQUIRE, "agent");
            xb_add(&bar[XB_XGEN(b.x)], 1u);
            asm volatile("s_waitcnt vmcnt(0)" ::: "memory");
        } else {
            XB_SPIN(xb_ld(&bar[XB_XGEN(b.x)]) == gen, bar);
            __builtin_amdgcn_fence(__ATOMIC_ACQUIRE, "agent");
            asm volatile("s_waitcnt vmcnt(0)" ::: "memory");
        }
    }
    __syncthreads();
}

__device__ __forceinline__ void ph_norm(const float* x, const float* gain, bf16* out, int wave, int lane) {
    asm volatile("" : "+s"(wave), "+v"(lane));
    const int gw = blockIdx.x * NWAVES + wave, NGW = gridDim.x * NWAVES;
    for (int m = gw; m < T_; m += NGW) {
        const f32x4* xr = (const f32x4*)(x + (size_t)m * D_) + lane;
        f32x4 v[4]; float s = 0.f;
#pragma unroll
        for (int j = 0; j < 4; ++j) { v[j] = xr[64 * j]; s += (v[j].x * v[j].x + v[j].y * v[j].y) + (v[j].z * v[j].z + v[j].w * v[j].w); }
        const float r = rsqrtf(wave_sum(s) * (1.f / D_) + EPS);
        v2u* o8 = (v2u*)(out + (size_t)m * D_) + lane;
#pragma unroll
        for (int j = 0; j < 4; ++j) { const f32x4 g = ((const f32x4*)gain)[lane + 64 * j]; v2u w; w.x = pk2(v[j].x * r * g.x, v[j].y * r * g.y); w.y = pk2(v[j].z * r * g.z, v[j].w * r * g.w); o8[64 * j] = w; }
    }
}

__device__ __forceinline__ void ph_norm_combine(float* xio, const bf16* Y, const int* rowof, const float* gain, bf16* out, int wave, int lane) {
    asm volatile("" : "+s"(wave), "+v"(lane));
    const int gw = blockIdx.x * NWAVES + wave, NGW = gridDim.x * NWAVES;
    for (int m = gw; m < T_; m += NGW) {
        f32x4* xr = (f32x4*)(xio + (size_t)m * D_) + lane;
        const int r0 = rowof[2 * m], r1 = rowof[2 * m + 1];
        const v2u* y0 = (const v2u*)(Y + (size_t)r0 * D_) + lane; const v2u* y1 = (const v2u*)(Y + (size_t)r1 * D_) + lane;
        f32x4 v[4]; float s = 0.f;
#pragma unroll
        for (int j = 0; j < 4; ++j) { const v2u a = y0[64 * j], b = y1[64 * j]; f32x4 x = xr[64 * j];
            x.x += bf2f(a.x & 0xffffu) + bf2f(b.x & 0xffffu); x.y += bf2f(a.x >> 16) + bf2f(b.x >> 16); x.z += bf2f(a.y & 0xffffu) + bf2f(b.y & 0xffffu); x.w += bf2f(a.y >> 16) + bf2f(b.y >> 16);
            v[j] = x; if (gain) xr[64 * j] = x; else xr[64 * j] = x;
            s += (x.x * x.x + x.y * x.y) + (x.z * x.z + x.w * x.w); }
        if (gain) {
            const float r = rsqrtf(wave_sum(s) * (1.f / D_) + EPS);
            v2u* o8 = (v2u*)(out + (size_t)m * D_) + lane;
#pragma unroll
            for (int j = 0; j < 4; ++j) { const f32x4 g = ((const f32x4*)gain)[lane + 64 * j]; v2u w; w.x = pk2(v[j].x * r * g.x, v[j].y * r * g.y); w.y = pk2(v[j].z * r * g.z, v[j].w * r * g.w); o8[64 * j] = w; }
        }
    }
}

__device__ __forceinline__ void ph_inproj_simple(const bf16* HB, const float* w_in, const float* f_bias, const float* qn, const float* kn, const float* dt_bias, const float* bgate,
                                                 bf16* FOX, bf16* GLA, bf16* SSM, float* SML, bf16* GATES, int tid) {
    asm volatile("" : "+v"(tid));
    const int r = tid >> 3, cg = tid & 7;
    constexpr int NTC = (INC + 63) / 64;
    for (int item = blockIdx.x; item < (T_ / 64) * NTC; item += gridDim.x) {
        const int tm = item / NTC, tn = item % NTC;
        const int row = tm * 64 + r, c0 = tn * 64 + cg * 8;
        float acc[8];
#pragma unroll
        for (int j = 0; j < 8; ++j) acc[j] = 0.f;
        if (c0 < INC) {
            const bf16* a = HB + (size_t)row * D_;
            const float* w = w_in + c0;
            for (int k8 = 0; k8 < D_ / 8; ++k8) {
                const v4u av = *(const v4u*)(a + 8 * k8);
                float af[8] = {bf2f(av.x & 0xffffu), bf2f(av.x >> 16), bf2f(av.y & 0xffffu), bf2f(av.y >> 16), bf2f(av.z & 0xffffu), bf2f(av.z >> 16), bf2f(av.w & 0xffffu), bf2f(av.w >> 16)};
#pragma unroll
                for (int kk = 0; kk < 8; ++kk) {
                    const f32x4 w0 = *(const f32x4*)(w + (size_t)(8 * k8 + kk) * INC), w1 = *(const f32x4*)(w + (size_t)(8 * k8 + kk) * INC + 4);
                    acc[0] += af[kk] * w0.x; acc[1] += af[kk] * w0.y; acc[2] += af[kk] * w0.z; acc[3] += af[kk] * w0.w;
                    acc[4] += af[kk] * w1.x; acc[5] += af[kk] * w1.y; acc[6] += af[kk] * w1.z; acc[7] += af[kk] * w1.w;
                }
            }
        }
        if (c0 < 1024) {
            float ss = 0.f;
#pragma unroll
            for (int j = 0; j < 8; ++j) ss += acc[j] * acc[j];
            ss += __shfl_xor(ss, 1); ss += __shfl_xor(ss, 2); ss += __shfl_xor(ss, 4);
            const float rs = rsqrtf(ss * (1.f / 64.f) + EPS);
            const bool isq = c0 < 512; const float* gain = isq ? qn : kn; const float sc = isq ? 0.125f * LOG2E : 1.f;
            float v[8];
#pragma unroll
            for (int j = 0; j < 8; ++j) v[j] = acc[j] * rs * gain[(c0 + j) & 63] * sc;
            v4u o; o.x = pk2(v[0], v[1]); o.y = pk2(v[2], v[3]); o.z = pk2(v[4], v[5]); o.w = pk2(v[6], v[7]);
            *(v4u*)(FOX + (size_t)row * FOXP + c0) = o;
        } else if (c0 < INC) {
#pragma unroll
            for (int j = 0; j < 8; ++j) {
                const int col = c0 + j; const float v = acc[j];
                if (col < 1536) FOX[(size_t)row * FOXP + col] = (bf16)f2bf(v);
                else if (col < 1544) SML[(size_t)row * SMLP + (col - 1536)] = logsig_f(v + f_bias[col - 1536]) * LOG2E;
                else if (col < 3080) GLA[(size_t)row * GLAP + (col - 1544)] = (bf16)f2bf(v);
                else if (col < 3096) SML[(size_t)row * SMLP + 8 + (col - 3080)] = v;
                else if (col < 4376) SSM[(size_t)row * SSMP + (col - 3096)] = (bf16)f2bf(v);
                else if (col < 4384) SML[(size_t)row * SMLP + 24 + (col - 4376)] = softplus_f(v + dt_bias[col - 4376]);
                else GATES[(size_t)row * GATP + (col - 4384)] = (bf16)f2bf(sigmoid_f(v + bgate[col - 4384]));
            }
        }
    }
}

__device__ __forceinline__ void ph_cumsum(const float* SML, float* CUM, LAS float* sh, int tid) {
    asm volatile("" : "+v"(tid));
    for (int seq = blockIdx.x; seq < 16; seq += gridDim.x) {
        const int b = seq >> 3, h = seq & 7;
        float loc[16]; float run = 0.f;
#pragma unroll
        for (int i = 0; i < 16; ++i) { run += SML[(size_t)(b * S_ + tid * 16 + i) * SMLP + h]; loc[i] = run; }
        const int lane_ = tid & 63, wave_ = tid >> 6;
        float inc = run;
#pragma unroll
        for (int o = 1; o < 64; o <<= 1) { const float t = __shfl_up(inc, o); if (lane_ >= o) inc += t; }
        __syncthreads();
        if (lane_ == 63) sh[512 + wave_] = inc;
        __syncthreads();
        float wp = 0.f;
#pragma unroll
        for (int w = 0; w < 8; ++w) wp += (w < wave_) ? sh[512 + w] : 0.f;
        sh[tid] = wp + inc - run;
        __syncthreads();
        const float ex = sh[tid];
#pragma unroll
        for (int i = 0; i < 16; ++i) CUM[(size_t)seq * S_ + tid * 16 + i] = ex + loc[i];
    }
}

__device__ __forceinline__ void attn_simple_wave(bf16* FOX, const float* CUM, int b, int h, int g, int lane) {
    const int t = g * 32 + (lane >> 1), hf = lane & 1;
    const size_t rowq = (size_t)(b * S_ + t) * FOXP + h * 64 + hf * 32;
    float q[32], o[32];
#pragma unroll
    for (int i = 0; i < 4; ++i) { const v4u w = *(const v4u*)(FOX + rowq + 8 * i);
        q[8 * i + 0] = bf2f(w.x & 0xffffu); q[8 * i + 1] = bf2f(w.x >> 16); q[8 * i + 2] = bf2f(w.y & 0xffffu); q[8 * i + 3] = bf2f(w.y >> 16);
        q[8 * i + 4] = bf2f(w.z & 0xffffu); q[8 * i + 5] = bf2f(w.z >> 16); q[8 * i + 6] = bf2f(w.w & 0xffffu); q[8 * i + 7] = bf2f(w.w >> 16); }
#pragma unroll
    for (int d = 0; d < 32; ++d) o[d] = 0.f;
    const float* cs = CUM + (size_t)(b * 8 + h) * S_;
    const float cq = cs[t];
    float m = -1e30f, l = 0.f;
    const int smax = g * 32 + 31;
#pragma unroll 1
    for (int s = 0; s <= smax; ++s) {
        const bf16* kp = FOX + (size_t)(b * S_ + s) * FOXP + 512 + h * 64 + hf * 32;
        float dot = 0.f;
#pragma unroll
        for (int i = 0; i < 4; ++i) { const v4u w = *(const v4u*)(kp + 8 * i);
            dot += q[8 * i + 0] * bf2f(w.x & 0xffffu) + q[8 * i + 1] * bf2f(w.x >> 16) + q[8 * i + 2] * bf2f(w.y & 0xffffu) + q[8 * i + 3] * bf2f(w.y >> 16)
                 + q[8 * i + 4] * bf2f(w.z & 0xffffu) + q[8 * i + 5] * bf2f(w.z >> 16) + q[8 * i + 6] * bf2f(w.w & 0xffffu) + q[8 * i + 7] * bf2f(w.w >> 16); }
        dot += __shfl_xor(dot, 1);
        float logit = dot + (cq - cs[s]);
        if (s > t) logit = -1e30f;
        const float mn = fmaxf(m, logit);
        const float sc = exp2f(m - mn), p = (s > t) ? 0.f : exp2f(logit - mn);
        l = l * sc + p; m = mn;
        const bf16* vp = kp + 512;
#pragma unroll
        for (int i = 0; i < 4; ++i) { const v4u w = *(const v4u*)(vp + 8 * i);
            o[8 * i + 0] = o[8 * i + 0] * sc + p * bf2f(w.x & 0xffffu); o[8 * i + 1] = o[8 * i + 1] * sc + p * bf2f(w.x >> 16);
            o[8 * i + 2] = o[8 * i + 2] * sc + p * bf2f(w.y & 0xffffu); o[8 * i + 3] = o[8 * i + 3] * sc + p * bf2f(w.y >> 16);
            o[8 * i + 4] = o[8 * i + 4] * sc + p * bf2f(w.z & 0xffffu); o[8 * i + 5] = o[8 * i + 5] * sc + p * bf2f(w.z >> 16);
            o[8 * i + 6] = o[8 * i + 6] * sc + p * bf2f(w.w & 0xffffu); o[8 * i + 7] = o[8 * i + 7] * sc + p * bf2f(w.w >> 16); }
    }
    const float rl = 1.f / l;
#pragma unroll
    for (int i = 0; i < 4; ++i) { v4u w; w.x = pk2(o[8 * i] * rl, o[8 * i + 1] * rl); w.y = pk2(o[8 * i + 2] * rl, o[8 * i + 3] * rl); w.z = pk2(o[8 * i + 4] * rl, o[8 * i + 5] * rl); w.w = pk2(o[8 * i + 6] * rl, o[8 * i + 7] * rl);
        *(v4u*)(FOX + rowq + 8 * i) = w; }
}

__device__ __forceinline__ void gla_simple_item(bf16* GLA, const float* SML, const float* w_lr, const float* b_gate, LAS float* L, int b, int h, int tid) {
    LAS float* qs = L; LAS float* ks = L + 4096; LAS float* ad = L + 8192; LAS float* vs = L + 12288; LAS float* ob = L + 20480; LAS float* red = L + 28672;
    const int v = tid & 127, dg = tid >> 7;
    float S[16];
#pragma unroll
    for (int i = 0; i < 16; ++i) S[i] = 0.f;
    for (int c = 0; c < S_ / 64; ++c) {
        const size_t row0 = (size_t)b * S_ + (size_t)c * 64;
        __syncthreads();
        for (int idx = tid; idx < 4096; idx += NTHR) { const int t = idx >> 6, d = idx & 63; const size_t row = row0 + t;
            qs[idx] = bf2f(GLA[row * GLAP + h * 64 + d]) * 0.125f; ks[idx] = bf2f(GLA[row * GLAP + 256 + h * 64 + d]);
            float z = b_gate[h * 64 + d];
#pragma unroll
            for (int j = 0; j < 16; ++j) z += SML[row * SMLP + 8 + j] * w_lr[j * 256 + h * 64 + d];
            ad[idx] = __expf(logsig_f(z) * (1.f / 16.f)); }
        for (int idx = tid; idx < 8192; idx += NTHR) { const int t = idx >> 7, vv = idx & 127; vs[idx] = bf2f(GLA[(row0 + t) * GLAP + 512 + h * 128 + vv]); }
        __syncthreads();
        for (int t = 0; t < 64; ++t) {
            const float vt = vs[t * 128 + v]; float part = 0.f;
#pragma unroll
            for (int i = 0; i < 16; ++i) { const int d = dg * 16 + i; S[i] = ad[t * 64 + d] * S[i] + ks[t * 64 + d] * vt; part += qs[t * 64 + d] * S[i]; }
            red[(t & 1) * 512 + dg * 128 + v] = part;
            __syncthreads();
            if (dg == 0) { const LAS float* rr = red + (t & 1) * 512; ob[t * 128 + v] = (rr[v] + rr[128 + v]) + (rr[256 + v] + rr[384 + v]); }
        }
        __syncthreads();
        for (int idx = tid; idx < 8192; idx += NTHR) { const int t = idx >> 7, vv = idx & 127; GLA[(row0 + t) * GLAP + 512 + h * 128 + vv] = (bf16)f2bf(ob[idx]); }
    }
}

__device__ __forceinline__ void ssd_simple_item(bf16* SSM, const float* SML, const float* conv_w, const float* conv_b, const float* a_log, const float* d_skip, LAS float* L, int b, int h, int tid) {
    LAS float* xs = L; LAS float* Bs = L + 4096; LAS float* Cs = L + 8192; LAS float* dts = L + 12288; LAS float* yb = L + 12352; LAS float* red = L + 16448;
    const int p = tid & 63, ng = tid >> 6, g = h >> 2;
    const float a = -__expf(a_log[h]), Dk = d_skip[h];
    float hs[8];
#pragma unroll
    for (int i = 0; i < 8; ++i) hs[i] = 0.f;
    for (int c = 0; c < S_ / 64; ++c) {
        const int s0 = c * 64;
        __syncthreads();
        for (int idx = tid; idx < 3 * 4096; idx += NTHR) { const int which = idx >> 12, t = (idx >> 6) & 63, n = idx & 63;
            const int ch = (which == 0) ? (h * 64 + n) : (which == 1 ? 512 + g * 64 + n : 640 + g * 64 + n);
            float acc = conv_b[ch];
#pragma unroll
            for (int j = 0; j < 4; ++j) { const int s = s0 + t - 3 + j; if (s >= 0) acc += conv_w[j * 768 + ch] * bf2f(SSM[((size_t)b * S_ + s) * SSMP + 512 + ch]); }
            L[idx] = silu_f(acc); }
        if (tid < 64) dts[tid] = SML[((size_t)b * S_ + s0 + tid) * SMLP + 24 + h];
        __syncthreads();
        for (int t = 0; t < 64; ++t) {
            const float dt = dts[t], dA = __expf(dt * a), xt = xs[t * 64 + p]; float part = 0.f;
#pragma unroll
            for (int i = 0; i < 8; ++i) { const int n = ng * 8 + i; hs[i] = dA * hs[i] + dt * Bs[t * 64 + n] * xt; part += Cs[t * 64 + n] * hs[i]; }
            red[(t & 1) * 512 + ng * 64 + p] = part;
            __syncthreads();
            if (ng == 0) { const LAS float* rr = red + (t & 1) * 512; float y = 0.f;
#pragma unroll
                for (int i = 0; i < 8; ++i) y += rr[i * 64 + p];
                yb[t * 64 + p] = y + Dk * xt; }
        }
        __syncthreads();
        for (int idx = tid; idx < 4096; idx += NTHR) { const int t = idx >> 6, pp = idx & 63; const size_t e = ((size_t)b * S_ + s0 + t) * SSMP + h * 64 + pp;
            const float z = bf2f(SSM[e]); SSM[e] = (bf16)f2bf(yb[idx] * silu_f(z)); }
    }
}

__device__ __forceinline__ void ph_mix_simple(bf16* FOX, const float* CUM, bf16* GLA, bf16* SSM, const float* SML, const float* w_lr, const float* b_gate,
                                              const float* conv_w, const float* conv_b, const float* a_log, const float* d_skip, LAS float* L, int tid, int wave, int lane) {
    asm volatile("" : "+v"(tid), "+s"(wave), "+v"(lane));
    for (int it = blockIdx.x; it < (FAST_ATTN ? 24 : 24 + 512); it += gridDim.x) {
        if (it < 8) gla_simple_item(GLA, SML, w_lr, b_gate, L, it >> 2, it & 3, tid);
        else if (it < 24) ssd_simple_item(SSM, SML, conv_w, conv_b, a_log, d_skip, L, (it - 8) >> 3, (it - 8) & 7, tid);
        else { const int wi = (it - 24) * 8 + wave; const int bh = wi >> 8, g = wi & 255; attn_simple_wave(FOX, CUM, bh >> 3, bh & 7, g, lane); }
        __syncthreads();
    }
}

__device__ __forceinline__ void ph_post(bf16* GLA, bf16* SSM, const float* gla_norm, const float* ssm_norm, int wave, int lane) {
    asm volatile("" : "+s"(wave), "+v"(lane));
    const int gw = blockIdx.x * NWAVES + wave, NGW = gridDim.x * NWAVES;
    for (int m = gw; m < T_; m += NGW) {
        {
            const v4u w = *(const v4u*)(GLA + (size_t)m * GLAP + 512 + 8 * lane), gr = *(const v4u*)(GLA + (size_t)m * GLAP + 1024 + 8 * lane);
            float o[8] = {bf2f(w.x & 0xffffu), bf2f(w.x >> 16), bf2f(w.y & 0xffffu), bf2f(w.y >> 16), bf2f(w.z & 0xffffu), bf2f(w.z >> 16), bf2f(w.w & 0xffffu), bf2f(w.w >> 16)};
            float gg[8] = {bf2f(gr.x & 0xffffu), bf2f(gr.x >> 16), bf2f(gr.y & 0xffffu), bf2f(gr.y >> 16), bf2f(gr.z & 0xffffu), bf2f(gr.z >> 16), bf2f(gr.w & 0xffffu), bf2f(gr.w >> 16)};
            float ss = 0.f;
#pragma unroll
            for (int j = 0; j < 8; ++j) ss += o[j] * o[j];
            ss += __shfl_xor(ss, 1); ss += __shfl_xor(ss, 2); ss += __shfl_xor(ss, 4); ss += __shfl_xor(ss, 8);
            const float rs = rsqrtf(ss * (1.f / 128.f) + EPS);
            float r[8];
#pragma unroll
            for (int j = 0; j < 8; ++j) r[j] = o[j] * rs * gla_norm[(8 * lane + j) & 127] * silu_f(gg[j]);
            v4u ov; ov.x = pk2(r[0], r[1]); ov.y = pk2(r[2], r[3]); ov.z = pk2(r[4], r[5]); ov.w = pk2(r[6], r[7]);
            *(v4u*)(GLA + (size_t)m * GLAP + 1024 + 8 * lane) = ov;
        }
        {
            const v4u w = *(const v4u*)(SSM + (size_t)m * SSMP + 8 * lane);
            float o[8] = {bf2f(w.x & 0xffffu), bf2f(w.x >> 16), bf2f(w.y & 0xffffu), bf2f(w.y >> 16), bf2f(w.z & 0xffffu), bf2f(w.z >> 16), bf2f(w.w & 0xffffu), bf2f(w.w >> 16)};
            float ss = 0.f;
#pragma unroll
            for (int j = 0; j < 8; ++j) ss += o[j] * o[j];
            ss += __shfl_xor(ss, 1); ss += __shfl_xor(ss, 2); ss += __shfl_xor(ss, 4); ss += __shfl_xor(ss, 8); ss += __shfl_xor(ss, 16);
            const float rs = rsqrtf(ss * (1.f / 256.f) + EPS);
            float r[8];
#pragma unroll
            for (int j = 0; j < 8; ++j) r[j] = o[j] * rs * ssm_norm[8 * lane + j];
            v4u ov; ov.x = pk2(r[0], r[1]); ov.y = pk2(r[2], r[3]); ov.z = pk2(r[4], r[5]); ov.w = pk2(r[6], r[7]);
            *(v4u*)(SSM + (size_t)m * SSMP + 8 * lane) = ov;
        }
    }
}

__device__ __forceinline__ void ph_merge_simple(bf16* FOX, const bf16* GLA, const bf16* SSM, const bf16* GATES, const float* w_branch, int tid) {
    asm volatile("" : "+v"(tid));
    const int r = tid >> 3, cg = tid & 7;
    for (int item = blockIdx.x; item < (T_ / 64) * 16; item += gridDim.x) {
        const int tm = item >> 4, tn = item & 15; const int row = tm * 64 + r, d0 = tn * 64 + cg * 8;
        float macc[8];
#pragma unroll
        for (int j = 0; j < 8; ++j) macc[j] = 0.f;
#pragma unroll 1
        for (int r3 = 0; r3 < 3; ++r3) {
            const bf16* a = (r3 == 0) ? FOX + (size_t)row * FOXP : (r3 == 1 ? GLA + (size_t)row * GLAP + 1024 : SSM + (size_t)row * SSMP);
            const float* w = w_branch + (size_t)r3 * 512 * 1024 + d0;
            float acc[8];
#pragma unroll
            for (int j = 0; j < 8; ++j) acc[j] = 0.f;
            for (int k8 = 0; k8 < 64; ++k8) {
                const v4u av = *(const v4u*)(a + 8 * k8);
                float af[8] = {bf2f(av.x & 0xffffu), bf2f(av.x >> 16), bf2f(av.y & 0xffffu), bf2f(av.y >> 16), bf2f(av.z & 0xffffu), bf2f(av.z >> 16), bf2f(av.w & 0xffffu), bf2f(av.w >> 16)};
#pragma unroll
                for (int kk = 0; kk < 8; ++kk) {
                    const f32x4 w0 = *(const f32x4*)(w + (size_t)(8 * k8 + kk) * 1024), w1 = *(const f32x4*)(w + (size_t)(8 * k8 + kk) * 1024 + 4);
                    acc[0] += af[kk] * w0.x; acc[1] += af[kk] * w0.y; acc[2] += af[kk] * w0.z; acc[3] += af[kk] * w0.w;
                    acc[4] += af[kk] * w1.x; acc[5] += af[kk] * w1.y; acc[6] += af[kk] * w1.z; acc[7] += af[kk] * w1.w;
                }
            }
            const v4u gv = *(const v4u*)(GATES + (size_t)row * GATP + r3 * 1024 + d0);
            macc[0] += bf2f(gv.x & 0xffffu) * acc[0]; macc[1] += bf2f(gv.x >> 16) * acc[1]; macc[2] += bf2f(gv.y & 0xffffu) * acc[2]; macc[3] += bf2f(gv.y >> 16) * acc[3];
            macc[4] += bf2f(gv.z & 0xffffu) * acc[4]; macc[5] += bf2f(gv.z >> 16) * acc[5]; macc[6] += bf2f(gv.w & 0xffffu) * acc[6]; macc[7] += bf2f(gv.w >> 16) * acc[7];
        }
        v4u o; o.x = pk2(macc[0], macc[1]); o.y = pk2(macc[2], macc[3]); o.z = pk2(macc[4], macc[5]); o.w = pk2(macc[6], macc[7]);
        *(v4u*)(FOX + (size_t)row * FOXP + 512 + d0) = o;
    }
}

__device__ __forceinline__ void ph_out_simple(const bf16* FOX, const float* w_out, const float* xold, float* xnew, int tid) {
    asm volatile("" : "+v"(tid));
    const int r = tid >> 3, cg = tid & 7;
    for (int item = blockIdx.x; item < (T_ / 64) * 16; item += gridDim.x) {
        const int tm = item >> 4, tn = item & 15; const int row = tm * 64 + r, d0 = tn * 64 + cg * 8;
        const bf16* a = FOX + (size_t)row * FOXP + 512; const float* w = w_out + d0;
        float acc[8];
#pragma unroll
        for (int j = 0; j < 8; ++j) acc[j] = 0.f;
        for (int k8 = 0; k8 < 128; ++k8) {
            const v4u av = *(const v4u*)(a + 8 * k8);
            float af[8] = {bf2f(av.x & 0xffffu), bf2f(av.x >> 16), bf2f(av.y & 0xffffu), bf2f(av.y >> 16), bf2f(av.z & 0xffffu), bf2f(av.z >> 16), bf2f(av.w & 0xffffu), bf2f(av.w >> 16)};
#pragma unroll
            for (int kk = 0; kk < 8; ++kk) {
                const f32x4 w0 = *(const f32x4*)(w + (size_t)(8 * k8 + kk) * 1024), w1 = *(const f32x4*)(w + (size_t)(8 * k8 + kk) * 1024 + 4);
                acc[0] += af[kk] * w0.x; acc[1] += af[kk] * w0.y; acc[2] += af[kk] * w0.z; acc[3] += af[kk] * w0.w;
                acc[4] += af[kk] * w1.x; acc[5] += af[kk] * w1.y; acc[6] += af[kk] * w1.z; acc[7] += af[kk] * w1.w;
            }
        }
        const f32x4 x0 = *(const f32x4*)(xold + (size_t)row * D_ + d0), x1 = *(const f32x4*)(xold + (size_t)row * D_ + d0 + 4);
        *(f32x4*)(xnew + (size_t)row * D_ + d0) = (f32x4){x0.x + acc[0], x0.y + acc[1], x0.z + acc[2], x0.w + acc[3]};
        *(f32x4*)(xnew + (size_t)row * D_ + d0 + 4) = (f32x4){x1.x + acc[4], x1.y + acc[5], x1.z + acc[6], x1.w + acc[7]};
    }
}

__device__ __forceinline__ void ph_norm2_route(const float* x, const float* gain, bf16* out, const float* wg, const float* bg, const float* we, const float* be, int* tok_e, float* tok_w, int wave, int lane) {
    asm volatile("" : "+s"(wave), "+v"(lane));
    const int gw = blockIdx.x * NWAVES + wave, NGW = gridDim.x * NWAVES;
    for (int m = gw; m < T_; m += NGW) {
        const f32x4* xr = (const f32x4*)(x + (size_t)m * D_) + lane;
        f32x4 v[4]; float s = 0.f;
#pragma unroll
        for (int j = 0; j < 4; ++j) { v[j] = xr[64 * j]; s += (v[j].x * v[j].x + v[j].y * v[j].y) + (v[j].z * v[j].z + v[j].w * v[j].w); }
        const float r = rsqrtf(wave_sum(s) * (1.f / D_) + EPS);
        v2u* o8 = (v2u*)(out + (size_t)m * D_) + lane;
        float gl[4] = {0.f, 0.f, 0.f, 0.f}; float hn[16];
#pragma unroll
        for (int j = 0; j < 4; ++j) { const f32x4 g = ((const f32x4*)gain)[lane + 64 * j];
            const float h0 = v[j].x * r * g.x, h1 = v[j].y * r * g.y, h2 = v[j].z * r * g.z, h3 = v[j].w * r * g.w;
            v2u w; w.x = pk2(h0, h1); w.y = pk2(h2, h3); o8[64 * j] = w;
            hn[4 * j] = h0; hn[4 * j + 1] = h1; hn[4 * j + 2] = h2; hn[4 * j + 3] = h3;
#pragma unroll
            for (int i = 0; i < 4; ++i) { const int k = 4 * (lane + 64 * j) + i; const f32x4 a = *(const f32x4*)(wg + (size_t)k * 4);
                gl[0] += hn[4 * j + i] * a.x; gl[1] += hn[4 * j + i] * a.y; gl[2] += hn[4 * j + i] * a.z; gl[3] += hn[4 * j + i] * a.w; } }
#pragma unroll
        for (int i = 0; i < 4; ++i) gl[i] = wave_sum(gl[i]) + bg[i];
        int gs = 0; float gm = gl[0];
#pragma unroll
        for (int i = 1; i < 4; ++i) if (gl[i] > gm) { gm = gl[i]; gs = i; }
        float gsum = 0.f;
#pragma unroll
        for (int i = 0; i < 4; ++i) gsum += __expf(gl[i] - gm);
        const float g_w = 1.f / gsum;
        gs = __builtin_amdgcn_readfirstlane(gs);
        float el[4] = {0.f, 0.f, 0.f, 0.f};
#pragma unroll
        for (int j = 0; j < 4; ++j)
#pragma unroll
            for (int i = 0; i < 4; ++i) { const int k = 4 * (lane + 64 * j) + i; const f32x4 c = *(const f32x4*)(we + (size_t)k * 16 + 4 * gs);
                el[0] += hn[4 * j + i] * c.x; el[1] += hn[4 * j + i] * c.y; el[2] += hn[4 * j + i] * c.z; el[3] += hn[4 * j + i] * c.w; }
#pragma unroll
        for (int i = 0; i < 4; ++i) el[i] = wave_sum(el[i]) + be[4 * gs + i];
        int i0 = 0; float m0 = el[0];
#pragma unroll
        for (int i = 1; i < 4; ++i) if (el[i] > m0) { m0 = el[i]; i0 = i; }
        int i1 = -1; float m1 = -3.0e38f;
#pragma unroll
        for (int i = 0; i < 4; ++i) if (i != i0 && el[i] > m1) { m1 = el[i]; i1 = i; }
        const float p1 = __expf(m1 - m0);
        const float w0 = g_w / (1.f + p1), w1 = g_w * p1 / (1.f + p1);
        if (lane == 0) { tok_e[2 * m] = gs * 4 + i0; tok_e[2 * m + 1] = gs * 4 + i1; tok_w[2 * m] = w0; tok_w[2 * m + 1] = w1; }
    }
}

__device__ __forceinline__ void ph_moe_simple(const bf16* HB, const int* tok_e, const float* tok_w, const float* wgate, const float* wup, const float* wdown, float* x, LAS float* L, int tid) {
    asm volatile("" : "+v"(tid));
    LAS float* hrow = L; LAS float* hid = L + 1024;
    for (int m = blockIdx.x; m < T_; m += gridDim.x) {
        __syncthreads();
        hrow[tid] = bf2f(HB[(size_t)m * D_ + tid]); hrow[tid + 512] = bf2f(HB[(size_t)m * D_ + tid + 512]);
        float y0 = 0.f, y1 = 0.f;
#pragma unroll 1
        for (int sl = 0; sl < 2; ++sl) {
            const int e = tok_e[2 * m + sl]; const float wt = tok_w[2 * m + sl];
            __syncthreads();
            const float* G = wgate + (size_t)e * 1024 * 512 + tid; const float* U = wup + (size_t)e * 1024 * 512 + tid;
            float g = 0.f, u = 0.f;
#pragma unroll 8
            for (int k = 0; k < 1024; ++k) { const float hk = hrow[k]; g += hk * G[(size_t)k * 512]; u += hk * U[(size_t)k * 512]; }
            hid[tid] = silu_f(g) * u;
            __syncthreads();
            const float* Dn = wdown + (size_t)e * 512 * 1024 + tid;
            float a0 = 0.f, a1 = 0.f;
#pragma unroll 8
            for (int j = 0; j < 512; ++j) { const float hj = hid[j]; a0 += hj * Dn[(size_t)j * 1024]; a1 += hj * Dn[(size_t)j * 1024 + 512]; }
            y0 += wt * a0; y1 += wt * a1;
        }
        x[(size_t)m * D_ + tid] += y0; x[(size_t)m * D_ + tid + 512] += y1;
    }
}


namespace pg8 {
typedef short bf16x8 __attribute__((ext_vector_type(8)));
constexpr int BM = 256, BK = 64, HALF = 128, HTB = HALF * BK * 2, STAGE_BYTES = 8 * HTB, NXCD = 8, WGM = 8;
__host__ __device__ __forceinline__ int lds_byte(int r, int c) { const int st = (r >> 4) * 2 + (c >> 5), rr = r & 15, cc = c & 31, ob = rr * 64 + cc * 2; return st * 1024 + (ob ^ (((ob >> 9) & 1) << 5)); }
__host__ __device__ __forceinline__ void stage_rc(int b, int& R, int& C) { const int st = b / 1024, sb = b % 1024, swz = sb ^ (((sb >> 9) & 1) << 5); R = (st >> 1) * 16 + swz / 64; C = (st & 1) * 32 + (swz % 64) / 2; }
__host__ __device__ __forceinline__ int perm32(int rho) { const int n = rho >> 4, i = rho & 15; return 8 * (i >> 2) + 4 * n + (i & 3); }
struct Unit { int pm, pn, aux; };
struct GridOrder {
    int nM, nN, nwg, G, c; const char* A; const char* B; size_t tsA, tsB;
    __device__ __forceinline__ void init(int M, int N, int G_, int c_, const void* A_, int lda, const void* B_, int ldb) { nM = M / BM; nN = N / BM; nwg = nM * nN; G = G_; c = c_; A = (const char*)A_; B = (const char*)B_; tsA = (size_t)BM * lda * 2; tsB = (size_t)BM * ldb * 2; }
    __device__ __forceinline__ bool next(int i, Unit& u) const {
        const long L = (long)i * G + c; if (L >= nwg) return false;
        int wgid = (int)L; { const int q = nwg / NXCD, r = nwg % NXCD, xcd = wgid % NXCD, off = wgid / NXCD; wgid = (xcd < r ? xcd * (q + 1) : r * (q + 1) + (xcd - r) * q) + off; }
        const int nig = WGM * nN, gid = wgid / nig, fm = gid * WGM, gsz = (nM - fm) < WGM ? (nM - fm) : WGM;
        u.pm = fm + ((wgid % nig) % gsz); u.pn = (wgid % nig) / gsz; u.aux = 0; return true;
    }
    __device__ __forceinline__ const char* abase(const Unit& u) const { return A + (size_t)u.pm * tsA; }
    __device__ __forceinline__ const char* bbase(const Unit& u) const { return B + (size_t)u.pn * tsB; }
};
template <class Epi, class Sched>
__device__ __forceinline__ void gemm_phase(LAS unsigned char* lds, const int K, const int lda, const Sched& S, const Epi& E) {
    int tid = threadIdx.x; asm volatile("" : "+v"(tid));
    const int wid = __builtin_amdgcn_readfirstlane(tid >> 6), lane = tid & 63, wr = wid >> 2, wc = wid & 3, fr = lane & 15, fq = lane >> 4;
    const int nt = K / BK;
    unsigned voffA[2], voffB[2];
#pragma unroll
    for (int i = 0; i < 2; ++i) { int R, C; stage_rc(tid * 16 + i * 8192, R, C); const int Rb = (R & ~31) + perm32(R & 31);
        voffA[i] = (unsigned)(R * lda + C) * 2u; voffB[i] = (unsigned)(Rb * K + C) * 2u; }
    const size_t kstep = (size_t)(BK * 2);
    const size_t hstepA = (size_t)HALF * lda * 2, hstepB = (size_t)HALF * K * 2;
    const unsigned ldsw = (unsigned)wid * 1024u;
    const int aoff = lds_byte(wr * 64 + fr, fq * 8), boff = lds_byte(wc * 32 + fr, fq * 8);
#define PG8_SA(b, h) (((b) * 2 + (h)) * HTB)
#define PG8_SB(b, h) ((4 + (b) * 2 + (h)) * HTB)
#define PG8_STAGE(bufoff, gbase, voff) do { _Pragma("unroll") for (int _i = 0; _i < 2; ++_i) \
        __builtin_amdgcn_global_load_lds((const unsigned*)((const char*)(gbase) + (voff)[_i]), (LAS unsigned*)(lds + (bufoff) + ldsw + _i * 8192), 16, 0, 0); } while (0)
#define PG8_LDA(dst, b, h) do { _Pragma("unroll") for (int m = 0; m < 4; ++m) _Pragma("unroll") for (int k = 0; k < 2; ++k) dst[m][k] = *(const LAS bf16x8*)(lds + PG8_SA(b, h) + aoff + m * 2048 + k * 1024); } while (0)
#define PG8_LDB(dst, b, h) do { _Pragma("unroll") for (int n = 0; n < 2; ++n) _Pragma("unroll") for (int k = 0; k < 2; ++k) dst[n][k] = *(const LAS bf16x8*)(lds + PG8_SB(b, h) + boff + n * 2048 + k * 1024); } while (0)
#define PG8_MMA(ai, bj, At, Bt) do { __builtin_amdgcn_s_setprio(1); _Pragma("unroll") for (int m = 0; m < 4; ++m) _Pragma("unroll") for (int n = 0; n < 2; ++n) _Pragma("unroll") for (int k = 0; k < 2; ++k) \
        acc[ai][bj][m][n] = __builtin_amdgcn_mfma_f32_16x16x32_bf16(Bt[n][k], At[m][k], acc[ai][bj][m][n], 0, 0, 0); __builtin_amdgcn_s_setprio(0); } while (0)
#define PG8_WAIT_V(n) asm volatile("s_waitcnt vmcnt(" #n ")" ::: "memory")
#define PG8_WAIT_L(n) asm volatile("s_waitcnt lgkmcnt(" #n ")" ::: "memory")
#define PG8_BAR __builtin_amdgcn_s_barrier()
#define PG8_SCHED __builtin_amdgcn_sched_barrier(0)
    Unit cur, nxt; int ui = 0;
    if (!S.next(0, cur)) return;
    f32x4 acc[2][2][4][2];
#pragma unroll
    for (int a = 0; a < 2; ++a)
#pragma unroll
        for (int b = 0; b < 2; ++b)
#pragma unroll
            for (int m = 0; m < 4; ++m)
#pragma unroll
                for (int n = 0; n < 2; ++n) acc[a][b][m][n] = (f32x4){0.f, 0.f, 0.f, 0.f};
    bf16x8 At[4][2], B0[2][2], B1[2][2];
    const char* cA = S.abase(cur); const char* cB = S.bbase(cur);
    PG8_STAGE(PG8_SB(0, 0), cB, voffB); PG8_STAGE(PG8_SB(0, 1), cB + hstepB, voffB); PG8_STAGE(PG8_SA(0, 0), cA, voffA); PG8_STAGE(PG8_SA(0, 1), cA + hstepA, voffA);
    if (wr == 1) PG8_BAR;
    PG8_WAIT_V(2); PG8_BAR;
    PG8_STAGE(PG8_SB(1, 0), cB + kstep, voffB); PG8_STAGE(PG8_SA(1, 0), cA + kstep, voffA); PG8_STAGE(PG8_SB(1, 1), cB + hstepB + kstep, voffB);
    PG8_WAIT_V(6); PG8_BAR;
    for (;;) {
        const bool has_next = S.next(ui + 1, nxt);
        const char* nA = has_next ? S.abase(nxt) : cA; const char* nB = has_next ? S.bbase(nxt) : cB;
        for (int t = 0; t < nt; t += 2) {
            const bool last = (t == nt - 2);
            const char* a1 = cA + (size_t)(t + 1) * kstep;
            const char* a2 = last ? nA : cA + (size_t)(t + 2) * kstep; const char* b2 = last ? nB : cB + (size_t)(t + 2) * kstep;
            const char* a3 = a2 + kstep; const char* b3 = b2 + kstep;
            PG8_LDB(B0, 0, 0); PG8_LDB(B1, 0, 1); PG8_SCHED; PG8_LDA(At, 0, 0); PG8_STAGE(PG8_SA(1, 1), a1 + hstepA, voffA);
            PG8_WAIT_V(8); PG8_WAIT_L(0); PG8_BAR; PG8_MMA(0, 0, At, B0); PG8_MMA(0, 1, At, B1); PG8_BAR; PG8_SCHED;
            PG8_LDA(At, 0, 1); PG8_STAGE(PG8_SB(0, 0), b2, voffB); PG8_STAGE(PG8_SB(0, 1), b2 + hstepB, voffB); PG8_STAGE(PG8_SA(0, 0), a2, voffA);
            PG8_WAIT_V(8); PG8_WAIT_L(0); PG8_BAR; PG8_MMA(1, 0, At, B0); PG8_MMA(1, 1, At, B1); PG8_BAR; PG8_SCHED;
            PG8_LDB(B0, 1, 0); PG8_LDB(B1, 1, 1); PG8_SCHED; PG8_LDA(At, 1, 0); PG8_STAGE(PG8_SA(0, 1), a2 + hstepA, voffA);
            PG8_WAIT_V(8); PG8_WAIT_L(0); PG8_BAR; PG8_MMA(0, 0, At, B0); PG8_MMA(0, 1, At, B1); PG8_BAR; PG8_SCHED;
            PG8_LDA(At, 1, 1); PG8_STAGE(PG8_SB(1, 0), b3, voffB); PG8_STAGE(PG8_SB(1, 1), b3 + hstepB, voffB); PG8_STAGE(PG8_SA(1, 0), a3, voffA);
            PG8_WAIT_V(8); PG8_WAIT_L(0); PG8_BAR; PG8_MMA(1, 0, At, B0); PG8_MMA(1, 1, At, B1); PG8_BAR; PG8_SCHED;
        }
        if (wr == 0) PG8_BAR;
        E(acc, cur, wr, wc, fr, fq);
        if (!has_next) break;
#pragma unroll
        for (int a = 0; a < 2; ++a)
#pragma unroll
            for (int b = 0; b < 2; ++b)
#pragma unroll
                for (int m = 0; m < 4; ++m)
#pragma unroll
                    for (int n = 0; n < 2; ++n) acc[a][b][m][n] = (f32x4){0.f, 0.f, 0.f, 0.f};
        cur = nxt; cA = nA; cB = nB; ++ui;
        if (wr == 1) PG8_BAR;
    }
    PG8_WAIT_V(0);
    PG8_BAR;
#undef PG8_SA
#undef PG8_SB
#undef PG8_STAGE
#undef PG8_LDA
#undef PG8_LDB
#undef PG8_MMA
#undef PG8_WAIT_V
#undef PG8_WAIT_L
#undef PG8_BAR
#undef PG8_SCHED
}
typedef float f32x2_t __attribute__((ext_vector_type(2))); typedef __bf16 bf16x2_t __attribute__((ext_vector_type(2)));
__device__ __forceinline__ unsigned cvt_pk_bf16(float lo, float hi) { f32x2_t v = {lo, hi}; bf16x2_t b = __builtin_convertvector(v, bf16x2_t); return __builtin_bit_cast(unsigned, b); }
__device__ __forceinline__ v4u pack8(const f32x4 a, const f32x4 b) { v4u w; w.x = cvt_pk_bf16(a[0], a[1]); w.y = cvt_pk_bf16(a[2], a[3]); w.z = cvt_pk_bf16(b[0], b[1]); w.w = cvt_pk_bf16(b[2], b[3]); return w; }

struct EpiInproj {
    bf16* FOX; bf16* GLA; bf16* SSM; float* SML; bf16* GATES; const float *qn, *kn, *f_bias, *dt_bias, *bgate;
    __device__ __forceinline__ void operator()(const f32x4 (&acc)[2][2][4][2], const Unit& u, int wr, int wc, int fr, int fq) const {
        asm volatile("" : "+v"(fr), "+v"(fq), "+s"(wr), "+s"(wc));
        const int pn = u.pn; const size_t row0 = (size_t)u.pm * BM + wr * 64 + fr;
        if (EPI_SKIP(pn)) return;
        if (pn < 4) {
            const bool isq = pn < 2; const float* gain = isq ? qn : kn; const float sc = isq ? 0.125f * LOG2E : 1.f;
            f32x4 g[2][2];
#pragma unroll
            for (int bj = 0; bj < 2; ++bj)
#pragma unroll
                for (int n = 0; n < 2; ++n) g[bj][n] = *(const f32x4*)(gain + 32 * bj + 8 * fq + 4 * n);
            bf16* dst = FOX + (isq ? 0 : 512) + (pn & 1) * 256 + 64 * wc + 8 * fq;
#pragma unroll
            for (int ai = 0; ai < 2; ++ai)
#pragma unroll
                for (int m = 0; m < 4; ++m) {
                    float ss = 0.f;
#pragma unroll
                    for (int bj = 0; bj < 2; ++bj)
#pragma unroll
                        for (int n = 0; n < 2; ++n) { const f32x4 x = acc[ai][bj][m][n]; ss += (x[0] * x[0] + x[1] * x[1]) + (x[2] * x[2] + x[3] * x[3]); }
                    ss += __shfl_xor(ss, 16); ss += __shfl_xor(ss, 32);
                    const float rs = rsqrtf(ss * (1.f / 64.f) + EPS) * sc;
                    bf16* rp = dst + (row0 + ai * HALF + m * 16) * FOXP;
#pragma unroll
                    for (int bj = 0; bj < 2; ++bj) *(v4u*)(rp + 32 * bj) = pack8(acc[ai][bj][m][0] * rs * g[bj][0], acc[ai][bj][m][1] * rs * g[bj][1]);
                }
        } else if (pn == 17) {
            if (wc == 0) {
                f32x4 b0 = (f32x4){0.f, 0.f, 0.f, 0.f}, b1 = b0;
                if (fq == 0) { b0 = *(const f32x4*)(f_bias); b1 = *(const f32x4*)(f_bias + 4); }
                if (fq == 3) { b0 = *(const f32x4*)(dt_bias); b1 = *(const f32x4*)(dt_bias + 4); }
#pragma unroll
                for (int ai = 0; ai < 2; ++ai)
#pragma unroll
                    for (int m = 0; m < 4; ++m) {
                        f32x4 v0 = acc[ai][0][m][0] + b0, v1 = acc[ai][0][m][1] + b1;
                        if (fq == 0) {
#pragma unroll
                            for (int i = 0; i < 4; ++i) { v0[i] = logsig_f(v0[i]) * LOG2E; v1[i] = logsig_f(v1[i]) * LOG2E; } }
                        if (fq == 3) {
#pragma unroll
                            for (int i = 0; i < 4; ++i) { v0[i] = softplus_f(v0[i]); v1[i] = softplus_f(v1[i]); } }
                        float* rp = SML + (row0 + ai * HALF + m * 16) * SMLP + 8 * fq;
                        *(f32x4*)rp = v0; *(f32x4*)(rp + 4) = v1;
                    }
            }
        } else if (pn >= 18) {
            const int colt = (pn - 18) * 256 + 32 * wc + 8 * fq;
#pragma unroll
            for (int bj = 0; bj < 2; ++bj) {
                const f32x4 b0 = *(const f32x4*)(bgate + colt + bj * HALF), b1 = *(const f32x4*)(bgate + colt + bj * HALF + 4);
#pragma unroll
                for (int ai = 0; ai < 2; ++ai)
#pragma unroll
                    for (int m = 0; m < 4; ++m) {
                        f32x4 v0 = acc[ai][bj][m][0] + b0, v1 = acc[ai][bj][m][1] + b1;
#pragma unroll
                        for (int i = 0; i < 4; ++i) { v0[i] = __builtin_amdgcn_rcpf(1.f + __expf(-v0[i])); v1[i] = __builtin_amdgcn_rcpf(1.f + __expf(-v1[i])); }
                        *(v4u*)(GATES + (row0 + ai * HALF + m * 16) * GATP + colt + bj * HALF) = pack8(v0, v1);
                    }
            }
        } else {
            bf16* dst = (pn < 6) ? FOX + 1024 + (pn - 4) * 256 : (pn < 12 ? GLA + (pn - 6) * 256 : SSM + (pn - 12) * 256);
            dst += 32 * wc + 8 * fq;
#pragma unroll
            for (int ai = 0; ai < 2; ++ai)
#pragma unroll
                for (int m = 0; m < 4; ++m) { bf16* rp = dst + (row0 + ai * HALF + m * 16) * 1536;
#pragma unroll
                    for (int bj = 0; bj < 2; ++bj) *(v4u*)(rp + bj * HALF) = pack8(acc[ai][bj][m][0], acc[ai][bj][m][1]); }
        }
    }
};
struct EpiResidual {
    const float* xold; float* xnew;
    __device__ __forceinline__ void operator()(const f32x4 (&acc)[2][2][4][2], const Unit& u, int wr, int wc, int fr, int fq) const {
        asm volatile("" : "+v"(fr), "+v"(fq), "+s"(wr), "+s"(wc));
        const size_t row0 = (size_t)u.pm * BM + wr * 64 + fr; const int col0 = u.pn * BM + 32 * wc + 8 * fq;
#pragma unroll
        for (int ai = 0; ai < 2; ++ai)
#pragma unroll
            for (int m = 0; m < 4; ++m) { const size_t off = (row0 + ai * HALF + m * 16) * D_ + col0;
#pragma unroll
                for (int bj = 0; bj < 2; ++bj) { const f32x4 x0 = *(const f32x4*)(xold + off + bj * HALF), x1 = *(const f32x4*)(xold + off + bj * HALF + 4);
                    *(f32x4*)(xnew + off + bj * HALF) = x0 + acc[ai][bj][m][0]; *(f32x4*)(xnew + off + bj * HALF + 4) = x1 + acc[ai][bj][m][1]; } }
    }
};
struct MergeOrder {
    int G, c; const char* ws; const char* B;
    __device__ __forceinline__ bool next(int i, Unit& u) const { const int q = i / 3; const int tile = c + q * G; if (tile >= 256) return false; u.pm = tile >> 2; u.pn = tile & 3; u.aux = i - 3 * q; return true; }
    __device__ __forceinline__ const char* abase(const Unit& u) const { return ws + WS_FOX + (size_t)u.aux * (48 * MiB) + (size_t)(u.aux & 1) * 2048 + (size_t)u.pm * BM * 1536 * 2; }
    __device__ __forceinline__ const char* bbase(const Unit& u) const { return B + ((size_t)u.aux * 1024 + (size_t)u.pn * BM) * 512 * 2; }
};
static_assert(WS_GLA - WS_FOX == 48 * MiB && WS_SSM - WS_GLA == 48 * MiB, "MergeOrder::abase");
struct EpiMerge {
    const bf16* GATES; bf16* MB;
    __device__ __forceinline__ void operator()(const f32x4 (&acc)[2][2][4][2], const Unit& u, int wr, int wc, int fr, int fq) const {
        asm volatile("" : "+v"(fr), "+v"(fq), "+s"(wr), "+s"(wc));
        const size_t row0 = (size_t)u.pm * BM + wr * 64 + fr; const int col0 = u.pn * BM + 32 * wc + 8 * fq; const int r = u.aux;
#pragma unroll
        for (int ai = 0; ai < 2; ++ai)
#pragma unroll
            for (int m = 0; m < 4; ++m) { const size_t row = row0 + ai * HALF + m * 16;
#pragma unroll
                for (int bj = 0; bj < 2; ++bj) {
                    const v4u gv = *(const v4u*)(GATES + row * GATP + r * 1024 + col0 + bj * HALF);
                    f32x4 v0 = acc[ai][bj][m][0], v1 = acc[ai][bj][m][1];
                    v0[0] *= bf2f(gv.x & 0xffffu); v0[1] *= bf2f(gv.x >> 16); v0[2] *= bf2f(gv.y & 0xffffu); v0[3] *= bf2f(gv.y >> 16);
                    v1[0] *= bf2f(gv.z & 0xffffu); v1[1] *= bf2f(gv.z >> 16); v1[2] *= bf2f(gv.w & 0xffffu); v1[3] *= bf2f(gv.w >> 16);
                    bf16* mp = MB + row * FOXP + col0 + bj * HALF;
                    if (r > 0) { const v4u pv = *(const v4u*)mp;
                        v0[0] += bf2f(pv.x & 0xffffu); v0[1] += bf2f(pv.x >> 16); v0[2] += bf2f(pv.y & 0xffffu); v0[3] += bf2f(pv.y >> 16);
                        v1[0] += bf2f(pv.z & 0xffffu); v1[1] += bf2f(pv.z >> 16); v1[2] += bf2f(pv.w & 0xffffu); v1[3] += bf2f(pv.w >> 16); }
                    *(v4u*)mp = pack8(v0, v1);
                } }
    }
};
}

__device__ __forceinline__ int inproj_src_col(int p) {
    const int tile = p >> 8, q = p & 255;
    if (tile < 4) { const int base = (tile < 2 ? 0 : 512) + (tile & 1) * 256; return base + 64 * ((q >> 5) & 3) + 32 * (q >> 7) + (q & 31); }
    if (tile < 6) return 1024 + (tile - 4) * 256 + q;
    if (tile < 12) return 1544 + (tile - 6) * 256 + q;
    if (tile < 17) return 3096 + (tile - 12) * 256 + q;
    if (tile == 17) return q < 8 ? 1536 + q : (q < 24 ? 3080 + (q - 8) : (q < 32 ? 4376 + (q - 24) : -1));
    return 4384 + (tile - 18) * 256 + q;
}
__device__ __forceinline__ void transpose_item(const float* W, int ldw, int src4, bf16* WT, int K, int p0, int k0, LAS float* scr, int lane) {
    const int n4 = lane & 7, kr = lane >> 3;
    f32x4 v[8];
#pragma unroll
    for (int i = 0; i < 8; ++i) v[i] = (src4 >= 0) ? *(const f32x4*)(W + (size_t)(k0 + kr + 8 * i) * ldw + src4) : (f32x4){0.f, 0.f, 0.f, 0.f};
#pragma unroll
    for (int i = 0; i < 8; ++i) *(LAS f32x4*)(scr + (kr + 8 * i) * 36 + 4 * n4) = v[i];
    asm volatile("s_waitcnt lgkmcnt(0)" ::: "memory");
    const int c = lane & 7;
#pragma unroll
    for (int j = 0; j < 4; ++j) { const int n = (lane >> 3) + 8 * j; const LAS float* sp = scr + (8 * c) * 36 + n;
        v4u o; o.x = pk2(sp[0 * 36], sp[1 * 36]); o.y = pk2(sp[2 * 36], sp[3 * 36]); o.z = pk2(sp[4 * 36], sp[5 * 36]); o.w = pk2(sp[6 * 36], sp[7 * 36]);
        *(v4u*)(WT + (size_t)(p0 + n) * K + k0 + 8 * c) = o; }
    asm volatile("s_waitcnt lgkmcnt(0)" ::: "memory");
}
__device__ __forceinline__ void convert_small_weights(const float* w_in, const float* w_branch, const float* w_out, bf16* WIN, bf16* WBR, bf16* WOUT, LAS float* scr, int wave, int lane) {
    asm volatile("" : "+s"(wave), "+v"(lane));
    const int gw = blockIdx.x * NWAVES + wave, NGW = gridDim.x * NWAVES;
    constexpr int I_IN = 16 * 240, I_BR = 8 * 32, I_OUT = 16 * 32;
    for (int it = gw; it < I_IN + 3 * I_BR + I_OUT; it += NGW) {
        int r = it;
        if (r < I_IN) { const int kb = r / 240, pb = r % 240; transpose_item(w_in, INC, inproj_src_col(pb * 32 + 4 * (lane & 7)), WIN, 1024, pb * 32, kb * 64, scr, lane); continue; } r -= I_IN;
        if (r < 3 * I_BR) { const int br = r / I_BR, q = r % I_BR, kb = q / 32, pb = q % 32; transpose_item(w_branch + (size_t)br * 512 * 1024, 1024, pb * 32 + 4 * (lane & 7), WBR + (size_t)br * 1024 * 512, 512, pb * 32, kb * 64, scr, lane); continue; } r -= 3 * I_BR;
        { const int kb = r / 32, pb = r % 32; transpose_item(w_out, 1024, pb * 32 + 4 * (lane & 7), WOUT, 1024, pb * 32, kb * 64, scr, lane); }
    }
}

__device__ __forceinline__ void ph_norm2_route_blk(const float* x, const float* gain, bf16* out, const float* wg, const float* bg, const float* we, const float* be,
                                                   int* tok_e, float* tok_w, int* lrank, int* cntblk, LAS int* sE, int tid, int wave, int lane) {
    asm volatile("" : "+v"(tid), "+s"(wave), "+v"(lane));
    LAS int* sR = sE + 128;
    for (int blk = blockIdx.x; blk < 256; blk += gridDim.x) {
        __syncthreads();
#pragma unroll 1
        for (int i = 0; i < 8; ++i) {
            const int m = blk * 64 + wave * 8 + i;
            const f32x4* xr = (const f32x4*)(x + (size_t)m * D_) + lane;
            f32x4 v[4]; float s = 0.f;
#pragma unroll
            for (int j = 0; j < 4; ++j) { v[j] = xr[64 * j]; s += (v[j].x * v[j].x + v[j].y * v[j].y) + (v[j].z * v[j].z + v[j].w * v[j].w); }
            const float r = rsqrtf(wave_sum(s) * (1.f / D_) + EPS);
            v2u* o8 = (v2u*)(out + (size_t)m * D_) + lane;
            float gl[4] = {0.f, 0.f, 0.f, 0.f}; float hn[16];
#pragma unroll
            for (int j = 0; j < 4; ++j) { const f32x4 g = ((const f32x4*)gain)[lane + 64 * j];
                const float h0 = v[j].x * r * g.x, h1 = v[j].y * r * g.y, h2 = v[j].z * r * g.z, h3 = v[j].w * r * g.w;
                v2u w; w.x = pk2(h0, h1); w.y = pk2(h2, h3); o8[64 * j] = w;
                hn[4 * j] = h0; hn[4 * j + 1] = h1; hn[4 * j + 2] = h2; hn[4 * j + 3] = h3;
#pragma unroll
                for (int q = 0; q < 4; ++q) { const int k = 4 * (lane + 64 * j) + q; const f32x4 a = *(const f32x4*)(wg + (size_t)k * 4);
                    gl[0] += hn[4 * j + q] * a.x; gl[1] += hn[4 * j + q] * a.y; gl[2] += hn[4 * j + q] * a.z; gl[3] += hn[4 * j + q] * a.w; } }
#pragma unroll
            for (int q = 0; q < 4; ++q) gl[q] = wave_sum(gl[q]) + bg[q];
            int gs = 0; float gm = gl[0];
#pragma unroll
            for (int q = 1; q < 4; ++q) if (gl[q] > gm) { gm = gl[q]; gs = q; }
            float gsum = 0.f;
#pragma unroll
            for (int q = 0; q < 4; ++q) gsum += __expf(gl[q] - gm);
            const float g_w = 1.f / gsum;
            gs = __builtin_amdgcn_readfirstlane(gs);
            float el[4] = {0.f, 0.f, 0.f, 0.f};
#pragma unroll
            for (int j = 0; j < 4; ++j)
#pragma unroll
                for (int q = 0; q < 4; ++q) { const int k = 4 * (lane + 64 * j) + q; const f32x4 c = *(const f32x4*)(we + (size_t)k * 16 + 4 * gs);
                    el[0] += hn[4 * j + q] * c.x; el[1] += hn[4 * j + q] * c.y; el[2] += hn[4 * j + q] * c.z; el[3] += hn[4 * j + q] * c.w; }
#pragma unroll
            for (int q = 0; q < 4; ++q) el[q] = wave_sum(el[q]) + be[4 * gs + q];
            int i0 = 0; float m0 = el[0];
#pragma unroll
            for (int q = 1; q < 4; ++q) if (el[q] > m0) { m0 = el[q]; i0 = q; }
            int i1 = -1; float m1 = -3.0e38f;
#pragma unroll
            for (int q = 0; q < 4; ++q) if (q != i0 && el[q] > m1) { m1 = el[q]; i1 = q; }
            const float p1 = __expf(m1 - m0);
            if (lane == 0) { const int e0 = gs * 4 + i0, e1 = gs * 4 + i1; tok_e[2 * m] = e0; tok_e[2 * m + 1] = e1; tok_w[2 * m] = g_w / (1.f + p1); tok_w[2 * m + 1] = g_w * p1 / (1.f + p1);
                sE[(wave * 8 + i) * 2] = e0; sE[(wave * 8 + i) * 2 + 1] = e1; }
        }
        __syncthreads();
        if (tid < 16) { int cnt = 0; for (int a = 0; a < 128; ++a) if (sE[a] == tid) { sR[a] = cnt; ++cnt; } cntblk[blk * 16 + tid] = cnt; }
        __syncthreads();
        if (tid < 128) lrank[blk * 128 + tid] = sR[tid];
    }
}
__device__ __forceinline__ void convert_expert_weights(const float* wgate, const float* wup, const float* wdown, bf16* W1, bf16* WD, LAS float* scr, int wave, int lane) {
    asm volatile("" : "+s"(wave), "+v"(lane));
    const int gw = blockIdx.x * NWAVES + wave, NGW = gridDim.x * NWAVES;
    for (int it = gw; it < 16 * 768; it += NGW) {
        const int e = it / 768; int r = it - e * 768;
        if (r < 512) { const int kb = r >> 5, pb = r & 31, t = pb >> 3, sub = pb & 7; const float* src = ((sub < 4) ? wgate : wup) + (size_t)e * 1024 * 512;
            transpose_item(src, 512, 128 * t + (sub & 3) * 32 + 4 * (lane & 7), W1 + (size_t)e * 1024 * 1024, 1024, pb * 32, kb * 64, scr, lane); }
        else { r -= 512; const int kb = r >> 5, pb = r & 31; transpose_item(wdown + (size_t)e * 512 * 1024, 1024, pb * 32 + 4 * (lane & 7), WD + (size_t)e * 1024 * 512, 512, pb * 32, kb * 64, scr, lane); }
    }
}
__device__ __forceinline__ void ph_moe_scatter(const bf16* HB, bf16* HS, const int* tok_e, const float* tok_w, const int* lrank, const int* cntblk, int* rowtok, float* roww, int* rowof,
                                               LAS int* sPre, LAS int* sRow, LAS int* sTb, LAS int* sTot, int tid, int wave, int lane) {
    asm volatile("" : "+v"(tid), "+s"(wave), "+v"(lane));
    __syncthreads();
    { LAS int* sCnt = sPre + 4096; LAS int* sSeg = sPre + 8192;
#pragma unroll
      for (int i = 0; i < 8; ++i) sCnt[tid + i * NTHR] = cntblk[tid + i * NTHR];
      __syncthreads();
      const int e = tid & 15, seg = tid >> 4; int loc = 0;
#pragma unroll
      for (int j = 0; j < 8; ++j) loc += sCnt[(seg * 8 + j) * 16 + e];
      sSeg[seg * 16 + e] = loc;
      __syncthreads();
      if (tid < 16) { int run = 0; for (int sg = 0; sg < 32; ++sg) { const int t = sSeg[sg * 16 + tid]; sSeg[sg * 16 + tid] = run; run += t; } sTot[tid] = run; }
      __syncthreads();
      int run = sSeg[seg * 16 + e];
#pragma unroll
      for (int j = 0; j < 8; ++j) { sPre[(seg * 8 + j) * 16 + e] = run; run += sCnt[(seg * 8 + j) * 16 + e]; } }
    __syncthreads();
    if (tid == 0) { int t = 0; for (int e = 0; e < 16; ++e) { sTb[e] = t; t += (sTot[e] + 255) >> 8; } sTb[16] = t; }
    __syncthreads();
    for (int e = blockIdx.x; e < 16; e += gridDim.x) { const int r1 = sTb[e + 1] * 256; for (int r = sTb[e] * 256 + sTot[e] + tid; r < r1; r += NTHR) { rowtok[r] = -1; roww[r] = 0.f; } }
    for (int blk = blockIdx.x; blk < 256; blk += gridDim.x) {
        __syncthreads();
        if (tid < 128) { const int t = blk * 64 + (tid >> 1); const int e = tok_e[2 * t + (tid & 1)];
            const int row = sTb[e] * 256 + sPre[blk * 16 + e] + lrank[blk * 128 + tid]; rowtok[row] = t; roww[row] = tok_w[2 * t + (tid & 1)]; rowof[2 * t + (tid & 1)] = row; sRow[tid] = row; }
        __syncthreads();
        for (int a = wave; a < 128; a += NWAVES) { const int t = blk * 64 + (a >> 1); const int row = sRow[a];
            const v4u* src = (const v4u*)(HB + (size_t)t * D_); v4u* dst = (v4u*)(HS + (size_t)row * D_); const v4u a0 = src[lane], a1 = src[lane + 64]; dst[lane] = a0; dst[lane + 64] = a1; }
    }
}
namespace pg8 {
struct MoeOrder {
    int G, c; const char* A; size_t tsA; const char* B; size_t strideE, tsB; const LAS int* tb;
    __device__ __forceinline__ bool next(int i, Unit& u) const {
        const int uu = c + i * G; const int TT = __builtin_amdgcn_readfirstlane(tb[16]); if (uu >= 4 * TT) return false;
        const int grt = uu >> 2; u.pm = grt; u.pn = uu & 3; int e = 0;
#pragma unroll
        for (int k = 1; k < 16; ++k) e += (grt >= __builtin_amdgcn_readfirstlane(tb[k])) ? 1 : 0;
        u.aux = e; return true; }
    __device__ __forceinline__ const char* abase(const Unit& u) const { return A + (size_t)u.pm * tsA; }
    __device__ __forceinline__ const char* bbase(const Unit& u) const { return B + (size_t)u.aux * strideE + (size_t)u.pn * tsB; }
};
struct EpiMoe1 {
    bf16* HID;
    __device__ __forceinline__ void operator()(const f32x4 (&acc)[2][2][4][2], const Unit& u, int wr, int wc, int fr, int fq) const {
        asm volatile("" : "+v"(fr), "+v"(fq), "+s"(wr), "+s"(wc));
        const size_t row0 = (size_t)u.pm * BM + wr * 64 + fr; const int col = u.pn * 128 + 32 * wc + 8 * fq;
#pragma unroll
        for (int ai = 0; ai < 2; ++ai)
#pragma unroll
            for (int m = 0; m < 4; ++m) {
                f32x4 h0, h1;
#pragma unroll
                for (int i = 0; i < 4; ++i) { const float g0 = acc[ai][0][m][0][i], g1 = acc[ai][0][m][1][i];
                    h0[i] = g0 * __builtin_amdgcn_rcpf(1.f + __expf(-g0)) * acc[ai][1][m][0][i]; h1[i] = g1 * __builtin_amdgcn_rcpf(1.f + __expf(-g1)) * acc[ai][1][m][1][i]; }
                *(v4u*)(HID + (row0 + ai * HALF + m * 16) * 512 + col) = pack8(h0, h1);
            }
    }
};
struct EpiMoe2 {
    const float* roww; bf16* Y;
    __device__ __forceinline__ void operator()(const f32x4 (&acc)[2][2][4][2], const Unit& u, int wr, int wc, int fr, int fq) const {
        asm volatile("" : "+v"(fr), "+v"(fq), "+s"(wr), "+s"(wc));
        const size_t row0 = (size_t)u.pm * BM + wr * 64 + fr; const int col0 = u.pn * BM + 32 * wc + 8 * fq;
#pragma unroll
        for (int ai = 0; ai < 2; ++ai)
#pragma unroll
            for (int m = 0; m < 4; ++m) { const size_t grow = row0 + ai * HALF + m * 16; const float w = roww[grow];
#pragma unroll
                for (int bj = 0; bj < 2; ++bj) *(v4u*)(Y + grow * D_ + col0 + bj * HALF) = pack8(acc[ai][bj][m][0] * w, acc[ai][bj][m][1] * w); }
    }
};
}

namespace mm {
typedef short bf16x8 __attribute__((ext_vector_type(8)));
constexpr int LD = 72;
__device__ __forceinline__ bf16x8 frag(const LAS bf16* M, int r0, int k0, int lane) { return *(const LAS bf16x8*)(M + (r0 + (lane & 15)) * LD + k0 + 8 * (lane >> 4)); }
__device__ __forceinline__ bf16x8 frag_g(const float* M, int r0, int k0, int lane) {
    const float* p = M + (size_t)(r0 + (lane & 15)) * 64 + k0 + 8 * (lane >> 4); const f32x4 a = *(const f32x4*)p, b = *(const f32x4*)(p + 4);
    const v4u w = pg8::pack8(a, b); return __builtin_bit_cast(bf16x8, w); }
__device__ __forceinline__ f32x4 mma(bf16x8 xf, bf16x8 yf, f32x4 acc) { return __builtin_amdgcn_mfma_f32_16x16x32_bf16(xf, yf, acc, 0, 0, 0); }
__device__ __forceinline__ float wave_incl_scan(float v, int lane) {
#pragma unroll
    for (int o = 1; o < 64; o <<= 1) { const float t = __shfl_up(v, o); if (lane >= o) v += t; }
    return v; }
}
constexpr int GST_CH = 8192, SST_CH = 4096;
constexpr int XCP = 768;
__device__ __forceinline__ float logsig_fast(float x) { return fminf(x, 0.f) - __logf(1.f + __expf(-fabsf(x))); }
__device__ __forceinline__ mm::bf16x8 frag_gb(const bf16* M, int r0, int k0, int lane) { return *(const mm::bf16x8*)(M + (size_t)(r0 + (lane & 15)) * 64 + k0 + 8 * (lane >> 4)); }
__device__ __forceinline__ v2u pack4(const f32x4 a) { v2u w; w.x = pg8::cvt_pk_bf16(a[0], a[1]); w.y = pg8::cvt_pk_bf16(a[2], a[3]); return w; }

__device__ __forceinline__ void gla_bcum(const float* SML, const float* w_lr, const float* b_gate, LAS float* BC, LAS float* BL, LAS float* WSM8, size_t row0, int h, int wave, int lane) {
    const int col = h * 64 + lane;
    float wc[16];
#pragma unroll
    for (int j = 0; j < 16; ++j) wc[j] = w_lr[j * 256 + col];
    const float bg = b_gate[col];
    float loc[8], run = 0.f;
#pragma unroll
    for (int i = 0; i < 8; ++i) { const f32x4* gp = (const f32x4*)(SML + (row0 + wave * 8 + i) * SMLP + 8);
        const f32x4 g0 = gp[0], g1 = gp[1], g2 = gp[2], g3 = gp[3];
        float z = bg + (g0[0] * wc[0] + g0[1] * wc[1] + g0[2] * wc[2] + g0[3] * wc[3]) + (g1[0] * wc[4] + g1[1] * wc[5] + g1[2] * wc[6] + g1[3] * wc[7])
                     + (g2[0] * wc[8] + g2[1] * wc[9] + g2[2] * wc[10] + g2[3] * wc[11]) + (g3[0] * wc[12] + g3[1] * wc[13] + g3[2] * wc[14] + g3[3] * wc[15]);
        run += logsig_fast(z) * (1.f / 16.f); loc[i] = run; }
    WSM8[wave * 64 + lane] = run;
    __syncthreads();
    float pre = 0.f;
#pragma unroll
    for (int w = 0; w < 8; ++w) pre += (w < wave) ? WSM8[w * 64 + lane] : 0.f;
#pragma unroll
    for (int i = 0; i < 8; ++i) BC[(wave * 8 + i) * 64 + lane] = pre + loc[i];
    if (wave == 7) BL[lane] = pre + run;
}
__device__ __forceinline__ void gla_stage_vt(const bf16* GLA, LAS bf16* VT, size_t row0, int h, int tid) {
#pragma unroll
    for (int j = 0; j < 2; ++j) { const int idx = tid + j * NTHR, s = idx >> 4, vg = idx & 15;
        const v4u w = *(const v4u*)(GLA + (row0 + s) * GLAP + 512 + h * 128 + vg * 8); LAS bf16* o = VT + (vg * 8) * mm::LD + s;
        o[0] = (bf16)(w.x & 0xffffu); o[mm::LD] = (bf16)(w.x >> 16); o[2 * mm::LD] = (bf16)(w.y & 0xffffu); o[3 * mm::LD] = (bf16)(w.y >> 16);
        o[4 * mm::LD] = (bf16)(w.z & 0xffffu); o[5 * mm::LD] = (bf16)(w.z >> 16); o[6 * mm::LD] = (bf16)(w.w & 0xffffu); o[7 * mm::LD] = (bf16)(w.w >> 16); }
}
__device__ __forceinline__ void gla_local_unit(bf16* GLA, const float* SML, const float* w_lr, const float* b_gate, bf16* GST, float* GDEC, LAS unsigned char* L8, int bh, int c, int tid, int wave, int lane) {
    LAS float* BC = (LAS float*)L8; LAS float* BL = (LAS float*)(L8 + 16384); LAS bf16* KE = (LAS bf16*)(L8 + 16640); LAS bf16* VT = (LAS bf16*)(L8 + 25856); LAS float* WSM8 = (LAS float*)(L8 + 44288);
    const int b = bh >> 2, h = bh & 3; const size_t row0 = (size_t)b * S_ + (size_t)c * 64;
    const int s = tid >> 3, dg = tid & 7;
    bf16* qp = GLA + (row0 + s) * GLAP + h * 64 + dg * 8; bf16* kp = qp + 256;
    const v4u wq = *(const v4u*)qp, wk = *(const v4u*)kp;
    __syncthreads();
    gla_bcum(SML, w_lr, b_gate, BC, BL, WSM8, row0, h, wave, lane);
    gla_stage_vt(GLA, VT, row0, h, tid);
    __syncthreads();
    { const float qf[8] = {bf2f(wq.x & 0xffffu), bf2f(wq.x >> 16), bf2f(wq.y & 0xffffu), bf2f(wq.y >> 16), bf2f(wq.z & 0xffffu), bf2f(wq.z >> 16), bf2f(wq.w & 0xffffu), bf2f(wq.w >> 16)};
      const float kf[8] = {bf2f(wk.x & 0xffffu), bf2f(wk.x >> 16), bf2f(wk.y & 0xffffu), bf2f(wk.y >> 16), bf2f(wk.z & 0xffffu), bf2f(wk.z >> 16), bf2f(wk.w & 0xffffu), bf2f(wk.w >> 16)};
      float qd[8], kd[8];
#pragma unroll
      for (int i = 0; i < 8; ++i) { const int d = dg * 8 + i; const float bc = BC[s * 64 + d]; qd[i] = qf[i] * 0.125f * __expf(bc); kd[i] = kf[i] * __expf(-bc);
          KE[d * mm::LD + s] = (bf16)f2bf(kf[i] * __expf(BL[d] - bc)); }
      v4u o; o.x = pk2(qd[0], qd[1]); o.y = pk2(qd[2], qd[3]); o.z = pk2(qd[4], qd[5]); o.w = pk2(qd[6], qd[7]); *(v4u*)qp = o;
      o.x = pk2(kd[0], kd[1]); o.y = pk2(kd[2], kd[3]); o.z = pk2(kd[4], kd[5]); o.w = pk2(kd[6], kd[7]); *(v4u*)kp = o; }
    if (tid < 64) GDEC[((size_t)bh * 128 + c) * 64 + tid] = __expf(BL[tid]);
    __syncthreads();
    f32x4 acc[4];
#pragma unroll
    for (int i = 0; i < 4; ++i) acc[i] = (f32x4){0.f, 0.f, 0.f, 0.f};
#pragma unroll
    for (int kk = 0; kk < 64; kk += 32) { const mm::bf16x8 yf = mm::frag(VT, wave * 16, kk, lane);
#pragma unroll
        for (int dt = 0; dt < 4; ++dt) acc[dt] = mm::mma(mm::frag(KE, dt * 16, kk, lane), yf, acc[dt]); }
    bf16* dst = GST + ((size_t)bh * 128 + c) * GST_CH + (size_t)(wave * 16 + (lane & 15)) * 64 + 4 * (lane >> 4);
#pragma unroll
    for (int dt = 0; dt < 4; ++dt) *(v2u*)(dst + dt * 16) = pack4(acc[dt]);
}
__device__ __forceinline__ void gla_out_unit(bf16* GLA, const bf16* GST, const float* gla_norm, LAS unsigned char* L8, int bh, int c, int tid, int wave, int lane) {
    LAS bf16* QD = (LAS bf16*)(L8 + 16640); LAS bf16* KD = (LAS bf16*)(L8 + 25856); LAS bf16* VT = (LAS bf16*)(L8 + 35072); LAS bf16* AL = (LAS bf16*)(L8 + 53504); LAS float* RED = (LAS float*)(L8 + 62720);
    const int b = bh >> 2, h = bh & 3; const size_t row0 = (size_t)b * S_ + (size_t)c * 64;
    const int tt = wave & 3, vh = wave >> 2, t = tt * 16 + (lane & 15);
    const bf16* Sc = GST + ((size_t)bh * 128 + c) * GST_CH;
    mm::bf16x8 sf[2][4]; v2u grv[4];
#pragma unroll
    for (int k2 = 0; k2 < 2; ++k2)
#pragma unroll
        for (int j = 0; j < 4; ++j) sf[k2][j] = frag_gb(Sc, (vh * 4 + j) * 16, k2 * 32, lane);
#pragma unroll
    for (int j = 0; j < 4; ++j) grv[j] = *(const v2u*)(GLA + (row0 + t) * GLAP + 1024 + h * 128 + (vh * 4 + j) * 16 + 4 * (lane >> 4));
    __syncthreads();
    { const int s = tid >> 3, dg = tid & 7; const bf16* qp = GLA + (row0 + s) * GLAP + h * 64 + dg * 8;
      *(LAS v4u*)(QD + s * mm::LD + dg * 8) = *(const v4u*)qp; *(LAS v4u*)(KD + s * mm::LD + dg * 8) = *(const v4u*)(qp + 256); }
    gla_stage_vt(GLA, VT, row0, h, tid);
    __syncthreads();
#pragma unroll
    for (int ii = 0; ii < 2; ++ii) { const int id = wave + 8 * ii, at = id >> 2, st = id & 3;
        f32x4 a = (f32x4){0.f, 0.f, 0.f, 0.f};
        if (st <= at) {
#pragma unroll
            for (int kk = 0; kk < 64; kk += 32) a = mm::mma(mm::frag(KD, st * 16, kk, lane), mm::frag(QD, at * 16, kk, lane), a); }
        const int ta = at * 16 + (lane & 15), s0 = st * 16 + 4 * (lane >> 4);
        v2u w; w.x = pk2(s0 <= ta ? a[0] : 0.f, s0 + 1 <= ta ? a[1] : 0.f); w.y = pk2(s0 + 2 <= ta ? a[2] : 0.f, s0 + 3 <= ta ? a[3] : 0.f);
        *(LAS v2u*)(AL + ta * mm::LD + s0) = w; }
    __syncthreads();
    f32x4 acc[4];
#pragma unroll
    for (int i = 0; i < 4; ++i) acc[i] = (f32x4){0.f, 0.f, 0.f, 0.f};
#pragma unroll
    for (int k2 = 0; k2 < 2; ++k2) { const mm::bf16x8 yq = mm::frag(QD, tt * 16, k2 * 32, lane), ya = mm::frag(AL, tt * 16, k2 * 32, lane);
#pragma unroll
        for (int j = 0; j < 4; ++j) { acc[j] = mm::mma(sf[k2][j], yq, acc[j]); acc[j] = mm::mma(mm::frag(VT, (vh * 4 + j) * 16, k2 * 32, lane), ya, acc[j]); } }
    float ss = 0.f;
#pragma unroll
    for (int j = 0; j < 4; ++j) ss += (acc[j][0] * acc[j][0] + acc[j][1] * acc[j][1]) + (acc[j][2] * acc[j][2] + acc[j][3] * acc[j][3]);
    ss += __shfl_xor(ss, 16); ss += __shfl_xor(ss, 32);
    if (lane < 16) RED[vh * 64 + t] = ss;
    __syncthreads();
    const float rs = rsqrtf((RED[t] + RED[64 + t]) * (1.f / 128.f) + EPS);
#pragma unroll
    for (int j = 0; j < 4; ++j) { const int v = (vh * 4 + j) * 16 + 4 * (lane >> 4);
        const f32x4 gn = *(const f32x4*)(gla_norm + v); const v2u gr = grv[j];
        v2u o; o.x = pk2(acc[j][0] * rs * gn[0] * silu_f(bf2f(gr.x & 0xffffu)), acc[j][1] * rs * gn[1] * silu_f(bf2f(gr.x >> 16)));
        o.y = pk2(acc[j][2] * rs * gn[2] * silu_f(bf2f(gr.y & 0xffffu)), acc[j][3] * rs * gn[3] * silu_f(bf2f(gr.y >> 16)));
        *(v2u*)(GLA + (row0 + t) * GLAP + 1024 + h * 128 + v) = o; }
}
__device__ __forceinline__ void ssd_acs(const float* SML, const float* a_log, LAS float* ACS, LAS float* DT, LAS float* AL4, size_t row0, int g, int wave, int lane) {
    if (wave < 4) { const float dt = SML[(row0 + lane) * SMLP + 24 + 4 * g + wave]; const float a = -__expf(a_log[4 * g + wave]);
        const float v = mm::wave_incl_scan(dt * a, lane); ACS[lane * 4 + wave] = v; DT[lane * 4 + wave] = dt; if (lane == 63) AL4[wave] = v; }
}
__device__ __forceinline__ void ssd_conv8(const bf16* SSM, const float* conv_w, const float* conv_b, int b, int s, int ch0, float (&out)[8]) {
    const f32x4 b0 = *(const f32x4*)(conv_b + ch0), b1 = *(const f32x4*)(conv_b + ch0 + 4);
    float acc[8] = {b0[0], b0[1], b0[2], b0[3], b1[0], b1[1], b1[2], b1[3]};
#pragma unroll
    for (int j = 0; j < 4; ++j) { const int sp = s - 3 + j;
        if (sp >= 0) { const v4u w = *(const v4u*)(SSM + ((size_t)b * S_ + sp) * SSMP + 512 + ch0);
            const f32x4 w0 = *(const f32x4*)(conv_w + j * 768 + ch0), w1 = *(const f32x4*)(conv_w + j * 768 + ch0 + 4);
            acc[0] += w0[0] * bf2f(w.x & 0xffffu); acc[1] += w0[1] * bf2f(w.x >> 16); acc[2] += w0[2] * bf2f(w.y & 0xffffu); acc[3] += w0[3] * bf2f(w.y >> 16);
            acc[4] += w1[0] * bf2f(w.z & 0xffffu); acc[5] += w1[1] * bf2f(w.z >> 16); acc[6] += w1[2] * bf2f(w.w & 0xffffu); acc[7] += w1[3] * bf2f(w.w >> 16); } }
#pragma unroll
    for (int i = 0; i < 8; ++i) out[i] = acc[i] * __builtin_amdgcn_rcpf(1.f + __expf(-acc[i]));
}
__device__ __forceinline__ void ssd_local_unit(const bf16* SSM, const float* SML, const float* conv_w, const float* conv_b, const float* a_log, bf16* XC, bf16* SST, float* SDEC, LAS unsigned char* L8, int bg, int c, int tid, int wave, int lane) {
    LAS float* ACS = (LAS float*)L8; LAS float* DT = (LAS float*)(L8 + 1024); LAS float* AL4 = (LAS float*)(L8 + 2048); LAS bf16* XE = (LAS bf16*)(L8 + 2304); LAS bf16* BT = (LAS bf16*)(L8 + 39168);
    const int b = bg >> 1, g = bg & 1; const size_t row0 = (size_t)b * S_ + (size_t)c * 64;
    __syncthreads();
    ssd_acs(SML, a_log, ACS, DT, AL4, row0, g, wave, lane);
    __syncthreads();
#pragma unroll 2
    for (int it = tid; it < 64 * 48; it += NTHR) { const int t = it / 48, cg = it - t * 48; float v[8];
        const int ch0 = (cg < 32) ? (g * 256 + cg * 8) : ((cg < 40 ? 512 : 640) + g * 64 + (cg & 7) * 8);
        ssd_conv8(SSM, conv_w, conv_b, b, c * 64 + t, ch0, v);
        v4u o; o.x = pk2(v[0], v[1]); o.y = pk2(v[2], v[3]); o.z = pk2(v[4], v[5]); o.w = pk2(v[6], v[7]); *(v4u*)(XC + (row0 + t) * XCP + ch0) = o;
        if (cg < 32) { const int hh = cg >> 3, p0 = (cg & 7) * 8; const float sc = DT[t * 4 + hh] * __expf(AL4[hh] - ACS[t * 4 + hh]); LAS bf16* q = XE + (hh * 64 + p0) * mm::LD + t;
#pragma unroll
            for (int i = 0; i < 8; ++i) q[i * mm::LD] = (bf16)f2bf(v[i] * sc); }
        else if (cg < 40) { LAS bf16* q = BT + ((cg - 32) * 8) * mm::LD + t;
#pragma unroll
            for (int i = 0; i < 8; ++i) q[i * mm::LD] = (bf16)f2bf(v[i]); } }
    if (tid < 4) SDEC[((size_t)(b * 8 + 4 * g + tid)) * 128 + c] = __expf(AL4[tid]);
    __syncthreads();
    const int hh = wave >> 1;
    f32x4 acc[2][4];
#pragma unroll
    for (int j = 0; j < 2; ++j)
#pragma unroll
        for (int n = 0; n < 4; ++n) acc[j][n] = (f32x4){0.f, 0.f, 0.f, 0.f};
#pragma unroll
    for (int kk = 0; kk < 64; kk += 32)
#pragma unroll
        for (int j = 0; j < 2; ++j) { const mm::bf16x8 yf = mm::frag(XE + hh * 64 * mm::LD, ((wave & 1) * 2 + j) * 16, kk, lane);
#pragma unroll
            for (int n = 0; n < 4; ++n) acc[j][n] = mm::mma(mm::frag(BT, n * 16, kk, lane), yf, acc[j][n]); }
    bf16* dst = SST + ((size_t)(b * 8 + 4 * g + hh) * 128 + c) * SST_CH + 4 * (lane >> 4);
#pragma unroll
    for (int j = 0; j < 2; ++j) { const int p = ((wave & 1) * 2 + j) * 16 + (lane & 15);
#pragma unroll
        for (int n = 0; n < 4; ++n) *(v2u*)(dst + (size_t)p * 64 + n * 16) = pack4(acc[j][n]); }
}
__device__ __forceinline__ void ssd_out_unit(bf16* SSM, const float* SML, const bf16* XC, const float* a_log, const float* d_skip, const float* ssm_norm, const bf16* SST,
                                             LAS unsigned char* L8, int bg, int c, int tid, int wave, int lane) {
    LAS float* ACS = (LAS float*)L8; LAS float* DT = (LAS float*)(L8 + 1024); LAS float* AL4 = (LAS float*)(L8 + 2048); LAS bf16* XT = (LAS bf16*)(L8 + 2304);
    LAS bf16* BM = (LAS bf16*)(L8 + 39168); LAS bf16* CM = (LAS bf16*)(L8 + 48384); LAS bf16* SCL = (LAS bf16*)(L8 + 57600); LAS float* RED = (LAS float*)(L8 + 94464);
    const int b = bg >> 1, g = bg & 1; const size_t row0 = (size_t)b * S_ + (size_t)c * 64;
    const int hh = wave >> 1, head = 4 * g + hh;
    const bf16* Sc = SST + ((size_t)(b * 8 + head) * 128 + c) * SST_CH;
    mm::bf16x8 sf[2][4];
#pragma unroll
    for (int k2 = 0; k2 < 2; ++k2)
#pragma unroll
        for (int n = 0; n < 4; ++n) sf[k2][n] = frag_gb(Sc, n * 16, k2 * 32, lane);
    __syncthreads();
    ssd_acs(SML, a_log, ACS, DT, AL4, row0, g, wave, lane);
#pragma unroll
    for (int rep = 0; rep < 6; ++rep) { const int it = tid + rep * NTHR, t = it / 48, cg = it - t * 48;
        const int ch0 = (cg < 32) ? (g * 256 + cg * 8) : ((cg < 40 ? 512 : 640) + g * 64 + (cg & 7) * 8);
        const v4u w = *(const v4u*)(XC + (row0 + t) * XCP + ch0);
        if (cg < 32) { LAS bf16* o = XT + ((cg >> 3) * 64 + (cg & 7) * 8) * mm::LD + t;
            o[0] = (bf16)(w.x & 0xffffu); o[mm::LD] = (bf16)(w.x >> 16); o[2 * mm::LD] = (bf16)(w.y & 0xffffu); o[3 * mm::LD] = (bf16)(w.y >> 16);
            o[4 * mm::LD] = (bf16)(w.z & 0xffffu); o[5 * mm::LD] = (bf16)(w.z >> 16); o[6 * mm::LD] = (bf16)(w.w & 0xffffu); o[7 * mm::LD] = (bf16)(w.w >> 16); }
        else *(LAS v4u*)((cg < 40 ? BM : CM) + t * mm::LD + (cg & 7) * 8) = w; }
    __syncthreads();
#pragma unroll
    for (int ii = 0; ii < 2; ++ii) { const int id = wave + 8 * ii, tt = id >> 2, st = id & 3;
        f32x4 a = (f32x4){0.f, 0.f, 0.f, 0.f};
        if (st <= tt) {
#pragma unroll
            for (int kk = 0; kk < 64; kk += 32) a = mm::mma(mm::frag(BM, st * 16, kk, lane), mm::frag(CM, tt * 16, kk, lane), a); }
        const int t = tt * 16 + (lane & 15), s0 = st * 16 + 4 * (lane >> 4);
#pragma unroll
        for (int h2 = 0; h2 < 4; ++h2) { const float at = ACS[t * 4 + h2]; float sc[4];
#pragma unroll
            for (int r = 0; r < 4; ++r) sc[r] = (s0 + r <= t) ? a[r] * __expf(at - ACS[(s0 + r) * 4 + h2]) * DT[(s0 + r) * 4 + h2] : 0.f;
            v2u w; w.x = pk2(sc[0], sc[1]); w.y = pk2(sc[2], sc[3]); *(LAS v2u*)(SCL + (h2 * 64 + t) * mm::LD + s0) = w; } }
    v2u zv[2][4];
#pragma unroll
    for (int j = 0; j < 2; ++j)
#pragma unroll
        for (int n = 0; n < 4; ++n) zv[j][n] = *(const v2u*)(SSM + (row0 + ((wave & 1) * 2 + j) * 16 + (lane & 15)) * SSMP + head * 64 + n * 16 + 4 * (lane >> 4));
    __syncthreads();
    f32x4 acc[2][4];
#pragma unroll
    for (int j = 0; j < 2; ++j)
#pragma unroll
        for (int n = 0; n < 4; ++n) acc[j][n] = (f32x4){0.f, 0.f, 0.f, 0.f};
#pragma unroll
    for (int k2 = 0; k2 < 2; ++k2)
#pragma unroll
        for (int j = 0; j < 2; ++j) { const mm::bf16x8 yf = mm::frag(CM, ((wave & 1) * 2 + j) * 16, k2 * 32, lane);
#pragma unroll
            for (int n = 0; n < 4; ++n) acc[j][n] = mm::mma(sf[k2][n], yf, acc[j][n]); }
#pragma unroll
    for (int j = 0; j < 2; ++j) { const float e = __expf(ACS[(((wave & 1) * 2 + j) * 16 + (lane & 15)) * 4 + hh]);
#pragma unroll
        for (int n = 0; n < 4; ++n) acc[j][n] *= e; }
#pragma unroll
    for (int kk = 0; kk < 64; kk += 32)
#pragma unroll
        for (int j = 0; j < 2; ++j) { const mm::bf16x8 yf = mm::frag(SCL + hh * 64 * mm::LD, ((wave & 1) * 2 + j) * 16, kk, lane);
#pragma unroll
            for (int n = 0; n < 4; ++n) acc[j][n] = mm::mma(mm::frag(XT + hh * 64 * mm::LD, n * 16, kk, lane), yf, acc[j][n]); }
    const float Dk = d_skip[head];
#pragma unroll
    for (int j = 0; j < 2; ++j) { const int t = ((wave & 1) * 2 + j) * 16 + (lane & 15); float ss = 0.f;
#pragma unroll
        for (int n = 0; n < 4; ++n) { const int p = n * 16 + 4 * (lane >> 4); const v2u zz = zv[j][n];
            const float zf[4] = {bf2f(zz.x & 0xffffu), bf2f(zz.x >> 16), bf2f(zz.y & 0xffffu), bf2f(zz.y >> 16)};
#pragma unroll
            for (int r = 0; r < 4; ++r) { const float xs = bf2f(XT[(hh * 64 + p + r) * mm::LD + t]); const float y = (acc[j][n][r] + Dk * xs) * silu_f(zf[r]); acc[j][n][r] = y; ss += y * y; } }
        ss += __shfl_xor(ss, 16); ss += __shfl_xor(ss, 32);
        if (lane < 16) RED[hh * 64 + t] = ss; }
    __syncthreads();
#pragma unroll
    for (int j = 0; j < 2; ++j) { const int t = ((wave & 1) * 2 + j) * 16 + (lane & 15);
        const float rs = rsqrtf(((RED[t] + RED[64 + t]) + (RED[128 + t] + RED[192 + t])) * (1.f / 256.f) + EPS);
#pragma unroll
        for (int n = 0; n < 4; ++n) { const int p = n * 16 + 4 * (lane >> 4); const f32x4 gn = *(const f32x4*)(ssm_norm + g * 256 + hh * 64 + p);
            v2u o; o.x = pk2(acc[j][n][0] * rs * gn[0], acc[j][n][1] * rs * gn[1]); o.y = pk2(acc[j][n][2] * rs * gn[2], acc[j][n][3] * rs * gn[3]);
            *(v2u*)(SSM + (row0 + t) * SSMP + head * 64 + p) = o; } }
}
__device__ __forceinline__ void ph_scan(bf16* GST, const float* GDEC, bf16* SST, const float* SDEC, int tid) {
    asm volatile("" : "+v"(tid));
    for (int e = blockIdx.x * NTHR + tid; e < 65536; e += gridDim.x * NTHR) {
        const bool isg = e < 32768; const int ee = isg ? e : e - 32768;
        const int bh = isg ? (ee >> 12) : (ee >> 11), el = (isg ? (ee & 4095) : (ee & 2047)) * 2, chs = isg ? GST_CH : SST_CH;
        unsigned* base = (unsigned*)((isg ? GST : SST) + (size_t)bh * 128 * chs + el); const int step = chs / 2;
        const float* dec = isg ? GDEC + (size_t)bh * 128 * 64 + (el & 63) : SDEC + (size_t)bh * 128; const int dst = isg ? 64 : 1, d1 = isg ? 1 : 0;
        float S0 = 0.f, S1 = 0.f;
#pragma unroll 1
        for (int c0 = 0; c0 < 128; c0 += 8) { unsigned kv[8]; float da[8], db[8];
#pragma unroll
            for (int i = 0; i < 8; ++i) { kv[i] = base[(size_t)(c0 + i) * step]; da[i] = dec[(size_t)(c0 + i) * dst]; db[i] = dec[(size_t)(c0 + i) * dst + d1]; }
#pragma unroll
            for (int i = 0; i < 8; ++i) { base[(size_t)(c0 + i) * step] = pk2(S0, S1); S0 = da[i] * S0 + bf2f(kv[i] & 0xffffu); S1 = db[i] * S1 + bf2f(kv[i] >> 16); } }
    }
}
__device__ __forceinline__ void ph_local(const float* SML, bf16* GLA, const bf16* SSM, const float* w_lr, const float* b_gate, const float* conv_w, const float* conv_b, const float* a_log,
                                         bf16* GST, float* GDEC, bf16* XC, bf16* SST, float* SDEC, LAS unsigned char* L8, int tid, int wave, int lane) {
    asm volatile("" : "+v"(tid), "+s"(wave), "+v"(lane));
    for (int u = blockIdx.x; u < 1024 + 512; u += gridDim.x) {
        if (u < 1024) gla_local_unit(GLA, SML, w_lr, b_gate, GST, GDEC, L8, u >> 7, u & 127, tid, wave, lane);
        else ssd_local_unit(SSM, SML, conv_w, conv_b, a_log, XC, SST, SDEC, L8, (u - 1024) >> 7, (u - 1024) & 127, tid, wave, lane);
    }
}
__device__ __forceinline__ void ph_mixout(bf16* GLA, bf16* SSM, const float* SML, const float* gla_norm, const bf16* XC, const float* a_log, const float* d_skip,
                                          const float* ssm_norm, const bf16* GST, const bf16* SST, LAS unsigned char* L8, int tid, int wave, int lane) {
    asm volatile("" : "+v"(tid), "+s"(wave), "+v"(lane));
    for (int u = blockIdx.x; u < 1024 + 512; u += gridDim.x) {
        if (u < 1024) gla_out_unit(GLA, GST, gla_norm, L8, u >> 7, u & 127, tid, wave, lane);
        else ssd_out_unit(SSM, SML, XC, a_log, d_skip, ssm_norm, SST, L8, (u - 1024) >> 7, (u - 1024) & 127, tid, wave, lane);
    }
}

namespace attn_body {
using bf16=__hip_bfloat16;
using bf16x8=__attribute__((ext_vector_type(8)))short;
using s16x4=__attribute__((ext_vector_type(4)))short;
using f32x16=__attribute__((ext_vector_type(16)))float;
using u32x4=__attribute__((ext_vector_type(4)))unsigned;
using f32x4g=__attribute__((ext_vector_type(4)))float;
constexpr int BATCH=2,NHEAD=8,SEQ=8192,D=64,PITCH=1536;
constexpr int NW=8,QBLK=32,QB=QBLK*NW,KVBLK=64,NQB=SEQ/QB;
constexpr int ATTN_PITCH=PITCH, ATTN_UNIT_ROWS=QB;
__device__ __forceinline__ int crow(int r,int hi){return (r&3)+8*(r>>2)+4*hi;}
#define SBAR() __builtin_amdgcn_sched_barrier(0)
__device__ __forceinline__ void cmask(f32x16&p0,f32x16&p1,int jb,int qrel,int hi){
  const float NEG=-INFINITY; int kb=64*jb+4*hi;
  #pragma unroll
  for(int r=0;r<16;++r){int kv=kb+(r&3)+8*(r>>2); if(kv>qrel)p0[r]=NEG; if(kv+32>qrel)p1[r]=NEG;}
}

constexpr int NSLOT=3, SLOTB=8192;
constexpr int LDS_K=0, LDS_V=NSLOT*SLOTB, LDS_WS=2*NSLOT*SLOTB, LDS_OST=LDS_WS+NW*64*4, LDS_C=LDS_OST+NW*4096, LDS_BYTES=LDS_C+SEQ*4;
constexpr float C2=0.125f*1.4426950408889634f;
__device__ __forceinline__ void glds16(const void*gsrc,unsigned lds_dst){unsigned keep;
  asm volatile("s_mov_b32 %0, m0\n\ts_mov_b32 m0, %2\n\ts_nop 0\n\tglobal_load_lds_dwordx4 %1, off\n\ts_mov_b32 m0, %0":"=&s"(keep):"v"(gsrc),"s"(lds_dst):"memory");}
__device__ __forceinline__ float max3f(float a,float b,float c){float r;asm("v_max3_f32 %0, %1, %2, %3":"=v"(r):"v"(a),"v"(b),"v"(c));return r;}
__device__ __forceinline__ float max2f(float a,float b){float r;asm("v_max_f32_e32 %0, %1, %2":"=v"(r):"v"(a),"v"(b));return r;}
__device__ __forceinline__ float fadd_s(float a,float b){float r;asm("v_add_f32_e32 %0, %1, %2":"=v"(r):"v"(a),"v"(b));return r;}
__device__ __forceinline__ float fsub_s(float a,float b){float r;asm("v_sub_f32_e32 %0, %1, %2":"=v"(r):"v"(a),"v"(b));return r;}
typedef float f32x2_t __attribute__((ext_vector_type(2))); typedef __bf16 bf16x2_t __attribute__((ext_vector_type(2)));
__device__ __forceinline__ unsigned cvtpk_s(float lo,float hi){f32x2_t v={lo,hi};bf16x2_t b=__builtin_convertvector(v,bf16x2_t);return __builtin_bit_cast(unsigned,b);}
#define WAIT_BAR(N) asm volatile("s_waitcnt vmcnt(" #N ") lgkmcnt(0)\n\ts_barrier":::"memory")

__device__ __forceinline__ void qkt(f32x16&p0,f32x16&p1,const char*Kslot,const bf16x8*qr,int r32,int hi){
  const char*kb=Kslot+hi*1024+r32*16;
  #pragma unroll
  for(int d0=0;d0<4;++d0){
    const bf16x8 b0=*reinterpret_cast<const bf16x8*>(kb+d0*2048);
    const bf16x8 b1=*reinterpret_cast<const bf16x8*>(kb+d0*2048+512);
    {p0=__builtin_amdgcn_mfma_f32_32x32x16_bf16(b0,qr[d0],p0,0,0,0);p1=__builtin_amdgcn_mfma_f32_32x32x16_bf16(b1,qr[d0],p1,0,0,0);}}
}
typedef __attribute__((address_space(3))) const char* lds_cptr;
typedef short v4i16_t __attribute__((ext_vector_type(4)));
__device__ __forceinline__ void kload8(bf16x8*kf,lds_cptr kp){
  kf[0]=*(const __attribute__((address_space(3))) bf16x8*)(kp);      kf[1]=*(const __attribute__((address_space(3))) bf16x8*)(kp+512);
  kf[2]=*(const __attribute__((address_space(3))) bf16x8*)(kp+2048); kf[3]=*(const __attribute__((address_space(3))) bf16x8*)(kp+2560);
  kf[4]=*(const __attribute__((address_space(3))) bf16x8*)(kp+4096); kf[5]=*(const __attribute__((address_space(3))) bf16x8*)(kp+4608);
  kf[6]=*(const __attribute__((address_space(3))) bf16x8*)(kp+6144); kf[7]=*(const __attribute__((address_space(3))) bf16x8*)(kp+6656);
}
__device__ __forceinline__ void kload2(bf16x8*kf,lds_cptr kp,int j){ kf[2*j]=*(const __attribute__((address_space(3))) bf16x8*)(kp+j*2048); kf[2*j+1]=*(const __attribute__((address_space(3))) bf16x8*)(kp+j*2048+512); }
__device__ __forceinline__ s16x4 vtr(lds_cptr p){ return __builtin_bit_cast(s16x4,__builtin_amdgcn_ds_read_tr16_b64_v4i16((__attribute__((address_space(3))) v4i16_t*)p)); }
__device__ __forceinline__ float rowmax(const f32x16&p0,const f32x16&p1){
  float a=max3f(p0[0],p0[1],p1[0]),b=max3f(p0[2],p0[3],p1[1]);a=max3f(a,p1[2],p1[3]);
  #pragma unroll
  for(int r=4;r<16;r+=4){a=max3f(a,p0[r],p0[r+1]);b=max3f(b,p0[r+2],p0[r+3]);a=max3f(a,p1[r],p1[r+1]);b=max3f(b,p1[r+2],p1[r+3]);}
  const float m=max2f(a,b);
  auto rr=__builtin_amdgcn_permlane32_swap(__float_as_uint(m),__float_as_uint(m),false,false);
  return max2f(__uint_as_float(rr[0]),__uint_as_float(rr[1]));
}
__device__ __forceinline__ void pv(f32x16*o,int vb,bf16x8 pa0,bf16x8 pa1,bf16x8 pa2,bf16x8 pa3){
  #pragma unroll
  for(int d0=0;d0<2;++d0){s16x4 lo[4],hi[4];
    #pragma unroll
    for(int ks=0;ks<4;++ks){
      asm volatile("ds_read_b64_tr_b16 %0,%1 offset:%c2":"=&v"(lo[ks]):"v"(vb),"i"(d0*4096+ks*1024):"memory");
      asm volatile("ds_read_b64_tr_b16 %0,%1 offset:%c2":"=&v"(hi[ks]):"v"(vb),"i"(d0*4096+ks*1024+512):"memory");}
    asm volatile("s_waitcnt lgkmcnt(0)":::"memory");SBAR();
    #define PK(k) (bf16x8){lo[k][0],lo[k][1],lo[k][2],lo[k][3],hi[k][0],hi[k][1],hi[k][2],hi[k][3]}
    o[d0]=__builtin_amdgcn_mfma_f32_32x32x16_bf16(pa0,PK(0),o[d0],0,0,0);
    o[d0]=__builtin_amdgcn_mfma_f32_32x32x16_bf16(pa1,PK(1),o[d0],0,0,0);
    o[d0]=__builtin_amdgcn_mfma_f32_32x32x16_bf16(pa2,PK(2),o[d0],0,0,0);
    o[d0]=__builtin_amdgcn_mfma_f32_32x32x16_bf16(pa3,PK(3),o[d0],0,0,0);
    #undef PK
  }
}

#ifndef ATTN_STORE16
#define ATTN_STORE16(p,v) (*(u32x4*)(p)=(v))
#endif
template<int THRL> __device__ __forceinline__ void attn_unit(int b,int h,int qb,const bf16*Q,const bf16*__restrict__ K,const bf16*__restrict__ V,bf16*O,const float*cum,float M0,char*shm){
  int tid=threadIdx.x; asm volatile("":"+v"(tid));
  const int lane=tid&63,r32=lane&31,hi=lane>>5; const int wid=__builtin_amdgcn_readfirstlane(tid>>6);
  const long rowbase=(long)b*SEQ; const int q0=qb*QB;
  const bf16*Qw=Q+(rowbase+q0+wid*QBLK)*PITCH+h*D;
  const bf16*Kh=K+rowbase*PITCH+h*D,*Vh=V+rowbase*PITCH+h*D;
  const unsigned lds0=(unsigned)(uintptr_t)shm;
  float*wsf=(float*)(shm+LDS_WS)+wid*64;
  const bf16*ksrc=Kh+(long)lane*PITCH+wid*8;
  const bf16*vsrc=Vh+(long)(16*(wid&3)+(lane>>2))*PITCH+(wid>>2)*32+(lane&3)*8;
  const unsigned kdst=lds0+LDS_K+wid*1024, vdst=lds0+LDS_V+wid*1024;
  #define DMA_K(t,slot) glds16(ksrc+(long)(t)*KVBLK*PITCH,(unsigned)__builtin_amdgcn_readfirstlane(kdst+(slot)))
  #define DMA_V(t,slot) glds16(vsrc+(long)(t)*KVBLK*PITCH,(unsigned)__builtin_amdgcn_readfirstlane(vdst+(slot)))
  const int vb0=(int)(lds0+LDS_V)+((lane>>4)&1)*32+(lane&3)*8+(4*hi+((lane&15)>>2))*64;
  const char*Kbase=shm+LDS_K; bf16x8 kf[8];
  const lds_cptr shm3=(lds_cptr)shm; const lds_cptr kp0=shm3+LDS_K+hi*1024+r32*16; const lds_cptr vp0=shm3+LDS_V+((lane>>4)&1)*32+(lane&3)*8+(4*hi+((lane&15)>>2))*64;
  const int NT=(q0+QB)/KVBLK;
  const float*chp=cum+((long)b*NHEAD+h)*SEQ;
  { const f32x4g*src4=(const f32x4g*)chp; __attribute__((address_space(3))) f32x4g*dst4=(__attribute__((address_space(3))) f32x4g*)(shm3+LDS_C);
    for(int i=tid;i<NT*16;i+=NW*64)dst4[i]=src4[i]; }
  const float cqm=chp[q0+wid*QBLK+r32]-M0;
  asm volatile("s_waitcnt vmcnt(0) lgkmcnt(0)":::"memory");
  const lds_cptr cb0=shm3+LDS_C+hi*16;
  #define CBIAS(C0,C1,t) do{ const lds_cptr cp_=cb0+(t)*256; \
    _Pragma("unroll") for(int j_=0;j_<4;++j_){ const f32x4g c_=*(const __attribute__((address_space(3))) f32x4g*)(cp_+j_*32); \
      C0[4*j_]=cqm-c_[0];C0[4*j_+1]=cqm-c_[1];C0[4*j_+2]=cqm-c_[2];C0[4*j_+3]=cqm-c_[3]; } \
    _Pragma("unroll") for(int j_=0;j_<4;++j_){ const f32x4g c_=*(const __attribute__((address_space(3))) f32x4g*)(cp_+128+j_*32); \
      C1[4*j_]=cqm-c_[0];C1[4*j_+1]=cqm-c_[1];C1[4*j_+2]=cqm-c_[2];C1[4*j_+3]=cqm-c_[3]; } }while(0)
  DMA_K(0,0);DMA_V(0,0);DMA_K(1,SLOTB);
  bf16x8 qr[4];
  #pragma unroll
  for(int d0=0;d0<4;++d0)qr[d0]=*reinterpret_cast<const bf16x8*>(&Qw[(long)r32*PITCH+d0*16+hi*8]);
  float l_reg=0.f;f32x16 o[2];o[0]=f32x16{};o[1]=f32x16{};
  const int qrel=wid*QBLK+r32;
  #define CMASK(P0,P1,t) do{int jb_=(t)-(NT-4); if(jb_>=0)cmask(P0,P1,jb_,qrel,hi);}while(0)
  f32x16 pA0,pA1,pB0,pB1;
  int sl_prev=0,sl_cur=0,sl_next=SLOTB;
  #define ROT() do{sl_prev=sl_cur;sl_cur=sl_next;sl_next=(sl_next==(NSLOT-1)*SLOTB)?0:sl_next+SLOTB;}while(0)
  DMA_K(2,2*SLOTB);
  WAIT_BAR(3);
  CBIAS(pA0,pA1,0);
  qkt(pA0,pA1,Kbase,qr,r32,hi);CMASK(pA0,pA1,0);
  _Pragma("unroll") for(int r=0;r<16;++r){pA0[r]=__builtin_amdgcn_exp2f(pA0[r]);pA1[r]=__builtin_amdgcn_exp2f(pA1[r]);}
  WAIT_BAR(0);
  DMA_K(3,0);DMA_V(1,SLOTB);
  ROT();
  kload8(kf,kp0+sl_cur);
  WAIT_BAR(2);
  s16x4 vlo[8],vhi[8]; u32x4 pw0,pw1,pw2,pw3;
  #define PKW(P,B) cvtpk_s(P[B],P[B+1])
  #define PAF(k) __builtin_bit_cast(bf16x8,pw##k)
  #define VFR(i) (bf16x8){vlo[i][0],vlo[i][1],vlo[i][2],vlo[i][3],vhi[i][0],vhi[i][1],vhi[i][2],vhi[i][3]}
  #define PIN(x) asm volatile("":"+v"(x))
  #define MX3(a,b,c) __builtin_fmaxf(__builtin_fmaxf((a),(b)),(c))
  #define GAPA(MF,A0,A1,A2,A3,W0,W1,PW) do{ MF; sacc+=A0; sacc+=A1; sacc+=A2; sacc+=A3; PIN(sacc); W0; W1; PIN(PW); SBAR(); }while(0)
  #define EX(v) __builtin_amdgcn_exp2f(v)
  #define GAPB(MF,X,B) do{ MF; X[B]=EX(X[B]); X[B+1]=EX(X[B+1]); X[B+2]=EX(X[B+2]); X[B+3]=EX(X[B+3]); PIN(X); SBAR(); }while(0)
  #define VRD(i) do{ vlo[i]=vtr(vp_+(((i)>>2)*4096+((i)&3)*1024)); vhi[i]=vtr(vp_+(((i)>>2)*4096+((i)&3)*1024+512)); }while(0)
  #define KRD(G,j) do{ if(G){ kload2(kf,kp0+sl_next,j); SBAR(); } }while(0)
  #define STEP(C0,C1,P0,P1,t,GK,GV,GL) do{ SBAR(); \
    CBIAS(C0,C1,t); SBAR(); \
    const lds_cptr vp_=vp0+sl_prev; \
    VRD(0); SBAR(); float sacc=(P0[0]+P0[1]); \
    GAPA(C0=__builtin_amdgcn_mfma_f32_32x32x16_bf16(kf[0],qr[0],C0,0,0,0), P0[2],P0[3],P0[4],P0[5],     pw0[0]=PKW(P0,0), pw0[1]=PKW(P0,2), pw0); \
    VRD(4); SBAR(); GAPA(C1=__builtin_amdgcn_mfma_f32_32x32x16_bf16(kf[1],qr[0],C1,0,0,0), P0[6],P0[7],P0[8],P0[9],     pw0[2]=PKW(P0,4), pw0[3]=PKW(P0,6), pw0); \
    VRD(1); SBAR(); GAPA(C0=__builtin_amdgcn_mfma_f32_32x32x16_bf16(kf[2],qr[1],C0,0,0,0),   P0[10],P0[11],P0[12],P0[13], pw1[0]=PKW(P0,8), pw1[1]=PKW(P0,10), pw1); \
    VRD(5); SBAR(); GAPA(C1=__builtin_amdgcn_mfma_f32_32x32x16_bf16(kf[3],qr[1],C1,0,0,0),   P0[14],P0[15],P1[0],P1[1],   pw1[2]=PKW(P0,12),pw1[3]=PKW(P0,14), pw1); \
    VRD(2); SBAR(); GAPA(C0=__builtin_amdgcn_mfma_f32_32x32x16_bf16(kf[4],qr[2],C0,0,0,0),   P1[2],P1[3],P1[4],P1[5],     pw2[0]=PKW(P1,0), pw2[1]=PKW(P1,2), pw2); \
    VRD(6); SBAR(); GAPA(C1=__builtin_amdgcn_mfma_f32_32x32x16_bf16(kf[5],qr[2],C1,0,0,0),   P1[6],P1[7],P1[8],P1[9],     pw2[2]=PKW(P1,4), pw2[3]=PKW(P1,6), pw2); \
    VRD(3); SBAR(); GAPA(C0=__builtin_amdgcn_mfma_f32_32x32x16_bf16(kf[6],qr[3],C0,0,0,0),   P1[10],P1[11],P1[12],P1[13], pw3[0]=PKW(P1,8), pw3[1]=PKW(P1,10), pw3); \
    VRD(7); SBAR(); GAPA(C1=__builtin_amdgcn_mfma_f32_32x32x16_bf16(kf[7],qr[3],C1,0,0,0),   P1[14],P1[15],0.f,0.f,       pw3[2]=PKW(P1,12),pw3[3]=PKW(P1,14), pw3); \
    l_reg+=sacc; \
    if(GK){DMA_K((t)+3,sl_cur);} if(GV){DMA_V((t)+1,sl_next);} \
    CMASK(C0,C1,t); \
    SBAR(); \
    GAPB(o[0]=__builtin_amdgcn_mfma_f32_32x32x16_bf16(PAF(0),VFR(0),o[0],0,0,0), C0,0); \
    GAPB(o[1]=__builtin_amdgcn_mfma_f32_32x32x16_bf16(PAF(0),VFR(4),o[1],0,0,0), C0,4); \
    KRD(GL,0); GAPB(o[0]=__builtin_amdgcn_mfma_f32_32x32x16_bf16(PAF(1),VFR(1),o[0],0,0,0), C0,8); \
    KRD(GL,1); GAPB(o[1]=__builtin_amdgcn_mfma_f32_32x32x16_bf16(PAF(1),VFR(5),o[1],0,0,0), C0,12); \
    KRD(GL,2); GAPB(o[0]=__builtin_amdgcn_mfma_f32_32x32x16_bf16(PAF(2),VFR(2),o[0],0,0,0), C1,0); \
    KRD(GL,3); GAPB(o[1]=__builtin_amdgcn_mfma_f32_32x32x16_bf16(PAF(2),VFR(6),o[1],0,0,0), C1,4); \
    GAPB(o[0]=__builtin_amdgcn_mfma_f32_32x32x16_bf16(PAF(3),VFR(3),o[0],0,0,0), C1,8); \
    GAPB(o[1]=__builtin_amdgcn_mfma_f32_32x32x16_bf16(PAF(3),VFR(7),o[1],0,0,0), C1,12); \
    }while(0)
  int t=1;
  #undef CMASK
  #define CMASK(P0,P1,t) do{}while(0)
  for(;t+5<NT;t+=2){
    STEP(pB0,pB1,pA0,pA1,t,true,true,true);     WAIT_BAR(2); ROT();
    STEP(pA0,pA1,pB0,pB1,t+1,true,true,true);   WAIT_BAR(2); ROT();
  }
  #undef CMASK
  #define CMASK(P0,P1,t) do{int jb_=(t)-(NT-4); if(jb_>=0)cmask(P0,P1,jb_,qrel,hi);}while(0)
  #define ENDW(tt) do{ if((tt)+3<NT){WAIT_BAR(2);} else if((tt)+2<NT){WAIT_BAR(1);} else {WAIT_BAR(0);} }while(0)
  for(;t+1<NT;t+=2){
    STEP(pB0,pB1,pA0,pA1,t,(t+3<NT),(t+1<NT),(t+1<NT));       ENDW(t);   ROT();
    STEP(pA0,pA1,pB0,pB1,t+1,(t+4<NT),(t+2<NT),(t+2<NT));     ENDW(t+1); ROT();
  }
  STEP(pB0,pB1,pA0,pA1,NT-1,false,false,false);
  { float sacc=pB0[0]+pB0[1]; _Pragma("unroll") for(int r=2;r<16;++r)sacc+=pB0[r]; _Pragma("unroll") for(int r=0;r<16;++r)sacc+=pB1[r]; l_reg+=sacc;
    pw0=(u32x4){PKW(pB0,0),PKW(pB0,2),PKW(pB0,4),PKW(pB0,6)};pw1=(u32x4){PKW(pB0,8),PKW(pB0,10),PKW(pB0,12),PKW(pB0,14)};pw2=(u32x4){PKW(pB1,0),PKW(pB1,2),PKW(pB1,4),PKW(pB1,6)};pw3=(u32x4){PKW(pB1,8),PKW(pB1,10),PKW(pB1,12),PKW(pB1,14)};
    SBAR(); pv(o,vb0+sl_cur,PAF(0),PAF(1),PAF(2),PAF(3)); }
  #undef PKW
  #undef PAF
  #undef VFR
  #undef PIN
  #undef MX3
  #undef GAPA
  #undef GAPB
  #undef EX
  #undef VRD
  #undef KRD
  #undef STEP
  #undef ENDW
  {auto rr=__builtin_amdgcn_permlane32_swap(__float_as_uint(l_reg),__float_as_uint(l_reg),false,false);l_reg=__uint_as_float(rr[0])+__uint_as_float(rr[1]);}
  if(hi==0)wsf[32+r32]=l_reg;asm volatile("s_waitcnt lgkmcnt(0)":::"memory");
  float rli[16];
  #pragma unroll
  for(int r=0;r<16;++r)rli[r]=__builtin_amdgcn_rcpf(wsf[32+crow(r,hi)]);
  bf16*Ow=O+(rowbase+q0+wid*QBLK)*PITCH+h*D;
  { bf16*stg=(bf16*)(shm+LDS_OST)+wid*2048;
    #pragma unroll
    for(int r=0;r<16;++r){const int orow=crow(r,hi);
      #pragma unroll
      for(int d0=0;d0<2;++d0)stg[orow*64+d0*32+r32]=__float2bfloat16(o[d0][r]*rli[r]);}
    asm volatile("s_waitcnt lgkmcnt(0)":::"memory");
    #pragma unroll
    for(int i=0;i<4;++i){const int row=i*8+(lane>>3),ch=lane&7; const u32x4 v=*(const u32x4*)(stg+row*64+ch*8); ATTN_STORE16(Ow+(long)row*PITCH+ch*8,v);} }
  asm volatile("s_waitcnt lgkmcnt(0)\n\ts_barrier":::"memory");
  #undef DMA_K
  #undef DMA_V
  #undef CMASK
  #undef CBIAS
  #undef ROT
}
constexpr int ATTN_LDS_BYTES=LDS_BYTES;
struct AttnTensors { const bf16* Q; const bf16* K; const bf16* V; bf16* O; const float* cum; float M0; };
struct AttnUnit { int bh; int qb; };
struct PairOrder {
  int vcu,G;
  __device__ __forceinline__ bool next(int i,AttnUnit&u)const{ const int p=vcu+(i>>1)*G; if(p>=256)return false; const int s=p&15; u.bh=p>>4; u.qb=(i&1)?s:31-s; return true; }
};
template<class Sched> __device__ __forceinline__ void attn_phase(char*lds,const AttnTensors&T,const Sched&S){
  AttnUnit u;
  for(int i=0;S.next(i,u);++i){ attn_unit<0>(u.bh/NHEAD,u.bh%NHEAD,u.qb,T.Q,T.K,T.V,T.O,T.cum,T.M0,lds); }
}
#undef SBAR
#undef WAIT_BAR
}
constexpr int NPH = FAST_MOE ? 11 : 9;
struct Args { const float* in[26]; float* out; unsigned char* ws; int ph_lo, ph_hi; };
__global__ void __launch_bounds__(NTHR, 2) mega(Args a) {
    extern __shared__ __attribute__((aligned(16))) unsigned char lds[];
    const int tid = threadIdx.x, lane = tid & 63, wave = __builtin_amdgcn_readfirstlane(tid >> 6);
    LAS unsigned char* L8 = (LAS unsigned char*)lds;
    LAS float* L = (LAS float*)lds;
    volatile LAS unsigned* MISC = (volatile LAS unsigned*)(L8 + MISC_OFF);
    for (int u = tid; u < (LDS_BYTES - LDSCTL_OFF) / 4; u += NTHR) ((LAS unsigned*)(L8 + LDSCTL_OFF))[u] = 0u;
    __syncthreads();
    unsigned char* ws = a.ws;
    unsigned* ctl = (unsigned*)(ws + WS_CTL);
    XcdBarrier bar; bar.bar = ctl + CW_BAR; bar.x = 0; bar.st = nullptr;
    if (!MK_SPLIT) bar = xcd_barrier_post(ctl + CW_BAR, MISC + 8);
#define WIN   ((bf16*)(opq(ws) + WS_WIN))
#define WBR   ((bf16*)(opq(ws) + WS_WBR))
#define WOUT  ((bf16*)(opq(ws) + WS_WOUT))
#define HB    ((bf16*)(opq(ws) + WS_HB))
#define FOX   ((bf16*)(opq(ws) + WS_FOX))
#define GLA   ((bf16*)(opq(ws) + WS_GLA))
#define SSM   ((bf16*)(opq(ws) + WS_SSM))
#define SML   ((float*)(opq(ws) + WS_SML))
#define CUM   ((float*)(opq(ws) + WS_CUM))
#define TOKE  ((int*)(opq(ws) + WS_TOKE))
#define TOKW  ((float*)(opq(ws) + WS_TOKW))
#define GATES ((bf16*)(opq(ws) + WS_GATES))
#define LRANK ((int*)(opq(ws) + WS_LRANK))
#define ROWTOK ((int*)(opq(ws) + WS_ROWTOK))
#define ROWW  ((float*)(opq(ws) + WS_ROWW))
#define CNTBLK ((int*)(opq(ws) + WS_CNTBLK))
#define W1E   ((bf16*)(opq(ws) + WS_W1E))
#define WDE   ((bf16*)(opq(ws) + WS_WDE))
#define HID   ((bf16*)(opq(ws) + WS_HID))
#define HS    ((bf16*)(opq(ws) + WS_HS))
#define YB    ((bf16*)(opq(ws) + WS_YB))
#define ROWOF ((int*)(opq(ws) + WS_ROWOF))
#define GST   ((bf16*)(opq(ws) + WS_GST))
#define SST   ((bf16*)(opq(ws) + WS_SSTB))
#define XC    ((bf16*)(opq(ws) + WS_XC))
#define GDEC  ((float*)(opq(ws) + WS_GDEC))
#define SDEC  ((float*)(opq(ws) + WS_SDEC))
    const int lo = a.ph_lo, hi = a.ph_hi;
#define IN(k) (lo <= (k) && (k) < hi)
#define PH_BEGIN(k) if (IN(pb + (k))) for (int rep_ = 0; rep_ < ((k) == REPEAT_PHASE ? 2 : 1); ++rep_) { if (rep_) xcd_barrier(bar);
#if PROF_PHASE >= 0
    unsigned long long tacc = 0ull, tprev = __builtin_amdgcn_s_memrealtime();
#define SEAM(k) do { if (IN(k) && IN((k) + 1)) xcd_barrier(bar); { const unsigned long long tn_ = __builtin_amdgcn_s_memrealtime(); if (((k) % NPH) == PROF_PHASE || PROF_PHASE == 99) tacc += tn_ - tprev; tprev = tn_; } } while (0)
#else
#define SEAM(k) do { if (IN(k) && IN((k) + 1)) xcd_barrier(bar); } while (0)
#endif
    for (int l = 0; l < NLAYER; ++l) {
        const int pb = l * NPH;
        const float* xin = (l == 0) ? ((const float*)(const GAS float*)a.in[0]) : ((float*)(GAS float*)a.out);
        PH_BEGIN(0) if (l == 0) ph_norm(xin, ((const float*)(const GAS float*)a.in[1]) + l * D_, HB, wave, lane);
            else ph_norm_combine(((float*)(GAS float*)a.out), YB, ROWOF, ((const float*)(const GAS float*)a.in[1]) + l * D_, HB, wave, lane);
            convert_small_weights(((const float*)(const GAS float*)a.in[2]) + (size_t)l * D_ * INC, ((const float*)(const GAS float*)a.in[15]) + (size_t)l * 3 * 512 * 1024, ((const float*)(const GAS float*)a.in[17]) + (size_t)l * D_ * D_, WIN, WBR, WOUT, L + wave * 2304, wave, lane); }
        SEAM(pb + 0);
        PH_BEGIN(1)
#if FAST_INPROJ
#if DUAL_INPROJ
            ph_inproj_simple(HB, ((const float*)(const GAS float*)a.in[2]) + (size_t)l * D_ * INC, ((const float*)(const GAS float*)a.in[3]) + l * 8, ((const float*)(const GAS float*)a.in[4]) + l * 64, ((const float*)(const GAS float*)a.in[5]) + l * 64, ((const float*)(const GAS float*)a.in[11]) + l * 8, ((const float*)(const GAS float*)a.in[16]) + l * 3072, FOX, GLA, SSM, SML, GATES, tid);
            xcd_barrier(bar);
#endif
            pg8::GridOrder S; S.init(T_, 7680, (int)gridDim.x, (int)blockIdx.x, HB, 1024, WIN, 1024);
            pg8::EpiInproj E{FOX, GLA, SSM, SML, GATES, ((const float*)(const GAS float*)a.in[4]) + l * 64, ((const float*)(const GAS float*)a.in[5]) + l * 64, ((const float*)(const GAS float*)a.in[3]) + l * 8, ((const float*)(const GAS float*)a.in[11]) + l * 8, ((const float*)(const GAS float*)a.in[16]) + l * 3072};
            pg8::gemm_phase(L8, 1024, 1024, S, E);
#else
            ph_inproj_simple(HB, ((const float*)(const GAS float*)a.in[2]) + (size_t)l * D_ * INC, ((const float*)(const GAS float*)a.in[3]) + l * 8, ((const float*)(const GAS float*)a.in[4]) + l * 64, ((const float*)(const GAS float*)a.in[5]) + l * 64, ((const float*)(const GAS float*)a.in[11]) + l * 8, ((const float*)(const GAS float*)a.in[16]) + l * 3072, FOX, GLA, SSM, SML, GATES, tid);
#endif
        }
        SEAM(pb + 1);
        PH_BEGIN(2) ph_cumsum(SML, CUM, L, tid);
#if FAST_MIX
            ph_local(SML, GLA, SSM, ((const float*)(const GAS float*)a.in[6]) + l * 16 * 256, ((const float*)(const GAS float*)a.in[7]) + l * 256, ((const float*)(const GAS float*)a.in[9]) + l * 4 * 768, ((const float*)(const GAS float*)a.in[10]) + l * 768, ((const float*)(const GAS float*)a.in[12]) + l * 8, GST, GDEC, XC, SST, SDEC, L8, tid, wave, lane);
#endif
        }
        SEAM(pb + 2);
        PH_BEGIN(3)
#if FAST_MIX
            ph_scan(GST, GDEC, SST, SDEC, tid);
#else
            ph_mix_simple(FOX, CUM, GLA, SSM, SML, ((const float*)(const GAS float*)a.in[6]) + l * 16 * 256, ((const float*)(const GAS float*)a.in[7]) + l * 256, ((const float*)(const GAS float*)a.in[9]) + l * 4 * 768, ((const float*)(const GAS float*)a.in[10]) + l * 768, ((const float*)(const GAS float*)a.in[12]) + l * 8, ((const float*)(const GAS float*)a.in[13]) + l * 8, L, tid, wave, lane);
#endif
#if FAST_ATTN
            { const float gq = ((const float*)(const GAS float*)a.in[4])[l * 64 + lane], gk = ((const float*)(const GAS float*)a.in[5])[l * 64 + lane];
              float gm = fabsf(gq * gk);
#pragma unroll
              for (int o = 1; o < 64; o <<= 1) gm = fmaxf(gm, __shfl_xor(gm, o));
              const float M0 = 8.f * LOG2E * 1.01f * gm;
              const attn_body::AttnTensors AT{(const attn_body::bf16*)FOX, (const attn_body::bf16*)(FOX + 512), (const attn_body::bf16*)(FOX + 1024), (attn_body::bf16*)FOX, CUM, M0};
              const int G = (int)gridDim.x, bx = (int)blockIdx.x;
              const attn_body::PairOrder S{(G % 8 == 0) ? (bx % 8) * (G / 8) + bx / 8 : bx, G};
              attn_body::attn_phase((char*)lds, AT, S); }
#endif
        }
        SEAM(pb + 3);
        PH_BEGIN(4)
#if FAST_MIX
            ph_mixout(GLA, SSM, SML, ((const float*)(const GAS float*)a.in[8]) + l * 128, XC, ((const float*)(const GAS float*)a.in[12]) + l * 8, ((const float*)(const GAS float*)a.in[13]) + l * 8, ((const float*)(const GAS float*)a.in[14]) + l * 512, GST, SST, L8, tid, wave, lane);
#else
            ph_post(GLA, SSM, ((const float*)(const GAS float*)a.in[8]) + l * 128, ((const float*)(const GAS float*)a.in[14]) + l * 512, wave, lane);
#endif
        }
        SEAM(pb + 4);
        PH_BEGIN(5)
#if FAST_MERGE
            pg8::MergeOrder S{(int)gridDim.x, (int)blockIdx.x, (const char*)opq(ws), (const char*)WBR};
            pg8::EpiMerge E{GATES, FOX + 512};
            pg8::gemm_phase(L8, 512, 1536, S, E);
#else
            ph_merge_simple(FOX, GLA, SSM, GATES, ((const float*)(const GAS float*)a.in[15]) + (size_t)l * 3 * 512 * 1024, tid);
#endif
        }
        SEAM(pb + 5);
        PH_BEGIN(6)
#if FAST_OUT
            pg8::GridOrder S; S.init(T_, 1024, (int)gridDim.x, (int)blockIdx.x, FOX + 512, 1536, WOUT, 1024);
            pg8::EpiResidual E{xin, ((float*)(GAS float*)a.out)};
            pg8::gemm_phase(L8, 1024, 1536, S, E);
#else
            ph_out_simple(FOX, ((const float*)(const GAS float*)a.in[17]) + (size_t)l * D_ * D_, xin, ((float*)(GAS float*)a.out), tid);
#endif
        }
        SEAM(pb + 6);
#if FAST_MOE
        PH_BEGIN(7)
            ph_norm2_route_blk(((float*)(GAS float*)a.out), ((const float*)(const GAS float*)a.in[18]) + l * D_, HB, ((const float*)(const GAS float*)a.in[19]) + l * D_ * 4, ((const float*)(const GAS float*)a.in[20]) + l * 4,
                               ((const float*)(const GAS float*)a.in[21]) + l * D_ * 16, ((const float*)(const GAS float*)a.in[22]) + l * 16, TOKE, TOKW, LRANK, CNTBLK, (LAS int*)(L8 + 73728), tid, wave, lane);
            convert_expert_weights(((const float*)(const GAS float*)a.in[23]) + (size_t)l * 16 * 1024 * 512, ((const float*)(const GAS float*)a.in[24]) + (size_t)l * 16 * 1024 * 512,
                                   ((const float*)(const GAS float*)a.in[25]) + (size_t)l * 16 * 512 * 1024, W1E, WDE, L + wave * 2304, wave, lane);
        }
        SEAM(pb + 7);
        PH_BEGIN(8) ph_moe_scatter(HB, HS, TOKE, TOKW, LRANK, CNTBLK, ROWTOK, ROWW, ROWOF, (LAS int*)L8, (LAS int*)(L8 + 40960), (LAS int*)(L8 + LDS_TB), (LAS int*)(L8 + LDS_TOT), tid, wave, lane); }
        SEAM(pb + 8);
        PH_BEGIN(9)
            pg8::MoeOrder S{(int)gridDim.x, (int)blockIdx.x, (const char*)HS, (size_t)256 * 1024 * 2, (const char*)W1E, (size_t)1024 * 1024 * 2, (size_t)256 * 1024 * 2, (const LAS int*)(L8 + LDS_TB)};
            pg8::EpiMoe1 E{HID};
            pg8::gemm_phase(L8, 1024, 1024, S, E);
        }
        SEAM(pb + 9);
        PH_BEGIN(10)
            pg8::MoeOrder S{(int)gridDim.x, (int)blockIdx.x, (const char*)HID, (size_t)256 * 512 * 2, (const char*)WDE, (size_t)1024 * 512 * 2, (size_t)256 * 512 * 2, (const LAS int*)(L8 + LDS_TB)};
            pg8::EpiMoe2 E{ROWW, YB};
            pg8::gemm_phase(L8, 512, 512, S, E);
        }
        SEAM(pb + 10);
#else
        if (IN(pb + 7)) ph_norm2_route(((float*)(GAS float*)a.out), ((const float*)(const GAS float*)a.in[18]) + l * D_, HB, ((const float*)(const GAS float*)a.in[19]) + l * D_ * 4, ((const float*)(const GAS float*)a.in[20]) + l * 4, ((const float*)(const GAS float*)a.in[21]) + l * D_ * 16, ((const float*)(const GAS float*)a.in[22]) + l * 16, TOKE, TOKW, wave, lane);
        SEAM(pb + 7);
        if (IN(pb + 8)) ph_moe_simple(HB, TOKE, TOKW, ((const float*)(const GAS float*)a.in[23]) + (size_t)l * 16 * 1024 * 512, ((const float*)(const GAS float*)a.in[24]) + (size_t)l * 16 * 1024 * 512, ((const float*)(const GAS float*)a.in[25]) + (size_t)l * 16 * 512 * 1024, ((float*)(GAS float*)a.out), L, tid);
        SEAM(pb + 8);
#endif
    }
    if (IN(NLAYER * NPH)) ph_norm_combine(((float*)(GAS float*)a.out), YB, ROWOF, nullptr, nullptr, wave, lane);
#if PROF_PHASE >= 0
    if (blockIdx.x == 0 && tid == 0) ((float*)(GAS float*)a.out)[0] = (float)tacc * 1.0e4f;
#endif
#undef IN
#undef SEAM
}

extern "C" void kernel_launch(void* const* d_in, const int* in_sizes, int n_in, void* d_out, int out_size, void* d_ws, size_t ws_size, hipStream_t stream) {
    static int grid = 0;
    if (grid == 0) {
        if (n_in != 26 || out_size != T_ * D_ || ws_size < WS_END) { fprintf(stderr, "kernel_launch: unexpected sizes\n"); grid = -1; return; }
        int dev = 0, cus = 0;
        if (hipGetDevice(&dev) != hipSuccess || hipDeviceGetAttribute(&cus, hipDeviceAttributeMultiprocessorCount, dev) != hipSuccess) { grid = -1; return; }
        if (hipFuncSetAttribute((const void*)mega, hipFuncAttributeMaxDynamicSharedMemorySize, LDS_BYTES) != hipSuccess) { grid = -1; return; }
        int per_cu = 0;
        (void)hipOccupancyMaxActiveBlocksPerMultiprocessor(&per_cu, (const void*)mega, NTHR, LDS_BYTES);
        (void)hipGetLastError();
        grid = cus;
    }
    if (grid < 0) return;
    if (hipMemsetAsync((char*)d_ws + WS_CTL, 0, CTL_ZERO_BYTES, stream) != hipSuccess) return;
    Args a{};
    for (int i = 0; i < 26; ++i) a.in[i] = (const float*)d_in[i];
    a.out = (float*)d_out; a.ws = (unsigned char*)d_ws;
#if MK_SPLIT
    for (int p = 0; p < NLAYER * NPH + 1; ++p) { a.ph_lo = p; a.ph_hi = p + 1; hipLaunchKernelGGL(mega, dim3(grid), dim3(NTHR), LDS_BYTES, stream, a); }
#else
    a.ph_lo = 0; a.ph_hi = NLAYER * NPH + 1;
    hipLaunchKernelGGL(mega, dim3(grid), dim3(NTHR), LDS_BYTES, stream, a);
#endif
}
```

```cpp
#include <hip/hip_runtime.h>
#include <hip/hip_bf16.h>
#include <cstdio>
#include <cstdint>

#ifndef FAST_INPROJ
#define FAST_INPROJ 1
#endif
#ifndef DUAL_INPROJ
#define DUAL_INPROJ 0
#endif
#ifndef EPI_SKIP
#define EPI_SKIP(pn) (false)
#endif
#ifndef FAST_MERGE
#define FAST_MERGE 1
#endif
#ifndef FAST_OUT
#define FAST_OUT 1
#endif
#ifndef FAST_MOE
#define FAST_MOE 1
#endif
#ifndef FAST_ATTN
#define FAST_ATTN 1
#endif
#ifndef FAST_MIX
#define FAST_MIX 1
#endif
#ifndef PROF_PHASE
#define PROF_PHASE -1
#endif
#ifndef REPEAT_PHASE
#define REPEAT_PHASE -1
#endif
#ifndef MK_SPLIT
#define MK_SPLIT 0
#endif

#define GAS __attribute__((address_space(1)))
#define LAS __attribute__((address_space(3)))
typedef unsigned short bf16;
typedef unsigned v4u __attribute__((ext_vector_type(4)));
typedef unsigned v2u __attribute__((ext_vector_type(2)));
typedef float f32x4 __attribute__((ext_vector_type(4)));

constexpr int T_ = 16384, S_ = 8192, D_ = 1024, NLAYER = 2, INC = 7456, NWAVES = 8, NTHR = 512;
constexpr float LOG2E = 1.4426950408889634f, EPS = 1e-6f;
constexpr int FOXP = 1536, GLAP = 1536, SSMP = 1536, SMLP = 32, GATP = 3072;
constexpr size_t MiB = 1u << 20;
constexpr size_t WS_CTL = 0, CTL_ZERO_BYTES = 1 * MiB;
constexpr size_t WS_WIN = 1 * MiB, WS_WBR = 16 * MiB, WS_WOUT = 19 * MiB;
constexpr size_t WS_HB = 21 * MiB, WS_SST = 53 * MiB, WS_FOX = 85 * MiB, WS_GLA = 133 * MiB, WS_SSM = 181 * MiB;
constexpr size_t WS_SML = 229 * MiB, WS_CUM = 231 * MiB, WS_TOKE = WS_CUM + 512 * 1024, WS_TOKW = WS_CUM + 640 * 1024, WS_LRANK = WS_CUM + 768 * 1024, WS_ROWTOK = WS_CUM + 896 * 1024,
                 WS_ROWW = WS_CUM + 1056 * 1024, WS_CNTBLK = WS_CUM + 1216 * 1024, WS_GATES = 233 * MiB, WS_END = 329 * MiB;
constexpr size_t WS_W1E = WS_GATES, WS_WDE = WS_GATES + 32 * MiB, WS_HID = WS_GATES + 48 * MiB, WS_HS = WS_FOX;
constexpr size_t WS_GST = WS_HB, WS_SSTB = WS_HB + 16 * MiB, WS_XC = WS_SST, WS_GDEC = WS_CUM + 1280 * 1024, WS_SDEC = WS_CUM + 1536 * 1024;
constexpr size_t WS_ROWOF = WS_CUM + 1600 * 1024, WS_YB = WS_HS;
constexpr int MOE_ROWS = 36864;
static_assert(WS_HID + (size_t)MOE_ROWS * 512 * 2 <= WS_END && WS_HS + (size_t)MOE_ROWS * 1024 * 2 <= WS_SSM + 48 * MiB, "MoE overlays");
constexpr int CW_BAR = 4096;
constexpr int RING_BYTES = 131072, LDSCTL_OFF = RING_BYTES, MISC_OFF = LDSCTL_OFF + 320, LDS_TB = LDSCTL_OFF + 512  , LDS_TOT = LDSCTL_OFF + 640  , LDS_BIAS = LDSCTL_OFF + 1024  , LDS_BYTES = 147456;

__device__ __forceinline__ GAS unsigned char* opq(unsigned char* p) { GAS unsigned char* g = (GAS unsigned char*)p; asm volatile("" : "+s"(g)); return g; }
__device__ __forceinline__ int lane_id() { int l; asm volatile("v_mbcnt_lo_u32_b32 %0, -1, 0\n\tv_mbcnt_hi_u32_b32 %0, -1, %0" : "=v"(l)); return l; }
__device__ __forceinline__ float bf2f(unsigned u) { return __builtin_bit_cast(float, u << 16); }
__device__ __forceinline__ unsigned f2bf(float f) { unsigned u = __builtin_bit_cast(unsigned, f); return (u + 0x7fffu + ((u >> 16) & 1u)) >> 16; }
__device__ __forceinline__ unsigned pk2(float lo, float hi) { return f2bf(lo) | (f2bf(hi) << 16); }
__device__ __forceinline__ float silu_f(float x) { return x * __builtin_amdgcn_rcpf(1.f + __expf(-x)); }
__device__ __forceinline__ float sigmoid_f(float x) { return __builtin_amdgcn_rcpf(1.f + __expf(-x)); }
__device__ __forceinline__ float softplus_f(float x) { return fmaxf(x, 0.f) + log1pf(__expf(-fabsf(x))); }
__device__ __forceinline__ float logsig_f(float x) { return fminf(x, 0.f) - log1pf(__expf(-fabsf(x))); }
__device__ __forceinline__ float wave_sum(float v) {
#pragma unroll
    for (int o = 1; o < 64; o <<= 1) v += __shfl_xor(v, o);
    return v;
}

#define XB_TMO      128
#define XB_XCNT(j)  (256  + 64 * (j))
#define XB_XSUB(j)  (1280 + 64 * (j))
#define XB_XGEN(j)  (2304 + 64 * (j))
#define XB_TOP      3328
#define XB_TOPGEN   3392
#define XCD_BAR_WORDS 3456
#define XB_SPIN_CAP (1u << 23)
__device__ __forceinline__ unsigned xb_ld(unsigned* p)              { return __hip_atomic_load(p, __ATOMIC_RELAXED, __HIP_MEMORY_SCOPE_AGENT); }
__device__ __forceinline__ unsigned xb_add(unsigned* p, unsigned v) { return __hip_atomic_fetch_add(p, v, __ATOMIC_RELAXED, __HIP_MEMORY_SCOPE_AGENT); }
__device__ __forceinline__ unsigned xb_xcc_id() { return (unsigned)__builtin_amdgcn_s_getreg((3 << 11) | 20) & 0xFu; }
#define XB_SPIN(cond, bar) do { unsigned _sp = 0; while (cond) { __builtin_amdgcn_s_sleep(1); \
    if ((++_sp & 255u) == 0u) { if (xb_ld(&(bar)[XB_TMO])) break; if (_sp > XB_SPIN_CAP) { atomicAdd(&(bar)[XB_TMO], 1u); break; } } } } while (0)
struct XcdBarrier { unsigned* bar; unsigned x; volatile LAS unsigned* st; };
__device__ __forceinline__ XcdBarrier xcd_barrier_post(unsigned* bar, volatile LAS unsigned* st, bool t0) {
    XcdBarrier b; b.bar = bar; b.x = xb_xcc_id(); b.st = st;
    if (t0) (void)xb_add(&bar[XB_XCNT(b.x)], 1u);
    return b;
}
__device__ __forceinline__ void xcd_barrier_complete(unsigned* bar, unsigned x, unsigned& nloc, unsigned& nx) {
    const unsigned G = gridDim.x * gridDim.y * gridDim.z;
    unsigned sum, cnt, mine, sp = 0u;
    for (;;) {
        sum = 0u; cnt = 0u; mine = 0u;
#pragma unroll
        for (unsigned j = 0; j < 16; ++j) { const unsigned c = xb_ld(&bar[XB_XCNT(j)]); sum += c; cnt += (c > 0u) ? 1u : 0u; mine = (j == x) ? c : mine; }
        if (sum == G) break;
        __builtin_amdgcn_s_sleep(1);
        if ((++sp & 255u) == 0u) { if (xb_ld(&bar[XB_TMO])) break; if (sp > XB_SPIN_CAP) { atomicAdd(&bar[XB_TMO], 1u); break; } }
    }
    nloc = mine > 0u ? mine : 1u; nx = cnt > 0u ? cnt : 1u;
}
__device__ __forceinline__ void xcd_barrier(const XcdBarrier& b, bool t0) {
    asm volatile("s_waitcnt vmcnt(0)" ::: "memory");
    __syncthreads();
    if (t0) {
        unsigned* bar = b.bar;
        __builtin_amdgcn_s_waitcnt(0);
        unsigned nloc = b.st[0], nx = b.st[1];
        if (nloc == 0u) { xcd_barrier_complete(bar, b.x, nloc, nx); b.st[0] = nloc; b.st[1] = nx; }
        const unsigned old = xb_add(&bar[XB_XSUB(b.x)], 1u);
        const unsigned gen = old / nloc;
        if (old + 1u == (gen + 1u) * nloc) {
            __builtin_amdgcn_fence(__ATOMIC_RELEASE, "agent");
            asm volatile("s_waitcnt vmcnt(0)" ::: "memory");
            const unsigned og = xb_add(&bar[XB_TOP], 1u);
            const unsigned tg = og / nx;
            if (og + 1u == (tg + 1u) * nx) xb_add(&bar[XB_TOPGEN], 1u);
            else XB_SPIN(xb_ld(&bar[XB_TOPGEN]) == tg, bar);
            __builtin_amdgcn_fence(__ATOMIC_ACQUIRE, "agent");
            xb_add(&bar[XB_XGEN(b.x)], 1u);
            asm volatile("s_waitcnt vmcnt(0)" ::: "memory");
        } else {
            XB_SPIN(xb_ld(&bar[XB_XGEN(b.x)]) == gen, bar);
            __builtin_amdgcn_fence(__ATOMIC_ACQUIRE, "agent");
            asm volatile("s_waitcnt vmcnt(0)" ::: "memory");
        }
    }
    __syncthreads();
}

__device__ __forceinline__ void ph_norm(const float* x, const float* gain, bf16* out, int wave, int lane) {
    asm volatile("" : "+s"(wave), "+v"(lane));
    const int gw = blockIdx.x * NWAVES + wave, NGW = gridDim.x * NWAVES;
    for (int m = gw; m < T_; m += NGW) {
        const f32x4* xr = (const f32x4*)(x + (size_t)m * D_) + lane;
        f32x4 v[4]; float s = 0.f;
#pragma unroll
        for (int j = 0; j < 4; ++j) { v[j] = xr[64 * j]; s += (v[j].x * v[j].x + v[j].y * v[j].y) + (v[j].z * v[j].z + v[j].w * v[j].w); }
        const float r = rsqrtf(wave_sum(s) * (1.f / D_) + EPS);
        v2u* o8 = (v2u*)(out + (size_t)m * D_) + lane;
#pragma unroll
        for (int j = 0; j < 4; ++j) { const f32x4 g = ((const f32x4*)gain)[lane + 64 * j]; v2u w; w.x = pk2(v[j].x * r * g.x, v[j].y * r * g.y); w.y = pk2(v[j].z * r * g.z, v[j].w * r * g.w); o8[64 * j] = w; }
    }
}

__device__ __forceinline__ void ph_norm_combine(float* xio, const bf16* Y, const int* rowof, const float* gain, bf16* out, int wave, int lane) {
    asm volatile("" : "+s"(wave), "+v"(lane));
    const int gw = blockIdx.x * NWAVES + wave, NGW = gridDim.x * NWAVES;
    for (int m = gw; m < T_; m += NGW) {
        f32x4* xr = (f32x4*)(xio + (size_t)m * D_) + lane;
        const int r0 = rowof[2 * m], r1 = rowof[2 * m + 1];
        const v2u* y0 = (const v2u*)(Y + (size_t)r0 * D_) + lane; const v2u* y1 = (const v2u*)(Y + (size_t)r1 * D_) + lane;
        f32x4 v[4]; float s = 0.f;
#pragma unroll
        for (int j = 0; j < 4; ++j) { const v2u a = y0[64 * j], b = y1[64 * j]; f32x4 x = xr[64 * j];
            x.x += bf2f(a.x & 0xffffu) + bf2f(b.x & 0xffffu); x.y += bf2f(a.x >> 16) + bf2f(b.x >> 16); x.z += bf2f(a.y & 0xffffu) + bf2f(b.y & 0xffffu); x.w += bf2f(a.y >> 16) + bf2f(b.y >> 16);
            v[j] = x; if (gain) xr[64 * j] = x; else xr[64 * j] = x;
            s += (x.x * x.x + x.y * x.y) + (x.z * x.z + x.w * x.w); }
        if (gain) {
            const float r = rsqrtf(wave_sum(s) * (1.f / D_) + EPS);
            v2u* o8 = (v2u*)(out + (size_t)m * D_) + lane;
#pragma unroll
            for (int j = 0; j < 4; ++j) { const f32x4 g = ((const f32x4*)gain)[lane + 64 * j]; v2u w; w.x = pk2(v[j].x * r * g.x, v[j].y * r * g.y); w.y = pk2(v[j].z * r * g.z, v[j].w * r * g.w); o8[64 * j] = w; }
        }
    }
}

__device__ __forceinline__ void ph_inproj_simple(const bf16* HB, const float* w_in, const float* f_bias, const float* qn, const float* kn, const float* dt_bias, const float* bgate,
                                                 bf16* FOX, bf16* GLA, bf16* SSM, float* SML, bf16* GATES, int tid) {
    asm volatile("" : "+v"(tid));
    const int r = tid >> 3, cg = tid & 7;
    constexpr int NTC = (INC + 63) / 64;
    for (int item = blockIdx.x; item < (T_ / 64) * NTC; item += gridDim.x) {
        const int tm = item / NTC, tn = item % NTC;
        const int row = tm * 64 + r, c0 = tn * 64 + cg * 8;
        float acc[8];
#pragma unroll
        for (int j = 0; j < 8; ++j) acc[j] = 0.f;
        if (c0 < INC) {
            const bf16* a = HB + (size_t)row * D_;
            const float* w = w_in + c0;
            for (int k8 = 0; k8 < D_ / 8; ++k8) {
                const v4u av = *(const v4u*)(a + 8 * k8);
                float af[8] = {bf2f(av.x & 0xffffu), bf2f(av.x >> 16), bf2f(av.y & 0xffffu), bf2f(av.y >> 16), bf2f(av.z & 0xffffu), bf2f(av.z >> 16), bf2f(av.w & 0xffffu), bf2f(av.w >> 16)};
#pragma unroll
                for (int kk = 0; kk < 8; ++kk) {
                    const f32x4 w0 = *(const f32x4*)(w + (size_t)(8 * k8 + kk) * INC), w1 = *(const f32x4*)(w + (size_t)(8 * k8 + kk) * INC + 4);
                    acc[0] += af[kk] * w0.x; acc[1] += af[kk] * w0.y; acc[2] += af[kk] * w0.z; acc[3] += af[kk] * w0.w;
                    acc[4] += af[kk] * w1.x; acc[5] += af[kk] * w1.y; acc[6] += af[kk] * w1.z; acc[7] += af[kk] * w1.w;
                }
            }
        }
        if (c0 < 1024) {
            float ss = 0.f;
#pragma unroll
            for (int j = 0; j < 8; ++j) ss += acc[j] * acc[j];
            ss += __shfl_xor(ss, 1); ss += __shfl_xor(ss, 2); ss += __shfl_xor(ss, 4);
            const float rs = rsqrtf(ss * (1.f / 64.f) + EPS);
            const bool isq = c0 < 512; const float* gain = isq ? qn : kn; const float sc = isq ? 0.125f * LOG2E : 1.f;
            float v[8];
#pragma unroll
            for (int j = 0; j < 8; ++j) v[j] = acc[j] * rs * gain[(c0 + j) & 63] * sc;
            v4u o; o.x = pk2(v[0], v[1]); o.y = pk2(v[2], v[3]); o.z = pk2(v[4], v[5]); o.w = pk2(v[6], v[7]);
            *(v4u*)(FOX + (size_t)row * FOXP + c0) = o;
        } else if (c0 < INC) {
#pragma unroll
            for (int j = 0; j < 8; ++j) {
                const int col = c0 + j; const float v = acc[j];
                if (col < 1536) FOX[(size_t)row * FOXP + col] = (bf16)f2bf(v);
                else if (col < 1544) SML[(size_t)row * SMLP + (col - 1536)] = logsig_f(v + f_bias[col - 1536]) * LOG2E;
                else if (col < 3080) GLA[(size_t)row * GLAP + (col - 1544)] = (bf16)f2bf(v);
                else if (col < 3096) SML[(size_t)row * SMLP + 8 + (col - 3080)] = v;
                else if (col < 4376) SSM[(size_t)row * SSMP + (col - 3096)] = (bf16)f2bf(v);
                else if (col < 4384) SML[(size_t)row * SMLP + 24 + (col - 4376)] = softplus_f(v + dt_bias[col - 4376]);
                else GATES[(size_t)row * GATP + (col - 4384)] = (bf16)f2bf(sigmoid_f(v + bgate[col - 4384]));
            }
        }
    }
}

__device__ __forceinline__ void ph_cumsum(const float* SML, float* CUM, LAS float* sh, int tid) {
    asm volatile("" : "+v"(tid));
    for (int seq = blockIdx.x; seq < 16; seq += gridDim.x) {
        const int b = seq >> 3, h = seq & 7;
        float loc[16]; float run = 0.f;
#pragma unroll
        for (int i = 0; i < 16; ++i) { run += SML[(size_t)(b * S_ + tid * 16 + i) * SMLP + h]; loc[i] = run; }
        const int lane_ = tid & 63, wave_ = tid >> 6;
        float inc = run;
#pragma unroll
        for (int o = 1; o < 64; o <<= 1) { const float t = __shfl_up(inc, o); if (lane_ >= o) inc += t; }
        __syncthreads();
        if (lane_ == 63) sh[512 + wave_] = inc;
        __syncthreads();
        float wp = 0.f;
#pragma unroll
        for (int w = 0; w < 8; ++w) wp += (w < wave_) ? sh[512 + w] : 0.f;
        sh[tid] = wp + inc - run;
        __syncthreads();
        const float ex = sh[tid];
#pragma unroll
        for (int i = 0; i < 16; ++i) CUM[(size_t)seq * S_ + tid * 16 + i] = ex + loc[i];
    }
}

__device__ __forceinline__ void attn_simple_wave(bf16* FOX, const float* CUM, int b, int h, int g, int lane) {
    const int t = g * 32 + (lane >> 1), hf = lane & 1;
    const size_t rowq = (size_t)(b * S_ + t) * FOXP + h * 64 + hf * 32;
    float q[32], o[32];
#pragma unroll
    for (int i = 0; i < 4; ++i) { const v4u w = *(const v4u*)(FOX + rowq + 8 * i);
        q[8 * i + 0] = bf2f(w.x & 0xffffu); q[8 * i + 1] = bf2f(w.x >> 16); q[8 * i + 2] = bf2f(w.y & 0xffffu); q[8 * i + 3] = bf2f(w.y >> 16);
        q[8 * i + 4] = bf2f(w.z & 0xffffu); q[8 * i + 5] = bf2f(w.z >> 16); q[8 * i + 6] = bf2f(w.w & 0xffffu); q[8 * i + 7] = bf2f(w.w >> 16); }
#pragma unroll
    for (int d = 0; d < 32; ++d) o[d] = 0.f;
    const float* cs = CUM + (size_t)(b * 8 + h) * S_;
    const float cq = cs[t];
    float m = -1e30f, l = 0.f;
    const int smax = g * 32 + 31;
#pragma unroll 1
    for (int s = 0; s <= smax; ++s) {
        const bf16* kp = FOX + (size_t)(b * S_ + s) * FOXP + 512 + h * 64 + hf * 32;
        float dot = 0.f;
#pragma unroll
        for (int i = 0; i < 4; ++i) { const v4u w = *(const v4u*)(kp + 8 * i);
            dot += q[8 * i + 0] * bf2f(w.x & 0xffffu) + q[8 * i + 1] * bf2f(w.x >> 16) + q[8 * i + 2] * bf2f(w.y & 0xffffu) + q[8 * i + 3] * bf2f(w.y >> 16)
                 + q[8 * i + 4] * bf2f(w.z & 0xffffu) + q[8 * i + 5] * bf2f(w.z >> 16) + q[8 * i + 6] * bf2f(w.w & 0xffffu) + q[8 * i + 7] * bf2f(w.w >> 16); }
        dot += __shfl_xor(dot, 1);
        float logit = dot + (cq - cs[s]);
        if (s > t) logit = -1e30f;
        const float mn = fmaxf(m, logit);
        const float sc = exp2f(m - mn), p = (s > t) ? 0.f : exp2f(logit - mn);
        l = l * sc + p; m = mn;
        const bf16* vp = kp + 512;
#pragma unroll
        for (int i = 0; i < 4; ++i) { const v4u w = *(const v4u*)(vp + 8 * i);
            o[8 * i + 0] = o[8 * i + 0] * sc + p * bf2f(w.x & 0xffffu); o[8 * i + 1] = o[8 * i + 1] * sc + p * bf2f(w.x >> 16);
            o[8 * i + 2] = o[8 * i + 2] * sc + p * bf2f(w.y & 0xffffu); o[8 * i + 3] = o[8 * i + 3] * sc + p * bf2f(w.y >> 16);
            o[8 * i + 4] = o[8 * i + 4] * sc + p * bf2f(w.z & 0xffffu); o[8 * i + 5] = o[8 * i + 5] * sc + p * bf2f(w.z >> 16);
            o[8 * i + 6] = o[8 * i + 6] * sc + p * bf2f(w.w & 0xffffu); o[8 * i + 7] = o[8 * i + 7] * sc + p * bf2f(w.w >> 16); }
    }
    const float rl = 1.f / l;
#pragma unroll
    for (int i = 0; i < 4; ++i) { v4u w; w.x = pk2(o[8 * i] * rl, o[8 * i + 1] * rl); w.y = pk2(o[8 * i + 2] * rl, o[8 * i + 3] * rl); w.z = pk2(o[8 * i + 4] * rl, o[8 * i + 5] * rl); w.w = pk2(o[8 * i + 6] * rl, o[8 * i + 7] * rl);
        *(v4u*)(FOX + rowq + 8 * i) = w; }
}

__device__ __forceinline__ void gla_simple_item(bf16* GLA, const float* SML, const float* w_lr, const float* b_gate, LAS float* L, int b, int h, int tid) {
    LAS float* qs = L; LAS float* ks = L + 4096; LAS float* ad = L + 8192; LAS float* vs = L + 12288; LAS float* ob = L + 20480; LAS float* red = L + 28672;
    const int v = tid & 127, dg = tid >> 7;
    float S[16];
#pragma unroll
    for (int i = 0; i < 16; ++i) S[i] = 0.f;
    for (int c = 0; c < S_ / 64; ++c) {
        const size_t row0 = (size_t)b * S_ + (size_t)c * 64;
        __syncthreads();
        for (int idx = tid; idx < 4096; idx += NTHR) { const int t = idx >> 6, d = idx & 63; const size_t row = row0 + t;
            qs[idx] = bf2f(GLA[row * GLAP + h * 64 + d]) * 0.125f; ks[idx] = bf2f(GLA[row * GLAP + 256 + h * 64 + d]);
            float z = b_gate[h * 64 + d];
#pragma unroll
            for (int j = 0; j < 16; ++j) z += SML[row * SMLP + 8 + j] * w_lr[j * 256 + h * 64 + d];
            ad[idx] = __expf(logsig_f(z) * (1.f / 16.f)); }
        for (int idx = tid; idx < 8192; idx += NTHR) { const int t = idx >> 7, vv = idx & 127; vs[idx] = bf2f(GLA[(row0 + t) * GLAP + 512 + h * 128 + vv]); }
        __syncthreads();
        for (int t = 0; t < 64; ++t) {
            const float vt = vs[t * 128 + v]; float part = 0.f;
#pragma unroll
            for (int i = 0; i < 16; ++i) { const int d = dg * 16 + i; S[i] = ad[t * 64 + d] * S[i] + ks[t * 64 + d] * vt; part += qs[t * 64 + d] * S[i]; }
            red[(t & 1) * 512 + dg * 128 + v] = part;
            __syncthreads();
            if (dg == 0) { const LAS float* rr = red + (t & 1) * 512; ob[t * 128 + v] = (rr[v] + rr[128 + v]) + (rr[256 + v] + rr[384 + v]); }
        }
        __syncthreads();
        for (int idx = tid; idx < 8192; idx += NTHR) { const int t = idx >> 7, vv = idx & 127; GLA[(row0 + t) * GLAP + 512 + h * 128 + vv] = (bf16)f2bf(ob[idx]); }
    }
}

__device__ __forceinline__ void ssd_simple_item(bf16* SSM, const float* SML, const float* conv_w, const float* conv_b, const float* a_log, const float* d_skip, LAS float* L, int b, int h, int tid) {
    LAS float* xs = L; LAS float* Bs = L + 4096; LAS float* Cs = L + 8192; LAS float* dts = L + 12288; LAS float* yb = L + 12352; LAS float* red = L + 16448;
    const int p = tid & 63, ng = tid >> 6, g = h >> 2;
    const float a = -__expf(a_log[h]), Dk = d_skip[h];
    float hs[8];
#pragma unroll
    for (int i = 0; i < 8; ++i) hs[i] = 0.f;
    for (int c = 0; c < S_ / 64; ++c) {
        const int s0 = c * 64;
        __syncthreads();
        for (int idx = tid; idx < 3 * 4096; idx += NTHR) { const int which = idx >> 12, t = (idx >> 6) & 63, n = idx & 63;
            const int ch = (which == 0) ? (h * 64 + n) : (which == 1 ? 512 + g * 64 + n : 640 + g * 64 + n);
            float acc = conv_b[ch];
#pragma unroll
            for (int j = 0; j < 4; ++j) { const int s = s0 + t - 3 + j; if (s >= 0) acc += conv_w[j * 768 + ch] * bf2f(SSM[((size_t)b * S_ + s) * SSMP + 512 + ch]); }
            L[idx] = silu_f(acc); }
        if (tid < 64) dts[tid] = SML[((size_t)b * S_ + s0 + tid) * SMLP + 24 + h];
        __syncthreads();
        for (int t = 0; t < 64; ++t) {
            const float dt = dts[t], dA = __expf(dt * a), xt = xs[t * 64 + p]; float part = 0.f;
#pragma unroll
            for (int i = 0; i < 8; ++i) { const int n = ng * 8 + i; hs[i] = dA * hs[i] + dt * Bs[t * 64 + n] * xt; part += Cs[t * 64 + n] * hs[i]; }
            red[(t & 1) * 512 + ng * 64 + p] = part;
            __syncthreads();
            if (ng == 0) { const LAS float* rr = red + (t & 1) * 512; float y = 0.f;
#pragma unroll
                for (int i = 0; i < 8; ++i) y += rr[i * 64 + p];
                yb[t * 64 + p] = y + Dk * xt; }
        }
        __syncthreads();
        for (int idx = tid; idx < 4096; idx += NTHR) { const int t = idx >> 6, pp = idx & 63; const size_t e = ((size_t)b * S_ + s0 + t) * SSMP + h * 64 + pp;
            const float z = bf2f(SSM[e]); SSM[e] = (bf16)f2bf(yb[idx] * silu_f(z)); }
    }
}

__device__ __forceinline__ void ph_mix_simple(bf16* FOX, const float* CUM, bf16* GLA, bf16* SSM, const float* SML, const float* w_lr, const float* b_gate,
                                              const float* conv_w, const float* conv_b, const float* a_log, const float* d_skip, LAS float* L, int tid, int wave, int lane) {
    asm volatile("" : "+v"(tid), "+s"(wave), "+v"(lane));
    for (int it = blockIdx.x; it < (FAST_ATTN ? 24 : 24 + 512); it += gridDim.x) {
        if (it < 8) gla_simple_item(GLA, SML, w_lr, b_gate, L, it >> 2, it & 3, tid);
        else if (it < 24) ssd_simple_item(SSM, SML, conv_w, conv_b, a_log, d_skip, L, (it - 8) >> 3, (it - 8) & 7, tid);
        else { const int wi = (it - 24) * 8 + wave; const int bh = wi >> 8, g = wi & 255; attn_simple_wave(FOX, CUM, bh >> 3, bh & 7, g, lane); }
        __syncthreads();
    }
}

__device__ __forceinline__ void ph_post(bf16* GLA, bf16* SSM, const float* gla_norm, const float* ssm_norm, int wave, int lane) {
    asm volatile("" : "+s"(wave), "+v"(lane));
    const int gw = blockIdx.x * NWAVES + wave, NGW = gridDim.x * NWAVES;
    for (int m = gw; m < T_; m += NGW) {
        {
            const v4u w = *(const v4u*)(GLA + (size_t)m * GLAP + 512 + 8 * lane), gr = *(const v4u*)(GLA + (size_t)m * GLAP + 1024 + 8 * lane);
            float o[8] = {bf2f(w.x & 0xffffu), bf2f(w.x >> 16), bf2f(w.y & 0xffffu), bf2f(w.y >> 16), bf2f(w.z & 0xffffu), bf2f(w.z >> 16), bf2f(w.w & 0xffffu), bf2f(w.w >> 16)};
            float gg[8] = {bf2f(gr.x & 0xffffu), bf2f(gr.x >> 16), bf2f(gr.y & 0xffffu), bf2f(gr.y >> 16), bf2f(gr.z & 0xffffu), bf2f(gr.z >> 16), bf2f(gr.w & 0xffffu), bf2f(gr.w >> 16)};
            float ss = 0.f;
#pragma unroll
            for (int j = 0; j < 8; ++j) ss += o[j] * o[j];
            ss += __shfl_xor(ss, 1); ss += __shfl_xor(ss, 2); ss += __shfl_xor(ss, 4); ss += __shfl_xor(ss, 8);
            const float rs = rsqrtf(ss * (1.f / 128.f) + EPS);
            float r[8];
#pragma unroll
            for (int j = 0; j < 8; ++j) r[j] = o[j] * rs * gla_norm[(8 * lane + j) & 127] * silu_f(gg[j]);
            v4u ov; ov.x = pk2(r[0], r[1]); ov.y = pk2(r[2], r[3]); ov.z = pk2(r[4], r[5]); ov.w = pk2(r[6], r[7]);
            *(v4u*)(GLA + (size_t)m * GLAP + 1024 + 8 * lane) = ov;
        }
        {
            const v4u w = *(const v4u*)(SSM + (size_t)m * SSMP + 8 * lane);
            float o[8] = {bf2f(w.x & 0xffffu), bf2f(w.x >> 16), bf2f(w.y & 0xffffu), bf2f(w.y >> 16), bf2f(w.z & 0xffffu), bf2f(w.z >> 16), bf2f(w.w & 0xffffu), bf2f(w.w >> 16)};
            float ss = 0.f;
#pragma unroll
            for (int j = 0; j < 8; ++j) ss += o[j] * o[j];
            ss += __shfl_xor(ss, 1); ss += __shfl_xor(ss, 2); ss += __shfl_xor(ss, 4); ss += __shfl_xor(ss, 8); ss += __shfl_xor(ss, 16);
            const float rs = rsqrtf(ss * (1.f / 256.f) + EPS);
            float r[8];
#pragma unroll
            for (int j = 0; j < 8; ++j) r[j] = o[j] * rs * ssm_norm[8 * lane + j];
            v4u ov; ov.x = pk2(r[0], r[1]); ov.y = pk2(r[2], r[3]); ov.z = pk2(r[4], r[5]); ov.w = pk2(r[6], r[7]);
            *(v4u*)(SSM + (size_t)m * SSMP + 8 * lane) = ov;
        }
    }
}

__device__ __forceinline__ void ph_merge_simple(bf16* FOX, const bf16* GLA, const bf16* SSM, const bf16* GATES, const float* w_branch, int tid) {
    asm volatile("" : "+v"(tid));
    const int r = tid >> 3, cg = tid & 7;
    for (int item = blockIdx.x; item < (T_ / 64) * 16; item += gridDim.x) {
        const int tm = item >> 4, tn = item & 15; const int row = tm * 64 + r, d0 = tn * 64 + cg * 8;
        float macc[8];
#pragma unroll
        for (int j = 0; j < 8; ++j) macc[j] = 0.f;
#pragma unroll 1
        for (int r3 = 0; r3 < 3; ++r3) {
            const bf16* a = (r3 == 0) ? FOX + (size_t)row * FOXP : (r3 == 1 ? GLA + (size_t)row * GLAP + 1024 : SSM + (size_t)row * SSMP);
            const float* w = w_branch + (size_t)r3 * 512 * 1024 + d0;
            float acc[8];
#pragma unroll
            for (int j = 0; j < 8; ++j) acc[j] = 0.f;
            for (int k8 = 0; k8 < 64; ++k8) {
                const v4u av = *(const v4u*)(a + 8 * k8);
                float af[8] = {bf2f(av.x & 0xffffu), bf2f(av.x >> 16), bf2f(av.y & 0xffffu), bf2f(av.y >> 16), bf2f(av.z & 0xffffu), bf2f(av.z >> 16), bf2f(av.w & 0xffffu), bf2f(av.w >> 16)};
#pragma unroll
                for (int kk = 0; kk < 8; ++kk) {
                    const f32x4 w0 = *(const f32x4*)(w + (size_t)(8 * k8 + kk) * 1024), w1 = *(const f32x4*)(w + (size_t)(8 * k8 + kk) * 1024 + 4);
                    acc[0] += af[kk] * w0.x; acc[1] += af[kk] * w0.y; acc[2] += af[kk] * w0.z; acc[3] += af[kk] * w0.w;
                    acc[4] += af[kk] * w1.x; acc[5] += af[kk] * w1.y; acc[6] += af[kk] * w1.z; acc[7] += af[kk] * w1.w;
                }
            }
            const v4u gv = *(const v4u*)(GATES + (size_t)row * GATP + r3 * 1024 + d0);
            macc[0] += bf2f(gv.x & 0xffffu) * acc[0]; macc[1] += bf2f(gv.x >> 16) * acc[1]; macc[2] += bf2f(gv.y & 0xffffu) * acc[2]; macc[3] += bf2f(gv.y >> 16) * acc[3];
            macc[4] += bf2f(gv.z & 0xffffu) * acc[4]; macc[5] += bf2f(gv.z >> 16) * acc[5]; macc[6] += bf2f(gv.w & 0xffffu) * acc[6]; macc[7] += bf2f(gv.w >> 16) * acc[7];
        }
        v4u o; o.x = pk2(macc[0], macc[1]); o.y = pk2(macc[2], macc[3]); o.z = pk2(macc[4], macc[5]); o.w = pk2(macc[6], macc[7]);
        *(v4u*)(FOX + (size_t)row * FOXP + 512 + d0) = o;
    }
}

__device__ __forceinline__ void ph_out_simple(const bf16* FOX, const float* w_out, const float* xold, float* xnew, int tid) {
    asm volatile("" : "+v"(tid));
    const int r = tid >> 3, cg = tid & 7;
    for (int item = blockIdx.x; item < (T_ / 64) * 16; item += gridDim.x) {
        const int tm = item >> 4, tn = item & 15; const int row = tm * 64 + r, d0 = tn * 64 + cg * 8;
        const bf16* a = FOX + (size_t)row * FOXP + 512; const float* w = w_out + d0;
        float acc[8];
#pragma unroll
        for (int j = 0; j < 8; ++j) acc[j] = 0.f;
        for (int k8 = 0; k8 < 128; ++k8) {
            const v4u av = *(const v4u*)(a + 8 * k8);
            float af[8] = {bf2f(av.x & 0xffffu), bf2f(av.x >> 16), bf2f(av.y & 0xffffu), bf2f(av.y >> 16), bf2f(av.z & 0xffffu), bf2f(av.z >> 16), bf2f(av.w & 0xffffu), bf2f(av.w >> 16)};
#pragma unroll
            for (int kk = 0; kk < 8; ++kk) {
                const f32x4 w0 = *(const f32x4*)(w + (size_t)(8 * k8 + kk) * 1024), w1 = *(const f32x4*)(w + (size_t)(8 * k8 + kk) * 1024 + 4);
                acc[0] += af[kk] * w0.x; acc[1] += af[kk] * w0.y; acc[2] += af[kk] * w0.z; acc[3] += af[kk] * w0.w;
                acc[4] += af[kk] * w1.x; acc[5] += af[kk] * w1.y; acc[6] += af[kk] * w1.z; acc[7] += af[kk] * w1.w;
            }
        }
        const f32x4 x0 = *(const f32x4*)(xold + (size_t)row * D_ + d0), x1 = *(const f32x4*)(xold + (size_t)row * D_ + d0 + 4);
        *(f32x4*)(xnew + (size_t)row * D_ + d0) = (f32x4){x0.x + acc[0], x0.y + acc[1], x0.z + acc[2], x0.w + acc[3]};
        *(f32x4*)(xnew + (size_t)row * D_ + d0 + 4) = (f32x4){x1.x + acc[4], x1.y + acc[5], x1.z + acc[6], x1.w + acc[7]};
    }
}

__device__ __forceinline__ void ph_norm2_route(const float* x, const float* gain, bf16* out, const float* wg, const float* bg, const float* we, const float* be, int* tok_e, float* tok_w, int wave, int lane) {
    asm volatile("" : "+s"(wave), "+v"(lane));
    const int gw = blockIdx.x * NWAVES + wave, NGW = gridDim.x * NWAVES;
    for (int m = gw; m < T_; m += NGW) {
        const f32x4* xr = (const f32x4*)(x + (size_t)m * D_) + lane;
        f32x4 v[4]; float s = 0.f;
#pragma unroll
        for (int j = 0; j < 4; ++j) { v[j] = xr[64 * j]; s += (v[j].x * v[j].x + v[j].y * v[j].y) + (v[j].z * v[j].z + v[j].w * v[j].w); }
        const float r = rsqrtf(wave_sum(s) * (1.f / D_) + EPS);
        v2u* o8 = (v2u*)(out + (size_t)m * D_) + lane;
        float gl[4] = {0.f, 0.f, 0.f, 0.f}; float hn[16];
#pragma unroll
        for (int j = 0; j < 4; ++j) { const f32x4 g = ((const f32x4*)gain)[lane + 64 * j];
            const float h0 = v[j].x * r * g.x, h1 = v[j].y * r * g.y, h2 = v[j].z * r * g.z, h3 = v[j].w * r * g.w;
            v2u w; w.x = pk2(h0, h1); w.y = pk2(h2, h3); o8[64 * j] = w;
            hn[4 * j] = h0; hn[4 * j + 1] = h1; hn[4 * j + 2] = h2; hn[4 * j + 3] = h3;
#pragma unroll
            for (int i = 0; i < 4; ++i) { const int k = 4 * (lane + 64 * j) + i; const f32x4 a = *(const f32x4*)(wg + (size_t)k * 4);
                gl[0] += hn[4 * j + i] * a.x; gl[1] += hn[4 * j + i] * a.y; gl[2] += hn[4 * j + i] * a.z; gl[3] += hn[4 * j + i] * a.w; } }
#pragma unroll
        for (int i = 0; i < 4; ++i) gl[i] = wave_sum(gl[i]) + bg[i];
        int gs = 0; float gm = gl[0];
#pragma unroll
        for (int i = 1; i < 4; ++i) if (gl[i] > gm) { gm = gl[i]; gs = i; }
        float gsum = 0.f;
#pragma unroll
        for (int i = 0; i < 4; ++i) gsum += __expf(gl[i] - gm);
        const float g_w = 1.f / gsum;
        gs = __builtin_amdgcn_readfirstlane(gs);
        float el[4] = {0.f, 0.f, 0.f, 0.f};
#pragma unroll
        for (int j = 0; j < 4; ++j)
#pragma unroll
            for (int i = 0; i < 4; ++i) { const int k = 4 * (lane + 64 * j) + i; const f32x4 c = *(const f32x4*)(we + (size_t)k * 16 + 4 * gs);
                el[0] += hn[4 * j + i] * c.x; el[1] += hn[4 * j + i] * c.y; el[2] += hn[4 * j + i] * c.z; el[3] += hn[4 * j + i] * c.w; }
#pragma unroll
        for (int i = 0; i < 4; ++i) el[i] = wave_sum(el[i]) + be[4 * gs + i];
        int i0 = 0; float m0 = el[0];
#pragma unroll
        for (int i = 1; i < 4; ++i) if (el[i] > m0) { m0 = el[i]; i0 = i; }
        int i1 = -1; float m1 = -3.0e38f;
#pragma unroll
        for (int i = 0; i < 4; ++i) if (i != i0 && el[i] > m1) { m1 = el[i]; i1 = i; }
        const float p1 = __expf(m1 - m0);
        const float w0 = g_w / (1.f + p1), w1 = g_w * p1 / (1.f + p1);
        if (lane == 0) { tok_e[2 * m] = gs * 4 + i0; tok_e[2 * m + 1] = gs * 4 + i1; tok_w[2 * m] = w0; tok_w[2 * m + 1] = w1; }
    }
}

__device__ __forceinline__ void ph_moe_simple(const bf16* HB, const int* tok_e, const float* tok_w, const float* wgate, const float* wup, const float* wdown, float* x, LAS float* L, int tid) {
    asm volatile("" : "+v"(tid));
    LAS float* hrow = L; LAS float* hid = L + 1024;
    for (int m = blockIdx.x; m < T_; m += gridDim.x) {
        __syncthreads();
        hrow[tid] = bf2f(HB[(size_t)m * D_ + tid]); hrow[tid + 512] = bf2f(HB[(size_t)m * D_ + tid + 512]);
        float y0 = 0.f, y1 = 0.f;
#pragma unroll 1
        for (int sl = 0; sl < 2; ++sl) {
            const int e = tok_e[2 * m + sl]; const float wt = tok_w[2 * m + sl];
            __syncthreads();
            const float* G = wgate + (size_t)e * 1024 * 512 + tid; const float* U = wup + (size_t)e * 1024 * 512 + tid;
            float g = 0.f, u = 0.f;
#pragma unroll 8
            for (int k = 0; k < 1024; ++k) { const float hk = hrow[k]; g += hk * G[(size_t)k * 512]; u += hk * U[(size_t)k * 512]; }
            hid[tid] = silu_f(g) * u;
            __syncthreads();
            const float* Dn = wdown + (size_t)e * 512 * 1024 + tid;
            float a0 = 0.f, a1 = 0.f;
#pragma unroll 8
            for (int j = 0; j < 512; ++j) { const float hj = hid[j]; a0 += hj * Dn[(size_t)j * 1024]; a1 += hj * Dn[(size_t)j * 1024 + 512]; }
            y0 += wt * a0; y1 += wt * a1;
        }
        x[(size_t)m * D_ + tid] += y0; x[(size_t)m * D_ + tid + 512] += y1;
    }
}


namespace pg8 {
typedef short bf16x8 __attribute__((ext_vector_type(8)));
constexpr int BM = 256, BK = 64, HALF = 128, HTB = HALF * BK * 2, STAGE_BYTES = 8 * HTB, NXCD = 8, WGM = 8;
__host__ __device__ __forceinline__ int lds_byte(int r, int c) { const int st = (r >> 4) * 2 + (c >> 5), rr = r & 15, cc = c & 31, ob = rr * 64 + cc * 2; return st * 1024 + (ob ^ (((ob >> 9) & 1) << 5)); }
__host__ __device__ __forceinline__ void stage_rc(int b, int& R, int& C) { const int st = b / 1024, sb = b % 1024, swz = sb ^ (((sb >> 9) & 1) << 5); R = (st >> 1) * 16 + swz / 64; C = (st & 1) * 32 + (swz % 64) / 2; }
__host__ __device__ __forceinline__ int perm32(int rho) { const int n = rho >> 4, i = rho & 15; return 8 * (i >> 2) + 4 * n + (i & 3); }
struct Unit { int pm, pn, aux; };
struct GridOrder {
    int nM, nN, nwg, G, c; const char* A; const char* B; size_t tsA, tsB;
    __device__ __forceinline__ void init(int M, int N, int G_, int c_, const void* A_, int lda, const void* B_, int ldb) { nM = M / BM; nN = N / BM; nwg = nM * nN; G = G_; c = c_; A = (const char*)A_; B = (const char*)B_; tsA = (size_t)BM * lda * 2; tsB = (size_t)BM * ldb * 2; }
    __device__ __forceinline__ bool next(int i, Unit& u) const {
        const long L = (long)i * G + c; if (L >= nwg) return false;
        int wgid = (int)L; { const int q = nwg / NXCD, r = nwg % NXCD, xcd = wgid % NXCD, off = wgid / NXCD; wgid = (xcd < r ? xcd * (q + 1) : r * (q + 1) + (xcd - r) * q) + off; }
        const int nig = WGM * nN, gid = wgid / nig, fm = gid * WGM, gsz = (nM - fm) < WGM ? (nM - fm) : WGM;
        u.pm = fm + ((wgid % nig) % gsz); u.pn = (wgid % nig) / gsz; u.aux = 0; return true;
    }
    __device__ __forceinline__ const char* abase(const Unit& u) const { return A + (size_t)u.pm * tsA; }
    __device__ __forceinline__ const char* bbase(const Unit& u) const { return B + (size_t)u.pn * tsB; }
};
template <class Epi, class Sched>
__device__ __forceinline__ void gemm_phase(LAS unsigned char* lds, const int K, const int lda, const Sched& S, const Epi& E, int wave_) {
    int tid = wave_ * 64 + lane_id(); asm volatile("" : "+v"(tid));
    const int wid = __builtin_amdgcn_readfirstlane(tid >> 6), lane = tid & 63, wr = wid >> 2, wc = wid & 3, fr = lane & 15, fq = lane >> 4;
    const int nt = K / BK;
    unsigned voffA[2], voffB[2];
#pragma unroll
    for (int i = 0; i < 2; ++i) { int R, C; stage_rc(tid * 16 + i * 8192, R, C); const int Rb = (R & ~31) + perm32(R & 31);
        voffA[i] = (unsigned)(R * lda + C) * 2u; voffB[i] = (unsigned)(Rb * K + C) * 2u; }
    const size_t kstep = (size_t)(BK * 2);
    const size_t hstepA = (size_t)HALF * lda * 2, hstepB = (size_t)HALF * K * 2;
    const unsigned ldsw = (unsigned)wid * 1024u;
    const int aoff = lds_byte(wr * 64 + fr, fq * 8), boff = lds_byte(wc * 32 + fr, fq * 8);
#define PG8_SA(b, h) (((b) * 2 + (h)) * HTB)
#define PG8_SB(b, h) ((4 + (b) * 2 + (h)) * HTB)
#define PG8_STAGE(bufoff, gbase, voff) do { _Pragma("unroll") for (int _i = 0; _i < 2; ++_i) \
        __builtin_amdgcn_global_load_lds((const unsigned*)((const char*)(gbase) + (voff)[_i]), (LAS unsigned*)(lds + (bufoff) + ldsw + _i * 8192), 16, 0, 0); } while (0)
#define PG8_LDA(dst, b, h) do { _Pragma("unroll") for (int m = 0; m < 4; ++m) _Pragma("unroll") for (int k = 0; k < 2; ++k) dst[m][k] = *(const LAS bf16x8*)(lds + PG8_SA(b, h) + aoff + m * 2048 + k * 1024); } while (0)
#define PG8_LDB(dst, b, h) do { _Pragma("unroll") for (int n = 0; n < 2; ++n) _Pragma("unroll") for (int k = 0; k < 2; ++k) dst[n][k] = *(const LAS bf16x8*)(lds + PG8_SB(b, h) + boff + n * 2048 + k * 1024); } while (0)
#define PG8_MMA(ai, bj, At, Bt) do { __builtin_amdgcn_s_setprio(1); _Pragma("unroll") for (int m = 0; m < 4; ++m) _Pragma("unroll") for (int n = 0; n < 2; ++n) _Pragma("unroll") for (int k = 0; k < 2; ++k) \
        acc[ai][bj][m][n] = __builtin_amdgcn_mfma_f32_16x16x32_bf16(Bt[n][k], At[m][k], acc[ai][bj][m][n], 0, 0, 0); __builtin_amdgcn_s_setprio(0); } while (0)
#define PG8_WAIT_V(n) asm volatile("s_waitcnt vmcnt(" #n ")" ::: "memory")
#define PG8_WAIT_L(n) asm volatile("s_waitcnt lgkmcnt(" #n ")" ::: "memory")
#define PG8_BAR __builtin_amdgcn_s_barrier()
#define PG8_SCHED __builtin_amdgcn_sched_barrier(0)
    Unit cur, nxt; int ui = 0;
    if (!S.next(0, cur)) return;
    f32x4 acc[2][2][4][2];
#pragma unroll
    for (int a = 0; a < 2; ++a)
#pragma unroll
        for (int b = 0; b < 2; ++b)
#pragma unroll
            for (int m = 0; m < 4; ++m)
#pragma unroll
                for (int n = 0; n < 2; ++n) acc[a][b][m][n] = (f32x4){0.f, 0.f, 0.f, 0.f};
    bf16x8 At[4][2], B0[2][2], B1[2][2];
    const char* cA = S.abase(cur); const char* cB = S.bbase(cur);
    PG8_STAGE(PG8_SB(0, 0), cB, voffB); PG8_STAGE(PG8_SB(0, 1), cB + hstepB, voffB); PG8_STAGE(PG8_SA(0, 0), cA, voffA); PG8_STAGE(PG8_SA(0, 1), cA + hstepA, voffA);
    if (wr == 1) PG8_BAR;
    PG8_WAIT_V(2); PG8_BAR;
    PG8_STAGE(PG8_SB(1, 0), cB + kstep, voffB); PG8_STAGE(PG8_SA(1, 0), cA + kstep, voffA); PG8_STAGE(PG8_SB(1, 1), cB + hstepB + kstep, voffB);
    PG8_WAIT_V(6); PG8_BAR;
    for (;;) {
        const bool has_next = S.next(ui + 1, nxt);
        const char* nA = has_next ? S.abase(nxt) : cA; const char* nB = has_next ? S.bbase(nxt) : cB;
        for (int t = 0; t < nt; t += 2) {
            const bool last = (t == nt - 2);
            const char* a1 = cA + (size_t)(t + 1) * kstep;
            const char* a2 = last ? nA : cA + (size_t)(t + 2) * kstep; const char* b2 = last ? nB : cB + (size_t)(t + 2) * kstep;
            const char* a3 = a2 + kstep; const char* b3 = b2 + kstep;
            PG8_LDB(B0, 0, 0); PG8_LDB(B1, 0, 1); PG8_SCHED; PG8_LDA(At, 0, 0); PG8_STAGE(PG8_SA(1, 1), a1 + hstepA, voffA);
            PG8_WAIT_V(8); PG8_WAIT_L(0); PG8_BAR; PG8_MMA(0, 0, At, B0); PG8_MMA(0, 1, At, B1); PG8_BAR; PG8_SCHED;
            PG8_LDA(At, 0, 1); PG8_STAGE(PG8_SB(0, 0), b2, voffB); PG8_STAGE(PG8_SB(0, 1), b2 + hstepB, voffB); PG8_STAGE(PG8_SA(0, 0), a2, voffA);
            PG8_WAIT_V(8); PG8_WAIT_L(0); PG8_BAR; PG8_MMA(1, 0, At, B0); PG8_MMA(1, 1, At, B1); PG8_BAR; PG8_SCHED;
            PG8_LDB(B0, 1, 0); PG8_LDB(B1, 1, 1); PG8_SCHED; PG8_LDA(At, 1, 0); PG8_STAGE(PG8_SA(0, 1), a2 + hstepA, voffA);
            PG8_WAIT_V(8); PG8_WAIT_L(0); PG8_BAR; PG8_MMA(0, 0, At, B0); PG8_MMA(0, 1, At, B1); PG8_BAR; PG8_SCHED;
            PG8_LDA(At, 1, 1); PG8_STAGE(PG8_SB(1, 0), b3, voffB); PG8_STAGE(PG8_SB(1, 1), b3 + hstepB, voffB); PG8_STAGE(PG8_SA(1, 0), a3, voffA);
            PG8_WAIT_V(8); PG8_WAIT_L(0); PG8_BAR; PG8_MMA(1, 0, At, B0); PG8_MMA(1, 1, At, B1); PG8_BAR; PG8_SCHED;
        }
        if (wr == 0) PG8_BAR;
        E(acc, cur, wr, wc, fr, fq);
        if (!has_next) break;
#pragma unroll
        for (int a = 0; a < 2; ++a)
#pragma unroll
            for (int b = 0; b < 2; ++b)
#pragma unroll
                for (int m = 0; m < 4; ++m)
#pragma unroll
                    for (int n = 0; n < 2; ++n) acc[a][b][m][n] = (f32x4){0.f, 0.f, 0.f, 0.f};
        cur = nxt; cA = nA; cB = nB; ++ui;
        if (wr == 1) PG8_BAR;
    }
    PG8_WAIT_V(0);
    PG8_BAR;
#undef PG8_SA
#undef PG8_SB
#undef PG8_STAGE
#undef PG8_LDA
#undef PG8_LDB
#undef PG8_MMA
#undef PG8_WAIT_V
#undef PG8_WAIT_L
#undef PG8_BAR
#undef PG8_SCHED
}
typedef float f32x2_t __attribute__((ext_vector_type(2))); typedef __bf16 bf16x2_t __attribute__((ext_vector_type(2)));
__device__ __forceinline__ unsigned cvt_pk_bf16(float lo, float hi) { f32x2_t v = {lo, hi}; bf16x2_t b = __builtin_convertvector(v, bf16x2_t); return __builtin_bit_cast(unsigned, b); }
__device__ __forceinline__ v4u pack8(const f32x4 a, const f32x4 b) { v4u w; w.x = cvt_pk_bf16(a[0], a[1]); w.y = cvt_pk_bf16(a[2], a[3]); w.z = cvt_pk_bf16(b[0], b[1]); w.w = cvt_pk_bf16(b[2], b[3]); return w; }

struct EpiInproj {
    bf16* FOX; bf16* GLA; bf16* SSM; float* SML; bf16* GATES; const LAS float *qn, *kn, *f_bias, *dt_bias, *bgate;
    __device__ __forceinline__ void operator()(const f32x4 (&acc)[2][2][4][2], const Unit& u, int wr, int wc, int fr, int fq) const {
        asm volatile("" : "+v"(fr), "+v"(fq), "+s"(wr), "+s"(wc));
        const int pn = u.pn; const size_t row0 = (size_t)u.pm * BM + wr * 64 + fr;
        if (EPI_SKIP(pn)) return;
        if (pn < 4) {
            const bool isq = pn < 2; const LAS float* gain = isq ? qn : kn; const float sc = isq ? 0.125f * LOG2E : 1.f;
            f32x4 g[2][2];
#pragma unroll
            for (int bj = 0; bj < 2; ++bj)
#pragma unroll
                for (int n = 0; n < 2; ++n) g[bj][n] = *(const LAS f32x4*)(gain + 32 * bj + 8 * fq + 4 * n);
            bf16* dst = FOX + (isq ? 0 : 512) + (pn & 1) * 256 + 64 * wc + 8 * fq;
#pragma unroll
            for (int ai = 0; ai < 2; ++ai)
#pragma unroll
                for (int m = 0; m < 4; ++m) {
                    float ss = 0.f;
#pragma unroll
                    for (int bj = 0; bj < 2; ++bj)
#pragma unroll
                        for (int n = 0; n < 2; ++n) { const f32x4 x = acc[ai][bj][m][n]; ss += (x[0] * x[0] + x[1] * x[1]) + (x[2] * x[2] + x[3] * x[3]); }
                    ss += __shfl_xor(ss, 16); ss += __shfl_xor(ss, 32);
                    const float rs = rsqrtf(ss * (1.f / 64.f) + EPS) * sc;
                    bf16* rp = dst + (row0 + ai * HALF + m * 16) * FOXP;
#pragma unroll
                    for (int bj = 0; bj < 2; ++bj) *(v4u*)(rp + 32 * bj) = pack8(acc[ai][bj][m][0] * rs * g[bj][0], acc[ai][bj][m][1] * rs * g[bj][1]);
                }
        } else if (pn == 17) {
            if (wc == 0) {
                f32x4 b0 = (f32x4){0.f, 0.f, 0.f, 0.f}, b1 = b0;
                if (fq == 0) { b0 = *(const LAS f32x4*)(f_bias); b1 = *(const LAS f32x4*)(f_bias + 4); }
                if (fq == 3) { b0 = *(const LAS f32x4*)(dt_bias); b1 = *(const LAS f32x4*)(dt_bias + 4); }
#pragma unroll
                for (int ai = 0; ai < 2; ++ai)
#pragma unroll
                    for (int m = 0; m < 4; ++m) {
                        f32x4 v0 = acc[ai][0][m][0] + b0, v1 = acc[ai][0][m][1] + b1;
                        if (fq == 0) {
#pragma unroll
                            for (int i = 0; i < 4; ++i) { v0[i] = (fminf(v0[i], 0.f) - __logf(1.f + __expf(-fabsf(v0[i])))) * LOG2E; v1[i] = (fminf(v1[i], 0.f) - __logf(1.f + __expf(-fabsf(v1[i])))) * LOG2E; } }
                        if (fq == 3) {
#pragma unroll
                            for (int i = 0; i < 4; ++i) { v0[i] = fmaxf(v0[i], 0.f) + __logf(1.f + __expf(-fabsf(v0[i]))); v1[i] = fmaxf(v1[i], 0.f) + __logf(1.f + __expf(-fabsf(v1[i]))); } }
                        float* rp = SML + (row0 + ai * HALF + m * 16) * SMLP + 8 * fq;
                        *(f32x4*)rp = v0; *(f32x4*)(rp + 4) = v1;
                    }
            }
        } else if (pn >= 18) {
            const int colt = (pn - 18) * 256 + 32 * wc + 8 * fq;
#pragma unroll
            for (int bj = 0; bj < 2; ++bj) {
                const f32x4 b0 = *(const LAS f32x4*)(bgate + colt + bj * HALF), b1 = *(const LAS f32x4*)(bgate + colt + bj * HALF + 4);
#pragma unroll
                for (int ai = 0; ai < 2; ++ai)
#pragma unroll
                    for (int m = 0; m < 4; ++m) {
                        f32x4 v0 = acc[ai][bj][m][0] + b0, v1 = acc[ai][bj][m][1] + b1;
#pragma unroll
                        for (int i = 0; i < 4; ++i) { v0[i] = __builtin_amdgcn_rcpf(1.f + __expf(-v0[i])); v1[i] = __builtin_amdgcn_rcpf(1.f + __expf(-v1[i])); }
                        *(v4u*)(GATES + (row0 + ai * HALF + m * 16) * GATP + colt + bj * HALF) = pack8(v0, v1);
                    }
            }
        } else {
            bf16* dst = (pn < 6) ? FOX + 1024 + (pn - 4) * 256 : (pn < 12 ? GLA + (pn - 6) * 256 : SSM + (pn - 12) * 256);
            dst += 32 * wc + 8 * fq;
#pragma unroll
            for (int ai = 0; ai < 2; ++ai)
#pragma unroll
                for (int m = 0; m < 4; ++m) { bf16* rp = dst + (row0 + ai * HALF + m * 16) * 1536;
#pragma unroll
                    for (int bj = 0; bj < 2; ++bj) *(v4u*)(rp + bj * HALF) = pack8(acc[ai][bj][m][0], acc[ai][bj][m][1]); }
        }
    }
};
struct EpiResidual {
    const float* xold; float* xnew;
    __device__ __forceinline__ void operator()(const f32x4 (&acc)[2][2][4][2], const Unit& u, int wr, int wc, int fr, int fq) const {
        asm volatile("" : "+v"(fr), "+v"(fq), "+s"(wr), "+s"(wc));
        const size_t row0 = (size_t)u.pm * BM + wr * 64 + fr; const int col0 = u.pn * BM + 32 * wc + 8 * fq;
#pragma unroll
        for (int ai = 0; ai < 2; ++ai)
#pragma unroll
            for (int mh = 0; mh < 2; ++mh) {
                f32x4 xv[2][2][2];
#pragma unroll
                for (int m2 = 0; m2 < 2; ++m2)
#pragma unroll
                    for (int bj = 0; bj < 2; ++bj) { const size_t off = (row0 + ai * HALF + (mh * 2 + m2) * 16) * D_ + col0 + bj * HALF; xv[m2][bj][0] = *(const f32x4*)(xold + off); xv[m2][bj][1] = *(const f32x4*)(xold + off + 4); }
#pragma unroll
                for (int m2 = 0; m2 < 2; ++m2)
#pragma unroll
                    for (int bj = 0; bj < 2; ++bj) { const size_t off = (row0 + ai * HALF + (mh * 2 + m2) * 16) * D_ + col0 + bj * HALF;
                        *(f32x4*)(xnew + off) = xv[m2][bj][0] + acc[ai][bj][mh * 2 + m2][0]; *(f32x4*)(xnew + off + 4) = xv[m2][bj][1] + acc[ai][bj][mh * 2 + m2][1]; }
            }
    }
};
struct MergeOrder {
    int G, c; const char* ws; const char* B;
    __device__ __forceinline__ bool next(int i, Unit& u) const { const int q = i / 3; const int tile = c + q * G; if (tile >= 256) return false; u.pm = tile >> 2; u.pn = tile & 3; u.aux = i - 3 * q; return true; }
    __device__ __forceinline__ const char* abase(const Unit& u) const { return ws + WS_FOX + (size_t)u.aux * (48 * MiB) + (size_t)(u.aux & 1) * 2048 + (size_t)u.pm * BM * 1536 * 2; }
    __device__ __forceinline__ const char* bbase(const Unit& u) const { return B + ((size_t)u.aux * 1024 + (size_t)u.pn * BM) * 512 * 2; }
};
static_assert(WS_GLA - WS_FOX == 48 * MiB && WS_SSM - WS_GLA == 48 * MiB, "MergeOrder::abase");
struct EpiMerge {
    const bf16* GATES; bf16* MB;
    __device__ __forceinline__ void operator()(const f32x4 (&acc)[2][2][4][2], const Unit& u, int wr, int wc, int fr, int fq) const {
        asm volatile("" : "+v"(fr), "+v"(fq), "+s"(wr), "+s"(wc));
        const size_t row0 = (size_t)u.pm * BM + wr * 64 + fr; const int col0 = u.pn * BM + 32 * wc + 8 * fq; const int r = u.aux;
#pragma unroll
        for (int ai = 0; ai < 2; ++ai)
#pragma unroll
            for (int mh = 0; mh < 2; ++mh) {
                v4u gv[2][2], pv[2][2];
#pragma unroll
                for (int m2 = 0; m2 < 2; ++m2)
#pragma unroll
                    for (int bj = 0; bj < 2; ++bj) { const size_t row = row0 + ai * HALF + (mh * 2 + m2) * 16;
                        gv[m2][bj] = *(const v4u*)(GATES + row * GATP + r * 1024 + col0 + bj * HALF);
                        pv[m2][bj] = (r > 0) ? *(const v4u*)(MB + row * FOXP + col0 + bj * HALF) : (v4u){0u, 0u, 0u, 0u}; }
#pragma unroll
                for (int m2 = 0; m2 < 2; ++m2)
#pragma unroll
                    for (int bj = 0; bj < 2; ++bj) { const int m = mh * 2 + m2; const size_t row = row0 + ai * HALF + m * 16; const v4u g = gv[m2][bj], p = pv[m2][bj];
                        f32x4 v0 = acc[ai][bj][m][0], v1 = acc[ai][bj][m][1];
                        v0[0] = v0[0] * bf2f(g.x & 0xffffu) + bf2f(p.x & 0xffffu); v0[1] = v0[1] * bf2f(g.x >> 16) + bf2f(p.x >> 16); v0[2] = v0[2] * bf2f(g.y & 0xffffu) + bf2f(p.y & 0xffffu); v0[3] = v0[3] * bf2f(g.y >> 16) + bf2f(p.y >> 16);
                        v1[0] = v1[0] * bf2f(g.z & 0xffffu) + bf2f(p.z & 0xffffu); v1[1] = v1[1] * bf2f(g.z >> 16) + bf2f(p.z >> 16); v1[2] = v1[2] * bf2f(g.w & 0xffffu) + bf2f(p.w & 0xffffu); v1[3] = v1[3] * bf2f(g.w >> 16) + bf2f(p.w >> 16);
                        *(v4u*)(MB + row * FOXP + col0 + bj * HALF) = pack8(v0, v1); }
            }
    }
};
}

__device__ __forceinline__ int inproj_src_col(int p) {
    const int tile = p >> 8, q = p & 255;
    if (tile < 4) { const int base = (tile < 2 ? 0 : 512) + (tile & 1) * 256; return base + 64 * ((q >> 5) & 3) + 32 * (q >> 7) + (q & 31); }
    if (tile < 6) return 1024 + (tile - 4) * 256 + q;
    if (tile < 12) return 1544 + (tile - 6) * 256 + q;
    if (tile < 17) return 3096 + (tile - 12) * 256 + q;
    if (tile == 17) return q < 8 ? 1536 + q : (q < 24 ? 3080 + (q - 8) : (q < 32 ? 4376 + (q - 24) : -1));
    return 4384 + (tile - 18) * 256 + q;
}
__device__ __forceinline__ void transpose_item(const float* W, int ldw, int src4, bf16* WT, int K, int p0, int k0, LAS float* scr, int lane) {
    const int n4 = lane & 7, kr = lane >> 3;
    f32x4 v[8];
#pragma unroll
    for (int i = 0; i < 8; ++i) v[i] = (src4 >= 0) ? *(const f32x4*)(W + (size_t)(k0 + kr + 8 * i) * ldw + src4) : (f32x4){0.f, 0.f, 0.f, 0.f};
#pragma unroll
    for (int i = 0; i < 8; ++i) *(LAS f32x4*)(scr + (kr + 8 * i) * 36 + 4 * n4) = v[i];
    asm volatile("s_waitcnt lgkmcnt(0)" ::: "memory");
    const int c = lane & 7;
#pragma unroll
    for (int j = 0; j < 4; ++j) { const int n = (lane >> 3) + 8 * j; const LAS float* sp = scr + (8 * c) * 36 + n;
        v4u o; o.x = pk2(sp[0 * 36], sp[1 * 36]); o.y = pk2(sp[2 * 36], sp[3 * 36]); o.z = pk2(sp[4 * 36], sp[5 * 36]); o.w = pk2(sp[6 * 36], sp[7 * 36]);
        *(v4u*)(WT + (size_t)(p0 + n) * K + k0 + 8 * c) = o; }
    asm volatile("s_waitcnt lgkmcnt(0)" ::: "memory");
}
__device__ __forceinline__ void convert_small_weights(const float* w_in, const float* w_branch, const float* w_out, bf16* WIN, bf16* WBR, bf16* WOUT, LAS float* scr, int wave, int lane) {
    asm volatile("" : "+s"(wave), "+v"(lane));
    const int gw = blockIdx.x * NWAVES + wave, NGW = gridDim.x * NWAVES;
    constexpr int I_IN = 16 * 240, I_BR = 8 * 32, I_OUT = 16 * 32;
    for (int it = gw; it < I_IN + 3 * I_BR + I_OUT; it += NGW) {
        int r = it;
        if (r < I_IN) { const int kb = r / 240, pb = r % 240; transpose_item(w_in, INC, inproj_src_col(pb * 32 + 4 * (lane & 7)), WIN, 1024, pb * 32, kb * 64, scr, lane); continue; } r -= I_IN;
        if (r < 3 * I_BR) { const int br = r / I_BR, q = r % I_BR, kb = q / 32, pb = q % 32; transpose_item(w_branch + (size_t)br * 512 * 1024, 1024, pb * 32 + 4 * (lane & 7), WBR + (size_t)br * 1024 * 512, 512, pb * 32, kb * 64, scr, lane); continue; } r -= 3 * I_BR;
        { const int kb = r / 32, pb = r % 32; transpose_item(w_out, 1024, pb * 32 + 4 * (lane & 7), WOUT, 1024, pb * 32, kb * 64, scr, lane); }
    }
}

template <int N> __device__ __forceinline__ void wave_sum_n(float (&v)[N]) {
#pragma unroll
    for (int o = 1; o < 64; o <<= 1) {
        float t[N];
#pragma unroll
        for (int n = 0; n < N; ++n) t[n] = __shfl_xor(v[n], o);
#pragma unroll
        for (int n = 0; n < N; ++n) v[n] += t[n]; }
}
__device__ __forceinline__ void ph_norm2_route_blk(const float* x, const float* gain, bf16* out, const float* wg, const float* bg, const float* we, const float* be,
                                                   int* tok_e, float* tok_w, int* lrank, int* cntblk, LAS unsigned char* L8, int tid, int wave, int lane) {
    asm volatile("" : "+v"(tid), "+s"(wave), "+v"(lane));
    LAS f32x4* WGT = (LAS f32x4*)L8; LAS f32x4* WET = (LAS f32x4*)(L8 + 16384); LAS int* sE = (LAS int*)(L8 + 81920); LAS int* sR = sE + 128; LAS int* sC = sE + 256;
    __syncthreads();
#pragma unroll
    for (int i = 0; i < 2; ++i) { const int k = tid + i * NTHR; WGT[(((k >> 8) * 4) + (k & 3)) * 64 + ((k >> 2) & 63)] = *(const f32x4*)(wg + (size_t)k * 4); }
#pragma unroll
    for (int i = 0; i < 8; ++i) { const int idx = tid + i * NTHR, k = idx >> 2, g4 = idx & 3; WET[((((k >> 8) * 4) + (k & 3)) * 4 + g4) * 64 + ((k >> 2) & 63)] = *(const f32x4*)(we + (size_t)idx * 4); }
    constexpr int TK = 2;
    for (int blk = blockIdx.x; blk < 256; blk += gridDim.x) {
        __syncthreads();
        if (tid < 16) sC[tid] = 0;
#pragma unroll 1
        for (int i0 = 0; i0 < 8; i0 += TK) {
            const int m0 = blk * 64 + wave * 8 + i0;
            f32x4 v[TK][4]; float ssq[TK];
#pragma unroll
            for (int q = 0; q < TK; ++q) { const f32x4* xr = (const f32x4*)(x + (size_t)(m0 + q) * D_) + lane; ssq[q] = 0.f;
#pragma unroll
                for (int j = 0; j < 4; ++j) v[q][j] = xr[64 * j]; }
#pragma unroll
            for (int q = 0; q < TK; ++q)
#pragma unroll
                for (int j = 0; j < 4; ++j) ssq[q] += (v[q][j].x * v[q][j].x + v[q][j].y * v[q][j].y) + (v[q][j].z * v[q][j].z + v[q][j].w * v[q][j].w);
            wave_sum_n<TK>(ssq);
            float gl[TK * 4];
#pragma unroll
            for (int q = 0; q < TK * 4; ++q) gl[q] = 0.f;
#pragma unroll
            for (int j = 0; j < 4; ++j) { const f32x4 g = ((const f32x4*)gain)[lane + 64 * j];
#pragma unroll
                for (int q = 0; q < TK; ++q) { const float r = rsqrtf(ssq[q] * (1.f / D_) + EPS);
                    v[q][j].x *= r * g.x; v[q][j].y *= r * g.y; v[q][j].z *= r * g.z; v[q][j].w *= r * g.w;
                    v2u w; w.x = pk2(v[q][j].x, v[q][j].y); w.y = pk2(v[q][j].z, v[q][j].w); ((v2u*)(out + (size_t)(m0 + q) * D_) + lane)[64 * j] = w; }
#pragma unroll
                for (int c = 0; c < 4; ++c) { const f32x4 a = WGT[(j * 4 + c) * 64 + lane];
#pragma unroll
                    for (int q = 0; q < TK; ++q) { const float hv = v[q][j][c]; gl[4 * q] += hv * a.x; gl[4 * q + 1] += hv * a.y; gl[4 * q + 2] += hv * a.z; gl[4 * q + 3] += hv * a.w; } } }
            wave_sum_n<TK * 4>(gl);
            int gs[TK]; float g_w[TK];
#pragma unroll
            for (int q = 0; q < TK; ++q) { float l0 = gl[4 * q] + bg[0], l1 = gl[4 * q + 1] + bg[1], l2 = gl[4 * q + 2] + bg[2], l3 = gl[4 * q + 3] + bg[3];
                int s_ = 0; float gm = l0; if (l1 > gm) { gm = l1; s_ = 1; } if (l2 > gm) { gm = l2; s_ = 2; } if (l3 > gm) { gm = l3; s_ = 3; }
                g_w[q] = 1.f / (__expf(l0 - gm) + __expf(l1 - gm) + __expf(l2 - gm) + __expf(l3 - gm)); gs[q] = __builtin_amdgcn_readfirstlane(s_); }
            float el[TK * 4];
#pragma unroll
            for (int q = 0; q < TK * 4; ++q) el[q] = 0.f;
#pragma unroll
            for (int j = 0; j < 4; ++j)
#pragma unroll
                for (int c = 0; c < 4; ++c)
#pragma unroll
                    for (int q = 0; q < TK; ++q) { const f32x4 a = WET[((j * 4 + c) * 4 + gs[q]) * 64 + lane]; const float hv = v[q][j][c];
                        el[4 * q] += hv * a.x; el[4 * q + 1] += hv * a.y; el[4 * q + 2] += hv * a.z; el[4 * q + 3] += hv * a.w; }
            wave_sum_n<TK * 4>(el);
#pragma unroll
            for (int q = 0; q < TK; ++q) { float e4[4];
#pragma unroll
                for (int c = 0; c < 4; ++c) e4[c] = el[4 * q + c] + be[4 * gs[q] + c];
                int i0_ = 0; float m0_ = e4[0];
#pragma unroll
                for (int c = 1; c < 4; ++c) if (e4[c] > m0_) { m0_ = e4[c]; i0_ = c; }
                int i1_ = -1; float m1_ = -3.0e38f;
#pragma unroll
                for (int c = 0; c < 4; ++c) if (c != i0_ && e4[c] > m1_) { m1_ = e4[c]; i1_ = c; }
                const float p1 = __expf(m1_ - m0_);
                if (lane == 0) { const int m = m0 + q, e0 = gs[q] * 4 + i0_, e1 = gs[q] * 4 + i1_; tok_e[2 * m] = e0; tok_e[2 * m + 1] = e1; tok_w[2 * m] = g_w[q] / (1.f + p1); tok_w[2 * m + 1] = g_w[q] * p1 / (1.f + p1);
                    sE[(wave * 8 + i0 + q) * 2] = e0; sE[(wave * 8 + i0 + q) * 2 + 1] = e1; } }
        }
        __syncthreads();
        if (tid < 128) { const int my = sE[tid]; int r = 0; bool last = true;
            for (int a2 = 0; a2 < 128; ++a2) { const bool same = sE[a2] == my; r += (same && a2 < tid) ? 1 : 0; last = last && !(same && a2 > tid); }
            sR[tid] = r; if (last) sC[my] = r + 1; }
        __syncthreads();
        if (tid < 16) cntblk[blk * 16 + tid] = sC[tid];
        if (tid < 128) lrank[blk * 128 + tid] = sR[tid];
    }
    __syncthreads();
}
__device__ __forceinline__ void convert_expert_weights(const float* wgate, const float* wup, const float* wdown, bf16* W1, bf16* WD, LAS float* scr, int wave, int lane) {
    asm volatile("" : "+s"(wave), "+v"(lane));
    const int gw = blockIdx.x * NWAVES + wave, NGW = gridDim.x * NWAVES;
    for (int it = gw; it < 16 * 768; it += NGW) {
        const int e = it / 768; int r = it - e * 768;
        if (r < 512) { const int kb = r >> 5, pb = r & 31, t = pb >> 3, sub = pb & 7; const float* src = ((sub < 4) ? wgate : wup) + (size_t)e * 1024 * 512;
            transpose_item(src, 512, 128 * t + (sub & 3) * 32 + 4 * (lane & 7), W1 + (size_t)e * 1024 * 1024, 1024, pb * 32, kb * 64, scr, lane); }
        else { r -= 512; const int kb = r >> 5, pb = r & 31; transpose_item(wdown + (size_t)e * 512 * 1024, 1024, pb * 32 + 4 * (lane & 7), WD + (size_t)e * 1024 * 512, 512, pb * 32, kb * 64, scr, lane); }
    }
}
__device__ __forceinline__ void ph_moe_scatter(const bf16* HB, bf16* HS, const int* tok_e, const float* tok_w, const int* lrank, const int* cntblk, int* rowtok, float* roww, int* rowof,
                                               LAS int* sPre, LAS int* sRow, LAS int* sTb, LAS int* sTot, int tid, int wave, int lane) {
    asm volatile("" : "+v"(tid), "+s"(wave), "+v"(lane));
    __syncthreads();
    { LAS int* sCnt = sPre + 4096; LAS int* sSeg = sPre + 8192;
#pragma unroll
      for (int i = 0; i < 8; ++i) sCnt[tid + i * NTHR] = cntblk[tid + i * NTHR];
      __syncthreads();
      const int e = tid & 15, seg = tid >> 4; int loc = 0;
#pragma unroll
      for (int j = 0; j < 8; ++j) loc += sCnt[(seg * 8 + j) * 16 + e];
      sSeg[seg * 16 + e] = loc;
      __syncthreads();
      if (tid < 16) { int run = 0; for (int sg = 0; sg < 32; ++sg) { const int t = sSeg[sg * 16 + tid]; sSeg[sg * 16 + tid] = run; run += t; } sTot[tid] = run; }
      __syncthreads();
      int run = sSeg[seg * 16 + e];
#pragma unroll
      for (int j = 0; j < 8; ++j) { sPre[(seg * 8 + j) * 16 + e] = run; run += sCnt[(seg * 8 + j) * 16 + e]; } }
    __syncthreads();
    if (tid == 0) { int t = 0; for (int e = 0; e < 16; ++e) { sTb[e] = t; t += (sTot[e] + 255) >> 8; } sTb[16] = t; }
    __syncthreads();
    for (int e = blockIdx.x; e < 16; e += gridDim.x) { const int r1 = sTb[e + 1] * 256; for (int r = sTb[e] * 256 + sTot[e] + tid; r < r1; r += NTHR) { rowtok[r] = -1; roww[r] = 0.f; } }
    for (int blk = blockIdx.x; blk < 256; blk += gridDim.x) {
        __syncthreads();
        if (tid < 128) { const int t = blk * 64 + (tid >> 1); const int e = tok_e[2 * t + (tid & 1)];
            const int row = sTb[e] * 256 + sPre[blk * 16 + e] + lrank[blk * 128 + tid]; rowtok[row] = t; roww[row] = tok_w[2 * t + (tid & 1)]; rowof[2 * t + (tid & 1)] = row; sRow[tid] = row; }
        __syncthreads();
        for (int a = wave; a < 128; a += NWAVES) { const int t = blk * 64 + (a >> 1); const int row = sRow[a];
            const v4u* src = (const v4u*)(HB + (size_t)t * D_); v4u* dst = (v4u*)(HS + (size_t)row * D_); const v4u a0 = src[lane], a1 = src[lane + 64]; dst[lane] = a0; dst[lane + 64] = a1; }
    }
}
namespace pg8 {
struct MoeOrder {
    int G, c; const char* A; size_t tsA; const char* B; size_t strideE, tsB; const LAS int* tb;
    __device__ __forceinline__ bool next(int i, Unit& u) const {
        const int uu = c + i * G; const int TT = __builtin_amdgcn_readfirstlane(tb[16]); if (uu >= 4 * TT) return false;
        const int grt = uu >> 2; u.pm = grt; u.pn = uu & 3; int e = 0;
#pragma unroll
        for (int k = 1; k < 16; ++k) e += (grt >= __builtin_amdgcn_readfirstlane(tb[k])) ? 1 : 0;
        u.aux = e; return true; }
    __device__ __forceinline__ const char* abase(const Unit& u) const { return A + (size_t)u.pm * tsA; }
    __device__ __forceinline__ const char* bbase(const Unit& u) const { return B + (size_t)u.aux * strideE + (size_t)u.pn * tsB; }
};
struct EpiMoe1 {
    bf16* HID;
    __device__ __forceinline__ void operator()(const f32x4 (&acc)[2][2][4][2], const Unit& u, int wr, int wc, int fr, int fq) const {
        asm volatile("" : "+v"(fr), "+v"(fq), "+s"(wr), "+s"(wc));
        const size_t row0 = (size_t)u.pm * BM + wr * 64 + fr; const int col = u.pn * 128 + 32 * wc + 8 * fq;
#pragma unroll
        for (int ai = 0; ai < 2; ++ai)
#pragma unroll
            for (int m = 0; m < 4; ++m) {
                f32x4 h0, h1;
#pragma unroll
                for (int i = 0; i < 4; ++i) { const float g0 = acc[ai][0][m][0][i], g1 = acc[ai][0][m][1][i];
                    h0[i] = g0 * __builtin_amdgcn_rcpf(1.f + __expf(-g0)) * acc[ai][1][m][0][i]; h1[i] = g1 * __builtin_amdgcn_rcpf(1.f + __expf(-g1)) * acc[ai][1][m][1][i]; }
                *(v4u*)(HID + (row0 + ai * HALF + m * 16) * 512 + col) = pack8(h0, h1);
            }
    }
};
struct EpiMoe2 {
    const float* roww; bf16* Y;
    __device__ __forceinline__ void operator()(const f32x4 (&acc)[2][2][4][2], const Unit& u, int wr, int wc, int fr, int fq) const {
        asm volatile("" : "+v"(fr), "+v"(fq), "+s"(wr), "+s"(wc));
        const size_t row0 = (size_t)u.pm * BM + wr * 64 + fr; const int col0 = u.pn * BM + 32 * wc + 8 * fq;
        float wv[2][4];
#pragma unroll
        for (int ai = 0; ai < 2; ++ai)
#pragma unroll
            for (int m = 0; m < 4; ++m) wv[ai][m] = roww[row0 + ai * HALF + m * 16];
#pragma unroll
        for (int ai = 0; ai < 2; ++ai)
#pragma unroll
            for (int m = 0; m < 4; ++m) { const size_t grow = row0 + ai * HALF + m * 16; const float w = wv[ai][m];
#pragma unroll
                for (int bj = 0; bj < 2; ++bj) *(v4u*)(Y + grow * D_ + col0 + bj * HALF) = pack8(acc[ai][bj][m][0] * w, acc[ai][bj][m][1] * w); }
    }
};
}

namespace mm {
typedef short bf16x8 __attribute__((ext_vector_type(8)));
constexpr int LD = 72;
__device__ __forceinline__ bf16x8 frag(const LAS bf16* M, int r0, int k0, int lane) { return *(const LAS bf16x8*)(M + (r0 + (lane & 15)) * LD + k0 + 8 * (lane >> 4)); }
__device__ __forceinline__ bf16x8 frag_g(const float* M, int r0, int k0, int lane) {
    const float* p = M + (size_t)(r0 + (lane & 15)) * 64 + k0 + 8 * (lane >> 4); const f32x4 a = *(const f32x4*)p, b = *(const f32x4*)(p + 4);
    const v4u w = pg8::pack8(a, b); return __builtin_bit_cast(bf16x8, w); }
__device__ __forceinline__ f32x4 mma(bf16x8 xf, bf16x8 yf, f32x4 acc) { return __builtin_amdgcn_mfma_f32_16x16x32_bf16(xf, yf, acc, 0, 0, 0); }
__device__ __forceinline__ float wave_incl_scan(float v, int lane) {
#pragma unroll
    for (int o = 1; o < 64; o <<= 1) { const float t = __shfl_up(v, o); if (lane >= o) v += t; }
    return v; }
}
constexpr int GST_CH = 8192, SST_CH = 4096;
constexpr int XCP = 768;
__device__ __forceinline__ float logsig_fast(float x) { return fminf(x, 0.f) - __logf(1.f + __expf(-fabsf(x))); }
__device__ __forceinline__ mm::bf16x8 frag_gb(const bf16* M, int r0, int k0, int lane) { return *(const mm::bf16x8*)(M + (size_t)(r0 + (lane & 15)) * 64 + k0 + 8 * (lane >> 4)); }
__device__ __forceinline__ v2u pack4(const f32x4 a) { v2u w; w.x = pg8::cvt_pk_bf16(a[0], a[1]); w.y = pg8::cvt_pk_bf16(a[2], a[3]); return w; }

__device__ __forceinline__ void gla_bcum(const float* SML, const float* w_lr, const float* b_gate, LAS float* BC, LAS float* BL, LAS float* WSM8, size_t row0, int h, int wave, int lane) {
    const int col = h * 64 + lane;
    float wc[16];
#pragma unroll
    for (int j = 0; j < 16; ++j) wc[j] = w_lr[j * 256 + col];
    const float bg = b_gate[col];
    float loc[8], run = 0.f;
#pragma unroll
    for (int i = 0; i < 8; ++i) { const f32x4* gp = (const f32x4*)(SML + (row0 + wave * 8 + i) * SMLP + 8);
        const f32x4 g0 = gp[0], g1 = gp[1], g2 = gp[2], g3 = gp[3];
        float z = bg + (g0[0] * wc[0] + g0[1] * wc[1] + g0[2] * wc[2] + g0[3] * wc[3]) + (g1[0] * wc[4] + g1[1] * wc[5] + g1[2] * wc[6] + g1[3] * wc[7])
                     + (g2[0] * wc[8] + g2[1] * wc[9] + g2[2] * wc[10] + g2[3] * wc[11]) + (g3[0] * wc[12] + g3[1] * wc[13] + g3[2] * wc[14] + g3[3] * wc[15]);
        run += logsig_fast(z) * (1.f / 16.f); loc[i] = run; }
    WSM8[wave * 64 + lane] = run;
    __syncthreads();
    float pre = 0.f;
#pragma unroll
    for (int w = 0; w < 8; ++w) pre += (w < wave) ? WSM8[w * 64 + lane] : 0.f;
#pragma unroll
    for (int i = 0; i < 8; ++i) BC[(wave * 8 + i) * 64 + lane] = pre + loc[i];
    if (wave == 7) BL[lane] = pre + run;
}
__device__ __forceinline__ void gla_stage_vt(const bf16* GLA, LAS bf16* VT, size_t row0, int h, int tid) {
#pragma unroll
    for (int j = 0; j < 2; ++j) { const int idx = tid + j * NTHR, s = idx >> 4, vg = idx & 15;
        const v4u w = *(const v4u*)(GLA + (row0 + s) * GLAP + 512 + h * 128 + vg * 8); LAS bf16* o = VT + (vg * 8) * mm::LD + s;
        o[0] = (bf16)(w.x & 0xffffu); o[mm::LD] = (bf16)(w.x >> 16); o[2 * mm::LD] = (bf16)(w.y & 0xffffu); o[3 * mm::LD] = (bf16)(w.y >> 16);
        o[4 * mm::LD] = (bf16)(w.z & 0xffffu); o[5 * mm::LD] = (bf16)(w.z >> 16); o[6 * mm::LD] = (bf16)(w.w & 0xffffu); o[7 * mm::LD] = (bf16)(w.w >> 16); }
}
__device__ __forceinline__ void gla_local_unit(bf16* GLA, bf16* QKD, const float* SML, const float* w_lr, const float* b_gate, bf16* GST, float* GDEC, LAS unsigned char* L8, int bh, int c, int tid, int wave, int lane) {
    LAS float* BC = (LAS float*)L8; LAS float* BL = (LAS float*)(L8 + 16384); LAS bf16* KE = (LAS bf16*)(L8 + 16640); LAS bf16* VT = (LAS bf16*)(L8 + 25856); LAS float* WSM8 = (LAS float*)(L8 + 44288);
    const int b = bh >> 2, h = bh & 3; const size_t row0 = (size_t)b * S_ + (size_t)c * 64;
    const int s = tid >> 3, dg = tid & 7;
    const bf16* qp = GLA + (row0 + s) * GLAP + h * 64 + dg * 8; const bf16* kp = qp + 256; bf16* qo = QKD + (row0 + s) * GLAP + h * 64 + dg * 8;
    const v4u wq = *(const v4u*)qp, wk = *(const v4u*)kp;
    __syncthreads();
    gla_bcum(SML, w_lr, b_gate, BC, BL, WSM8, row0, h, wave, lane);
    gla_stage_vt(GLA, VT, row0, h, tid);
    __syncthreads();
    { const float qf[8] = {bf2f(wq.x & 0xffffu), bf2f(wq.x >> 16), bf2f(wq.y & 0xffffu), bf2f(wq.y >> 16), bf2f(wq.z & 0xffffu), bf2f(wq.z >> 16), bf2f(wq.w & 0xffffu), bf2f(wq.w >> 16)};
      const float kf[8] = {bf2f(wk.x & 0xffffu), bf2f(wk.x >> 16), bf2f(wk.y & 0xffffu), bf2f(wk.y >> 16), bf2f(wk.z & 0xffffu), bf2f(wk.z >> 16), bf2f(wk.w & 0xffffu), bf2f(wk.w >> 16)};
      float qd[8], kd[8];
#pragma unroll
      for (int i = 0; i < 8; ++i) { const int d = dg * 8 + i; const float bc = BC[s * 64 + d]; qd[i] = qf[i] * 0.125f * __expf(bc); kd[i] = kf[i] * __expf(-bc);
          KE[d * mm::LD + s] = (bf16)f2bf(kf[i] * __expf(BL[d] - bc)); }
      v4u o; o.x = pk2(qd[0], qd[1]); o.y = pk2(qd[2], qd[3]); o.z = pk2(qd[4], qd[5]); o.w = pk2(qd[6], qd[7]); *(v4u*)qo = o;
      o.x = pk2(kd[0], kd[1]); o.y = pk2(kd[2], kd[3]); o.z = pk2(kd[4], kd[5]); o.w = pk2(kd[6], kd[7]); *(v4u*)(qo + 256) = o; }
    if (tid < 64) GDEC[((size_t)bh * 128 + c) * 64 + tid] = __expf(BL[tid]);
    __syncthreads();
    f32x4 acc[4];
#pragma unroll
    for (int i = 0; i < 4; ++i) acc[i] = (f32x4){0.f, 0.f, 0.f, 0.f};
#pragma unroll
    for (int kk = 0; kk < 64; kk += 32) { const mm::bf16x8 yf = mm::frag(VT, wave * 16, kk, lane);
#pragma unroll
        for (int dt = 0; dt < 4; ++dt) acc[dt] = mm::mma(mm::frag(KE, dt * 16, kk, lane), yf, acc[dt]); }
    bf16* dst = GST + ((size_t)bh * 128 + c) * GST_CH + (size_t)(wave * 16 + (lane & 15)) * 64 + 4 * (lane >> 4);
#pragma unroll
    for (int dt = 0; dt < 4; ++dt) *(v2u*)(dst + dt * 16) = pack4(acc[dt]);
}
__device__ __forceinline__ void gla_out_unit(bf16* GLA, bf16* OB, const bf16* GST, const float* gla_norm, LAS unsigned char* L8, int bh, int c, int tid, int wave, int lane) {
    LAS bf16* QD = (LAS bf16*)(L8 + 16640); LAS bf16* KD = (LAS bf16*)(L8 + 25856); LAS bf16* VT = (LAS bf16*)(L8 + 35072); LAS bf16* AL = (LAS bf16*)(L8 + 53504); LAS float* RED = (LAS float*)(L8 + 62720);
    const int b = bh >> 2, h = bh & 3; const size_t row0 = (size_t)b * S_ + (size_t)c * 64;
    const int tt = wave & 3, vh = wave >> 2, t = tt * 16 + (lane & 15);
    const bf16* Sc = GST + ((size_t)bh * 128 + c) * GST_CH;
    mm::bf16x8 sf[2][4]; v2u grv[4];
#pragma unroll
    for (int k2 = 0; k2 < 2; ++k2)
#pragma unroll
        for (int j = 0; j < 4; ++j) sf[k2][j] = frag_gb(Sc, (vh * 4 + j) * 16, k2 * 32, lane);
#pragma unroll
    for (int j = 0; j < 4; ++j) grv[j] = *(const v2u*)(GLA + (row0 + t) * GLAP + 1024 + h * 128 + (vh * 4 + j) * 16 + 4 * (lane >> 4));
    __syncthreads();
    { const int s = tid >> 3, dg = tid & 7; const bf16* qp = GLA + (row0 + s) * GLAP + h * 64 + dg * 8;
      *(LAS v4u*)(QD + s * mm::LD + dg * 8) = *(const v4u*)qp; *(LAS v4u*)(KD + s * mm::LD + dg * 8) = *(const v4u*)(qp + 256); }
    gla_stage_vt(GLA, VT, row0, h, tid);
    __syncthreads();
#pragma unroll
    for (int ii = 0; ii < 2; ++ii) { const int id = wave + 8 * ii, at = id >> 2, st = id & 3;
        f32x4 a = (f32x4){0.f, 0.f, 0.f, 0.f};
        if (st <= at) {
#pragma unroll
            for (int kk = 0; kk < 64; kk += 32) a = mm::mma(mm::frag(KD, st * 16, kk, lane), mm::frag(QD, at * 16, kk, lane), a); }
        const int ta = at * 16 + (lane & 15), s0 = st * 16 + 4 * (lane >> 4);
        v2u w; w.x = pk2(s0 <= ta ? a[0] : 0.f, s0 + 1 <= ta ? a[1] : 0.f); w.y = pk2(s0 + 2 <= ta ? a[2] : 0.f, s0 + 3 <= ta ? a[3] : 0.f);
        *(LAS v2u*)(AL + ta * mm::LD + s0) = w; }
    __syncthreads();
    f32x4 acc[4];
#pragma unroll
    for (int i = 0; i < 4; ++i) acc[i] = (f32x4){0.f, 0.f, 0.f, 0.f};
#pragma unroll
    for (int k2 = 0; k2 < 2; ++k2) { const mm::bf16x8 yq = mm::frag(QD, tt * 16, k2 * 32, lane), ya = mm::frag(AL, tt * 16, k2 * 32, lane);
#pragma unroll
        for (int j = 0; j < 4; ++j) { acc[j] = mm::mma(sf[k2][j], yq, acc[j]); acc[j] = mm::mma(mm::frag(VT, (vh * 4 + j) * 16, k2 * 32, lane), ya, acc[j]); } }
    float ss = 0.f;
#pragma unroll
    for (int j = 0; j < 4; ++j) ss += (acc[j][0] * acc[j][0] + acc[j][1] * acc[j][1]) + (acc[j][2] * acc[j][2] + acc[j][3] * acc[j][3]);
    ss += __shfl_xor(ss, 16); ss += __shfl_xor(ss, 32);
    if (lane < 16) RED[vh * 64 + t] = ss;
    __syncthreads();
    const float rs = rsqrtf((RED[t] + RED[64 + t]) * (1.f / 128.f) + EPS);
#pragma unroll
    for (int j = 0; j < 4; ++j) { const int v = (vh * 4 + j) * 16 + 4 * (lane >> 4);
        const f32x4 gn = *(const f32x4*)(gla_norm + v); const v2u gr = grv[j];
        v2u o; o.x = pk2(acc[j][0] * rs * gn[0] * silu_f(bf2f(gr.x & 0xffffu)), acc[j][1] * rs * gn[1] * silu_f(bf2f(gr.x >> 16)));
        o.y = pk2(acc[j][2] * rs * gn[2] * silu_f(bf2f(gr.y & 0xffffu)), acc[j][3] * rs * gn[3] * silu_f(bf2f(gr.y >> 16)));
        *(v2u*)(OB + (row0 + t) * GLAP + 1024 + h * 128 + v) = o; }
}
__device__ __forceinline__ void ssd_acs(const float* SML, const float* a_log, LAS float* ACS, LAS float* DT, LAS float* AL4, size_t row0, int g, int wave, int lane) {
    if (wave < 4) { const float dt = SML[(row0 + lane) * SMLP + 24 + 4 * g + wave]; const float a = -__expf(a_log[4 * g + wave]);
        const float v = mm::wave_incl_scan(dt * a, lane); ACS[lane * 4 + wave] = v; DT[lane * 4 + wave] = dt; if (lane == 63) AL4[wave] = v; }
}
__device__ __forceinline__ void ssd_conv8(const bf16* SSM, const float* conv_w, const float* conv_b, int b, int s, int ch0, float (&out)[8]) {
    const f32x4 b0 = *(const f32x4*)(conv_b + ch0), b1 = *(const f32x4*)(conv_b + ch0 + 4);
    float acc[8] = {b0[0], b0[1], b0[2], b0[3], b1[0], b1[1], b1[2], b1[3]};
#pragma unroll
    for (int j = 0; j < 4; ++j) { const int sp = s - 3 + j;
        if (sp >= 0) { const v4u w = *(const v4u*)(SSM + ((size_t)b * S_ + sp) * SSMP + 512 + ch0);
            const f32x4 w0 = *(const f32x4*)(conv_w + j * 768 + ch0), w1 = *(const f32x4*)(conv_w + j * 768 + ch0 + 4);
            acc[0] += w0[0] * bf2f(w.x & 0xffffu); acc[1] += w0[1] * bf2f(w.x >> 16); acc[2] += w0[2] * bf2f(w.y & 0xffffu); acc[3] += w0[3] * bf2f(w.y >> 16);
            acc[4] += w1[0] * bf2f(w.z & 0xffffu); acc[5] += w1[1] * bf2f(w.z >> 16); acc[6] += w1[2] * bf2f(w.w & 0xffffu); acc[7] += w1[3] * bf2f(w.w >> 16); } }
#pragma unroll
    for (int i = 0; i < 8; ++i) out[i] = acc[i] * __builtin_amdgcn_rcpf(1.f + __expf(-acc[i]));
}
__device__ __forceinline__ void ssd_local_unit(const bf16* SSM, const float* SML, const float* conv_w, const float* conv_b, const float* a_log, bf16* XC, bf16* SST, float* SDEC, LAS unsigned char* L8, int bg, int c, int tid, int wave, int lane) {
    LAS float* ACS = (LAS float*)L8; LAS float* DT = (LAS float*)(L8 + 1024); LAS float* AL4 = (LAS float*)(L8 + 2048); LAS bf16* XE = (LAS bf16*)(L8 + 2304); LAS bf16* BT = (LAS bf16*)(L8 + 39168);
    const int b = bg >> 1, g = bg & 1; const size_t row0 = (size_t)b * S_ + (size_t)c * 64;
    __syncthreads();
    ssd_acs(SML, a_log, ACS, DT, AL4, row0, g, wave, lane);
    __syncthreads();
    if (tid < 384) {
        const int cg = tid % 48, ts = tid / 48; const int ch0 = (cg < 32) ? (g * 256 + cg * 8) : ((cg < 40 ? 512 : 640) + g * 64 + (cg & 7) * 8);
        float wt[4][8], bs[8];
#pragma unroll
        for (int j = 0; j < 4; ++j) { const f32x4 w0 = *(const f32x4*)(conv_w + j * 768 + ch0), w1 = *(const f32x4*)(conv_w + j * 768 + ch0 + 4);
            wt[j][0] = w0[0]; wt[j][1] = w0[1]; wt[j][2] = w0[2]; wt[j][3] = w0[3]; wt[j][4] = w1[0]; wt[j][5] = w1[1]; wt[j][6] = w1[2]; wt[j][7] = w1[3]; }
        { const f32x4 b0 = *(const f32x4*)(conv_b + ch0), b1 = *(const f32x4*)(conv_b + ch0 + 4); bs[0] = b0[0]; bs[1] = b0[1]; bs[2] = b0[2]; bs[3] = b0[3]; bs[4] = b1[0]; bs[5] = b1[1]; bs[6] = b1[2]; bs[7] = b1[3]; }
        v4u rw[11];
#pragma unroll
        for (int i = 0; i < 11; ++i) { const int sp = c * 64 + ts * 8 - 3 + i; rw[i] = (sp >= 0) ? *(const v4u*)(SSM + ((size_t)b * S_ + sp) * SSMP + 512 + ch0) : (v4u){0u, 0u, 0u, 0u}; }
#pragma unroll
        for (int i = 0; i < 8; ++i) { const int t = ts * 8 + i; float v[8];
#pragma unroll
            for (int q = 0; q < 8; ++q) v[q] = bs[q];
#pragma unroll
            for (int j = 0; j < 4; ++j) { const v4u w = rw[i + j];
                v[0] += wt[j][0] * bf2f(w.x & 0xffffu); v[1] += wt[j][1] * bf2f(w.x >> 16); v[2] += wt[j][2] * bf2f(w.y & 0xffffu); v[3] += wt[j][3] * bf2f(w.y >> 16);
                v[4] += wt[j][4] * bf2f(w.z & 0xffffu); v[5] += wt[j][5] * bf2f(w.z >> 16); v[6] += wt[j][6] * bf2f(w.w & 0xffffu); v[7] += wt[j][7] * bf2f(w.w >> 16); }
#pragma unroll
            for (int q = 0; q < 8; ++q) v[q] = v[q] * __builtin_amdgcn_rcpf(1.f + __expf(-v[q]));
            v4u o; o.x = pk2(v[0], v[1]); o.y = pk2(v[2], v[3]); o.z = pk2(v[4], v[5]); o.w = pk2(v[6], v[7]); *(v4u*)(XC + (row0 + t) * XCP + ch0) = o;
            if (cg < 32) { const int hh = cg >> 3, p0 = (cg & 7) * 8; const float sc = DT[t * 4 + hh] * __expf(AL4[hh] - ACS[t * 4 + hh]); LAS bf16* q2 = XE + (hh * 64 + p0) * mm::LD + t;
#pragma unroll
                for (int q = 0; q < 8; ++q) q2[q * mm::LD] = (bf16)f2bf(v[q] * sc); }
            else if (cg < 40) { LAS bf16* q2 = BT + ((cg - 32) * 8) * mm::LD + t;
#pragma unroll
                for (int q = 0; q < 8; ++q) q2[q * mm::LD] = (bf16)f2bf(v[q]); } } }
    if (tid < 4) SDEC[((size_t)(b * 8 + 4 * g + tid)) * 128 + c] = __expf(AL4[tid]);
    __syncthreads();
    const int hh = wave >> 1;
    f32x4 acc[2][4];
#pragma unroll
    for (int j = 0; j < 2; ++j)
#pragma unroll
        for (int n = 0; n < 4; ++n) acc[j][n] = (f32x4){0.f, 0.f, 0.f, 0.f};
#pragma unroll
    for (int kk = 0; kk < 64; kk += 32)
#pragma unroll
        for (int j = 0; j < 2; ++j) { const mm::bf16x8 yf = mm::frag(XE + hh * 64 * mm::LD, ((wave & 1) * 2 + j) * 16, kk, lane);
#pragma unroll
            for (int n = 0; n < 4; ++n) acc[j][n] = mm::mma(mm::frag(BT, n * 16, kk, lane), yf, acc[j][n]); }
    bf16* dst = SST + ((size_t)(b * 8 + 4 * g + hh) * 128 + c) * SST_CH + 4 * (lane >> 4);
#pragma unroll
    for (int j = 0; j < 2; ++j) { const int p = ((wave & 1) * 2 + j) * 16 + (lane & 15);
#pragma unroll
        for (int n = 0; n < 4; ++n) *(v2u*)(dst + (size_t)p * 64 + n * 16) = pack4(acc[j][n]); }
}
__device__ __forceinline__ void ssd_out_unit(bf16* SSM, bf16* OC, const float* SML, const bf16* XC, const float* a_log, const float* d_skip, const float* ssm_norm, const bf16* SST,
                                             LAS unsigned char* L8, int bg, int c, int tid, int wave, int lane) {
    LAS float* ACS = (LAS float*)L8; LAS float* DT = (LAS float*)(L8 + 1024); LAS float* AL4 = (LAS float*)(L8 + 2048); LAS bf16* XT = (LAS bf16*)(L8 + 2304);
    LAS bf16* BM = (LAS bf16*)(L8 + 39168); LAS bf16* CM = (LAS bf16*)(L8 + 48384); LAS bf16* SCL = (LAS bf16*)(L8 + 57600); LAS float* RED = (LAS float*)(L8 + 94464);
    const int b = bg >> 1, g = bg & 1; const size_t row0 = (size_t)b * S_ + (size_t)c * 64;
    const int hh = wave >> 1, head = 4 * g + hh;
    const bf16* Sc = SST + ((size_t)(b * 8 + head) * 128 + c) * SST_CH;
    mm::bf16x8 sf[2][4];
#pragma unroll
    for (int k2 = 0; k2 < 2; ++k2)
#pragma unroll
        for (int n = 0; n < 4; ++n) sf[k2][n] = frag_gb(Sc, n * 16, k2 * 32, lane);
    __syncthreads();
    ssd_acs(SML, a_log, ACS, DT, AL4, row0, g, wave, lane);
#pragma unroll
    for (int rep = 0; rep < 6; ++rep) { const int it = tid + rep * NTHR, t = it / 48, cg = it - t * 48;
        const int ch0 = (cg < 32) ? (g * 256 + cg * 8) : ((cg < 40 ? 512 : 640) + g * 64 + (cg & 7) * 8);
        const v4u w = *(const v4u*)(XC + (row0 + t) * XCP + ch0);
        if (cg < 32) { LAS bf16* o = XT + ((cg >> 3) * 64 + (cg & 7) * 8) * mm::LD + t;
            o[0] = (bf16)(w.x & 0xffffu); o[mm::LD] = (bf16)(w.x >> 16); o[2 * mm::LD] = (bf16)(w.y & 0xffffu); o[3 * mm::LD] = (bf16)(w.y >> 16);
            o[4 * mm::LD] = (bf16)(w.z & 0xffffu); o[5 * mm::LD] = (bf16)(w.z >> 16); o[6 * mm::LD] = (bf16)(w.w & 0xffffu); o[7 * mm::LD] = (bf16)(w.w >> 16); }
        else *(LAS v4u*)((cg < 40 ? BM : CM) + t * mm::LD + (cg & 7) * 8) = w; }
    __syncthreads();
#pragma unroll
    for (int ii = 0; ii < 2; ++ii) { const int id = wave + 8 * ii, tt = id >> 2, st = id & 3;
        f32x4 a = (f32x4){0.f, 0.f, 0.f, 0.f};
        if (st <= tt) {
#pragma unroll
            for (int kk = 0; kk < 64; kk += 32) a = mm::mma(mm::frag(BM, st * 16, kk, lane), mm::frag(CM, tt * 16, kk, lane), a); }
        const int t = tt * 16 + (lane & 15), s0 = st * 16 + 4 * (lane >> 4);
#pragma unroll
        for (int h2 = 0; h2 < 4; ++h2) { const float at = ACS[t * 4 + h2]; float sc[4];
#pragma unroll
            for (int r = 0; r < 4; ++r) sc[r] = (s0 + r <= t) ? a[r] * __expf(at - ACS[(s0 + r) * 4 + h2]) * DT[(s0 + r) * 4 + h2] : 0.f;
            v2u w; w.x = pk2(sc[0], sc[1]); w.y = pk2(sc[2], sc[3]); *(LAS v2u*)(SCL + (h2 * 64 + t) * mm::LD + s0) = w; } }
    v2u zv[2][4];
#pragma unroll
    for (int j = 0; j < 2; ++j)
#pragma unroll
        for (int n = 0; n < 4; ++n) zv[j][n] = *(const v2u*)(SSM + (row0 + ((wave & 1) * 2 + j) * 16 + (lane & 15)) * SSMP + head * 64 + n * 16 + 4 * (lane >> 4));
    __syncthreads();
    f32x4 acc[2][4];
#pragma unroll
    for (int j = 0; j < 2; ++j)
#pragma unroll
        for (int n = 0; n < 4; ++n) acc[j][n] = (f32x4){0.f, 0.f, 0.f, 0.f};
#pragma unroll
    for (int k2 = 0; k2 < 2; ++k2)
#pragma unroll
        for (int j = 0; j < 2; ++j) { const mm::bf16x8 yf = mm::frag(CM, ((wave & 1) * 2 + j) * 16, k2 * 32, lane);
#pragma unroll
            for (int n = 0; n < 4; ++n) acc[j][n] = mm::mma(sf[k2][n], yf, acc[j][n]); }
#pragma unroll
    for (int j = 0; j < 2; ++j) { const float e = __expf(ACS[(((wave & 1) * 2 + j) * 16 + (lane & 15)) * 4 + hh]);
#pragma unroll
        for (int n = 0; n < 4; ++n) acc[j][n] *= e; }
#pragma unroll
    for (int kk = 0; kk < 64; kk += 32)
#pragma unroll
        for (int j = 0; j < 2; ++j) { const mm::bf16x8 yf = mm::frag(SCL + hh * 64 * mm::LD, ((wave & 1) * 2 + j) * 16, kk, lane);
#pragma unroll
            for (int n = 0; n < 4; ++n) acc[j][n] = mm::mma(mm::frag(XT + hh * 64 * mm::LD, n * 16, kk, lane), yf, acc[j][n]); }
    const float Dk = d_skip[head];
#pragma unroll
    for (int j = 0; j < 2; ++j) { const int t = ((wave & 1) * 2 + j) * 16 + (lane & 15); float ss = 0.f;
#pragma unroll
        for (int n = 0; n < 4; ++n) { const int p = n * 16 + 4 * (lane >> 4); const v2u zz = zv[j][n];
            const float zf[4] = {bf2f(zz.x & 0xffffu), bf2f(zz.x >> 16), bf2f(zz.y & 0xffffu), bf2f(zz.y >> 16)};
#pragma unroll
            for (int r = 0; r < 4; ++r) { const float xs = bf2f(XT[(hh * 64 + p + r) * mm::LD + t]); const float y = (acc[j][n][r] + Dk * xs) * silu_f(zf[r]); acc[j][n][r] = y; ss += y * y; } }
        ss += __shfl_xor(ss, 16); ss += __shfl_xor(ss, 32);
        if (lane < 16) RED[hh * 64 + t] = ss; }
    __syncthreads();
#pragma unroll
    for (int j = 0; j < 2; ++j) { const int t = ((wave & 1) * 2 + j) * 16 + (lane & 15);
        const float rs = rsqrtf(((RED[t] + RED[64 + t]) + (RED[128 + t] + RED[192 + t])) * (1.f / 256.f) + EPS);
#pragma unroll
        for (int n = 0; n < 4; ++n) { const int p = n * 16 + 4 * (lane >> 4); const f32x4 gn = *(const f32x4*)(ssm_norm + g * 256 + hh * 64 + p);
            v2u o; o.x = pk2(acc[j][n][0] * rs * gn[0], acc[j][n][1] * rs * gn[1]); o.y = pk2(acc[j][n][2] * rs * gn[2], acc[j][n][3] * rs * gn[3]);
            *(v2u*)(OC + (row0 + t) * SSMP + head * 64 + p) = o; } }
}
__device__ __forceinline__ void ph_scan(bf16* GST, const float* GDEC, bf16* SST, const float* SDEC, int tid) {
    asm volatile("" : "+v"(tid));
    for (int e = blockIdx.x * NTHR + tid; e < 65536; e += gridDim.x * NTHR) {
        const bool isg = e < 32768; const int ee = isg ? e : e - 32768;
        const int bh = isg ? (ee >> 12) : (ee >> 11), el = (isg ? (ee & 4095) : (ee & 2047)) * 2, chs = isg ? GST_CH : SST_CH;
        unsigned* base = (unsigned*)((isg ? GST : SST) + (size_t)bh * 128 * chs + el); const int step = chs / 2;
        const float* dec = isg ? GDEC + (size_t)bh * 128 * 64 + (el & 63) : SDEC + (size_t)bh * 128; const int dst = isg ? 64 : 1, d1 = isg ? 1 : 0;
        float S0 = 0.f, S1 = 0.f;
#pragma unroll 1
        for (int c0 = 0; c0 < 128; c0 += 16) { unsigned kv[16]; float da[16], db[16];
#pragma unroll
            for (int i = 0; i < 16; ++i) { kv[i] = base[(size_t)(c0 + i) * step]; da[i] = dec[(size_t)(c0 + i) * dst]; db[i] = dec[(size_t)(c0 + i) * dst + d1]; }
#pragma unroll
            for (int i = 0; i < 16; ++i) { base[(size_t)(c0 + i) * step] = pk2(S0, S1); S0 = da[i] * S0 + bf2f(kv[i] & 0xffffu); S1 = db[i] * S1 + bf2f(kv[i] >> 16); } }
    }
}
__device__ __forceinline__ void ph_local(const float* SML, bf16* GLA, bf16* QKD, const bf16* SSM, const float* w_lr, const float* b_gate, const float* conv_w, const float* conv_b, const float* a_log,
                                         bf16* GST, float* GDEC, bf16* XC, bf16* SST, float* SDEC, LAS unsigned char* L8, int tid, int wave, int lane) {
    asm volatile("" : "+v"(tid), "+s"(wave), "+v"(lane));
    for (int u = blockIdx.x; u < 1024 + 512; u += gridDim.x) {
        if (u < 1024) gla_local_unit(GLA, QKD, SML, w_lr, b_gate, GST, GDEC, L8, u >> 7, u & 127, tid, wave, lane);
        else ssd_local_unit(SSM, SML, conv_w, conv_b, a_log, XC, SST, SDEC, L8, (u - 1024) >> 7, (u - 1024) & 127, tid, wave, lane);
    }
}
__device__ __forceinline__ void ph_mixout(bf16* GLA, bf16* SSM, bf16* OB, bf16* OC, const float* SML, const float* gla_norm, const bf16* XC, const float* a_log, const float* d_skip,
                                          const float* ssm_norm, const bf16* GST, const bf16* SST, LAS unsigned char* L8, int tid, int wave, int lane) {
    asm volatile("" : "+v"(tid), "+s"(wave), "+v"(lane));
    for (int u = blockIdx.x; u < 1024 + 512; u += gridDim.x) {
        if (u < 1024) gla_out_unit(GLA, OB, GST, gla_norm, L8, u >> 7, u & 127, tid, wave, lane);
        else ssd_out_unit(SSM, OC, SML, XC, a_log, d_skip, ssm_norm, SST, L8, (u - 1024) >> 7, (u - 1024) & 127, tid, wave, lane);
    }
}

namespace attn_body {
using bf16=__hip_bfloat16;
using bf16x8=__attribute__((ext_vector_type(8)))short;
using s16x4=__attribute__((ext_vector_type(4)))short;
using f32x16=__attribute__((ext_vector_type(16)))float;
using u32x4=__attribute__((ext_vector_type(4)))unsigned;
using f32x4g=__attribute__((ext_vector_type(4)))float;
constexpr int BATCH=2,NHEAD=8,SEQ=8192,D=64,PITCH=1536;
constexpr int NW=8,QBLK=32,QB=QBLK*NW,KVBLK=64,NQB=SEQ/QB;
constexpr int ATTN_PITCH=PITCH, ATTN_UNIT_ROWS=QB;
__device__ __forceinline__ int crow(int r,int hi){return (r&3)+8*(r>>2)+4*hi;}
#define SBAR() __builtin_amdgcn_sched_barrier(0)
__device__ __forceinline__ void cmask(f32x16&p0,f32x16&p1,int jb,int qrel,int hi){
  const float NEG=-INFINITY; int kb=64*jb+4*hi;
  #pragma unroll
  for(int r=0;r<16;++r){int kv=kb+(r&3)+8*(r>>2); if(kv>qrel)p0[r]=NEG; if(kv+32>qrel)p1[r]=NEG;}
}

constexpr int NSLOT=3, SLOTB=8192;
constexpr int LDS_K=0, LDS_V=NSLOT*SLOTB, LDS_WS=2*NSLOT*SLOTB, LDS_OST=LDS_WS+NW*64*4, LDS_C=LDS_OST+NW*4096, LDS_BYTES=LDS_C+SEQ*4;
constexpr float C2=0.125f*1.4426950408889634f;
__device__ __forceinline__ void glds16(const void*gsrc,unsigned lds_dst){unsigned keep;
  asm volatile("s_mov_b32 %0, m0\n\ts_mov_b32 m0, %2\n\ts_nop 0\n\tglobal_load_lds_dwordx4 %1, off\n\ts_mov_b32 m0, %0":"=&s"(keep):"v"(gsrc),"s"(lds_dst):"memory");}
__device__ __forceinline__ float max3f(float a,float b,float c){float r;asm("v_max3_f32 %0, %1, %2, %3":"=v"(r):"v"(a),"v"(b),"v"(c));return r;}
__device__ __forceinline__ float max2f(float a,float b){float r;asm("v_max_f32_e32 %0, %1, %2":"=v"(r):"v"(a),"v"(b));return r;}
__device__ __forceinline__ float fadd_s(float a,float b){float r;asm("v_add_f32_e32 %0, %1, %2":"=v"(r):"v"(a),"v"(b));return r;}
__device__ __forceinline__ float fsub_s(float a,float b){float r;asm("v_sub_f32_e32 %0, %1, %2":"=v"(r):"v"(a),"v"(b));return r;}
typedef float f32x2_t __attribute__((ext_vector_type(2))); typedef __bf16 bf16x2_t __attribute__((ext_vector_type(2)));
__device__ __forceinline__ unsigned cvtpk_s(float lo,float hi){f32x2_t v={lo,hi};bf16x2_t b=__builtin_convertvector(v,bf16x2_t);return __builtin_bit_cast(unsigned,b);}
#define WAIT_BAR(N) asm volatile("s_waitcnt vmcnt(" #N ") lgkmcnt(0)\n\ts_barrier":::"memory")

__device__ __forceinline__ void qkt(f32x16&p0,f32x16&p1,const char*Kslot,const bf16x8*qr,int r32,int hi){
  const char*kb=Kslot+hi*1024+r32*16;
  #pragma unroll
  for(int d0=0;d0<4;++d0){
    const bf16x8 b0=*reinterpret_cast<const bf16x8*>(kb+d0*2048);
    const bf16x8 b1=*reinterpret_cast<const bf16x8*>(kb+d0*2048+512);
    {p0=__builtin_amdgcn_mfma_f32_32x32x16_bf16(b0,qr[d0],p0,0,0,0);p1=__builtin_amdgcn_mfma_f32_32x32x16_bf16(b1,qr[d0],p1,0,0,0);}}
}
typedef __attribute__((address_space(3))) const char* lds_cptr;
typedef short v4i16_t __attribute__((ext_vector_type(4)));
__device__ __forceinline__ void kload8(bf16x8*kf,lds_cptr kp){
  kf[0]=*(const __attribute__((address_space(3))) bf16x8*)(kp);      kf[1]=*(const __attribute__((address_space(3))) bf16x8*)(kp+512);
  kf[2]=*(const __attribute__((address_space(3))) bf16x8*)(kp+2048); kf[3]=*(const __attribute__((address_space(3))) bf16x8*)(kp+2560);
  kf[4]=*(const __attribute__((address_space(3))) bf16x8*)(kp+4096); kf[5]=*(const __attribute__((address_space(3))) bf16x8*)(kp+4608);
  kf[6]=*(const __attribute__((address_space(3))) bf16x8*)(kp+6144); kf[7]=*(const __attribute__((address_space(3))) bf16x8*)(kp+6656);
}
__device__ __forceinline__ void kload2(bf16x8*kf,lds_cptr kp,int j){ kf[2*j]=*(const __attribute__((address_space(3))) bf16x8*)(kp+j*2048); kf[2*j+1]=*(const __attribute__((address_space(3))) bf16x8*)(kp+j*2048+512); }
__device__ __forceinline__ s16x4 vtr(lds_cptr p){ return __builtin_bit_cast(s16x4,__builtin_amdgcn_ds_read_tr16_b64_v4i16((__attribute__((address_space(3))) v4i16_t*)p)); }
__device__ __forceinline__ float rowmax(const f32x16&p0,const f32x16&p1){
  float a=max3f(p0[0],p0[1],p1[0]),b=max3f(p0[2],p0[3],p1[1]);a=max3f(a,p1[2],p1[3]);
  #pragma unroll
  for(int r=4;r<16;r+=4){a=max3f(a,p0[r],p0[r+1]);b=max3f(b,p0[r+2],p0[r+3]);a=max3f(a,p1[r],p1[r+1]);b=max3f(b,p1[r+2],p1[r+3]);}
  const float m=max2f(a,b);
  auto rr=__builtin_amdgcn_permlane32_swap(__float_as_uint(m),__float_as_uint(m),false,false);
  return max2f(__uint_as_float(rr[0]),__uint_as_float(rr[1]));
}
__device__ __forceinline__ void pv(f32x16*o,int vb,bf16x8 pa0,bf16x8 pa1,bf16x8 pa2,bf16x8 pa3){
  #pragma unroll
  for(int d0=0;d0<2;++d0){s16x4 lo[4],hi[4];
    #pragma unroll
    for(int ks=0;ks<4;++ks){
      asm volatile("ds_read_b64_tr_b16 %0,%1 offset:%c2":"=&v"(lo[ks]):"v"(vb),"i"(d0*4096+ks*1024):"memory");
      asm volatile("ds_read_b64_tr_b16 %0,%1 offset:%c2":"=&v"(hi[ks]):"v"(vb),"i"(d0*4096+ks*1024+512):"memory");}
    asm volatile("s_waitcnt lgkmcnt(0)":::"memory");SBAR();
    #define PK(k) (bf16x8){lo[k][0],lo[k][1],lo[k][2],lo[k][3],hi[k][0],hi[k][1],hi[k][2],hi[k][3]}
    o[d0]=__builtin_amdgcn_mfma_f32_32x32x16_bf16(pa0,PK(0),o[d0],0,0,0);
    o[d0]=__builtin_amdgcn_mfma_f32_32x32x16_bf16(pa1,PK(1),o[d0],0,0,0);
    o[d0]=__builtin_amdgcn_mfma_f32_32x32x16_bf16(pa2,PK(2),o[d0],0,0,0);
    o[d0]=__builtin_amdgcn_mfma_f32_32x32x16_bf16(pa3,PK(3),o[d0],0,0,0);
    #undef PK
  }
}

#ifndef ATTN_STORE16
#define ATTN_STORE16(p,v) (*(u32x4*)(p)=(v))
#endif
template<int THRL> __device__ __forceinline__ void attn_unit(int b,int h,int qb,const bf16*Q,const bf16*__restrict__ K,const bf16*__restrict__ V,bf16*O,const float*cum,float M0,char*shm,int wave_){
  int tid=wave_*64+lane_id(); asm volatile("":"+v"(tid));
  const int lane=tid&63,r32=lane&31,hi=lane>>5; const int wid=__builtin_amdgcn_readfirstlane(tid>>6);
  const long rowbase=(long)b*SEQ; const int q0=qb*QB;
  const bf16*Qw=Q+(rowbase+q0+wid*QBLK)*PITCH+h*D;
  const float*chp=cum+((long)b*NHEAD+h)*SEQ;
  const int NTF=(q0+QB)/KVBLK;
  int tskip;
  { const float cq0=chp[q0], thr=-(2.f*M0+150.f); const int t1=lane, t2=lane+64;
    const bool s1=(t1<NTF-4)&&(cq0-chp[64*t1+63]<thr), s2=(t2<NTF-4)&&(cq0-chp[64*t2+63]<thr);
    tskip=(__builtin_popcountll(__ballot(s1))+__builtin_popcountll(__ballot(s2)))&~1; tskip=__builtin_amdgcn_readfirstlane(tskip); }
  const long kvbase=rowbase+(long)tskip*KVBLK;
  const bf16*Kh=K+kvbase*PITCH+h*D,*Vh=V+kvbase*PITCH+h*D;
  const unsigned lds0=(unsigned)(uintptr_t)shm;
  float*wsf=(float*)(shm+LDS_WS)+wid*64;
  const bf16*ksrc=Kh+(long)lane*PITCH+wid*8;
  const bf16*vsrc=Vh+(long)(16*(wid&3)+(lane>>2))*PITCH+(wid>>2)*32+(lane&3)*8;
  const unsigned kdst=lds0+LDS_K+wid*1024, vdst=lds0+LDS_V+wid*1024;
  #define DMA_K(t,slot) glds16(ksrc+(long)(t)*KVBLK*PITCH,(unsigned)__builtin_amdgcn_readfirstlane(kdst+(slot)))
  #define DMA_V(t,slot) glds16(vsrc+(long)(t)*KVBLK*PITCH,(unsigned)__builtin_amdgcn_readfirstlane(vdst+(slot)))
  const int vb0=(int)(lds0+LDS_V)+((lane>>4)&1)*32+(lane&3)*8+(4*hi+((lane&15)>>2))*64;
  const char*Kbase=shm+LDS_K; bf16x8 kf[8];
  const lds_cptr shm3=(lds_cptr)shm; const lds_cptr kp0=shm3+LDS_K+hi*1024+r32*16; const lds_cptr vp0=shm3+LDS_V+((lane>>4)&1)*32+(lane&3)*8+(4*hi+((lane&15)>>2))*64;
  const int NT=NTF-tskip;
  { const f32x4g*src4=(const f32x4g*)(chp+tskip*KVBLK); __attribute__((address_space(3))) f32x4g*dst4=(__attribute__((address_space(3))) f32x4g*)(shm3+LDS_C);
    for(int i=tid;i<NT*16;i+=NW*64)dst4[i]=src4[i]; }
  const float cqm=chp[q0+wid*QBLK+r32]-M0;
  asm volatile("s_waitcnt vmcnt(0) lgkmcnt(0)":::"memory");
  const lds_cptr cb0=shm3+LDS_C+hi*16;
  const f32x4g cq4={cqm,cqm,cqm,cqm};
  #define CBIAS(C0,C1,t) do{ const lds_cptr cp_=cb0+(t)*256; \
    _Pragma("unroll") for(int j_=0;j_<4;++j_){ const f32x4g b_=cq4-*(const __attribute__((address_space(3))) f32x4g*)(cp_+j_*32); \
      C0[4*j_]=b_[0];C0[4*j_+1]=b_[1];C0[4*j_+2]=b_[2];C0[4*j_+3]=b_[3]; } \
    _Pragma("unroll") for(int j_=0;j_<4;++j_){ const f32x4g b_=cq4-*(const __attribute__((address_space(3))) f32x4g*)(cp_+128+j_*32); \
      C1[4*j_]=b_[0];C1[4*j_+1]=b_[1];C1[4*j_+2]=b_[2];C1[4*j_+3]=b_[3]; } }while(0)
  DMA_K(0,0);DMA_V(0,0);DMA_K(1,SLOTB);
  bf16x8 qr[4];
  #pragma unroll
  for(int d0=0;d0<4;++d0)qr[d0]=*reinterpret_cast<const bf16x8*>(&Qw[(long)r32*PITCH+d0*16+hi*8]);
  float l_reg=0.f;f32x16 o[2];o[0]=f32x16{};o[1]=f32x16{};
  const int qrel=wid*QBLK+r32;
  #define CMASK(P0,P1,t) do{int jb_=(t)-(NT-4); if(jb_>=0)cmask(P0,P1,jb_,qrel,hi);}while(0)
  f32x16 pA0,pA1,pB0,pB1;
  int sl_prev=0,sl_cur=0,sl_next=SLOTB;
  #define ROT() do{sl_prev=sl_cur;sl_cur=sl_next;sl_next=(sl_next==(NSLOT-1)*SLOTB)?0:sl_next+SLOTB;}while(0)
  DMA_K(2,2*SLOTB);
  WAIT_BAR(3);
  CBIAS(pA0,pA1,0);
  qkt(pA0,pA1,Kbase,qr,r32,hi);CMASK(pA0,pA1,0);
  _Pragma("unroll") for(int r=0;r<16;++r){pA0[r]=__builtin_amdgcn_exp2f(pA0[r]);pA1[r]=__builtin_amdgcn_exp2f(pA1[r]);}
  WAIT_BAR(0);
  DMA_K(3,0);DMA_V(1,SLOTB);
  ROT();
  kload8(kf,kp0+sl_cur);
  WAIT_BAR(2);
  s16x4 vlo[8],vhi[8]; u32x4 pw0,pw1,pw2,pw3;
  #define PKW(P,B) cvtpk_s(P[B],P[B+1])
  #define PAF(k) __builtin_bit_cast(bf16x8,pw##k)
  #define VFR(i) (bf16x8){vlo[i][0],vlo[i][1],vlo[i][2],vlo[i][3],vhi[i][0],vhi[i][1],vhi[i][2],vhi[i][3]}
  #define PIN(x) asm volatile("":"+v"(x))
  #define MX3(a,b,c) __builtin_fmaxf(__builtin_fmaxf((a),(b)),(c))
  #define GAPA(MF,A0,A1,A2,A3,W0,W1,PW) do{ MF; sacc+=A0; sacc+=A1; sacc+=A2; sacc+=A3; PIN(sacc); W0; W1; PIN(PW); SBAR(); }while(0)
  #define EX(v) __builtin_amdgcn_exp2f(v)
  #define GAPB(MF,X,B) do{ MF; X[B]=EX(X[B]); X[B+1]=EX(X[B+1]); X[B+2]=EX(X[B+2]); X[B+3]=EX(X[B+3]); PIN(X); SBAR(); }while(0)
  #define VRD(i) do{ vlo[i]=vtr(vp_+(((i)>>2)*4096+((i)&3)*1024)); vhi[i]=vtr(vp_+(((i)>>2)*4096+((i)&3)*1024+512)); }while(0)
  #define KRD(G,j) do{ if(G){ kload2(kf,kp0+sl_next,j); SBAR(); } }while(0)
  #define STEP(C0,C1,P0,P1,t,GK,GV,GL) do{ SBAR(); \
    CBIAS(C0,C1,t); SBAR(); \
    const lds_cptr vp_=vp0+sl_prev; \
    VRD(0); SBAR(); float sacc=(P0[0]+P0[1]); \
    GAPA(C0=__builtin_amdgcn_mfma_f32_32x32x16_bf16(kf[0],qr[0],C0,0,0,0), P0[2],P0[3],P0[4],P0[5],     pw0[0]=PKW(P0,0), pw0[1]=PKW(P0,2), pw0); \
    VRD(4); SBAR(); GAPA(C1=__builtin_amdgcn_mfma_f32_32x32x16_bf16(kf[1],qr[0],C1,0,0,0), P0[6],P0[7],P0[8],P0[9],     pw0[2]=PKW(P0,4), pw0[3]=PKW(P0,6), pw0); \
    VRD(1); SBAR(); GAPA(C0=__builtin_amdgcn_mfma_f32_32x32x16_bf16(kf[2],qr[1],C0,0,0,0),   P0[10],P0[11],P0[12],P0[13], pw1[0]=PKW(P0,8), pw1[1]=PKW(P0,10), pw1); \
    VRD(5); SBAR(); GAPA(C1=__builtin_amdgcn_mfma_f32_32x32x16_bf16(kf[3],qr[1],C1,0,0,0),   P0[14],P0[15],P1[0],P1[1],   pw1[2]=PKW(P0,12),pw1[3]=PKW(P0,14), pw1); \
    VRD(2); SBAR(); GAPA(C0=__builtin_amdgcn_mfma_f32_32x32x16_bf16(kf[4],qr[2],C0,0,0,0),   P1[2],P1[3],P1[4],P1[5],     pw2[0]=PKW(P1,0), pw2[1]=PKW(P1,2), pw2); \
    VRD(6); SBAR(); GAPA(C1=__builtin_amdgcn_mfma_f32_32x32x16_bf16(kf[5],qr[2],C1,0,0,0),   P1[6],P1[7],P1[8],P1[9],     pw2[2]=PKW(P1,4), pw2[3]=PKW(P1,6), pw2); \
    VRD(3); SBAR(); GAPA(C0=__builtin_amdgcn_mfma_f32_32x32x16_bf16(kf[6],qr[3],C0,0,0,0),   P1[10],P1[11],P1[12],P1[13], pw3[0]=PKW(P1,8), pw3[1]=PKW(P1,10), pw3); \
    VRD(7); SBAR(); GAPA(C1=__builtin_amdgcn_mfma_f32_32x32x16_bf16(kf[7],qr[3],C1,0,0,0),   P1[14],P1[15],0.f,0.f,       pw3[2]=PKW(P1,12),pw3[3]=PKW(P1,14), pw3); \
    l_reg+=sacc; \
    if(GK){DMA_K((t)+3,sl_cur);} if(GV){DMA_V((t)+1,sl_next);} \
    CMASK(C0,C1,t); \
    SBAR(); \
    GAPB(o[0]=__builtin_amdgcn_mfma_f32_32x32x16_bf16(PAF(0),VFR(0),o[0],0,0,0), C0,0); \
    GAPB(o[1]=__builtin_amdgcn_mfma_f32_32x32x16_bf16(PAF(0),VFR(4),o[1],0,0,0), C0,4); \
    KRD(GL,0); GAPB(o[0]=__builtin_amdgcn_mfma_f32_32x32x16_bf16(PAF(1),VFR(1),o[0],0,0,0), C0,8); \
    KRD(GL,1); GAPB(o[1]=__builtin_amdgcn_mfma_f32_32x32x16_bf16(PAF(1),VFR(5),o[1],0,0,0), C0,12); \
    KRD(GL,2); GAPB(o[0]=__builtin_amdgcn_mfma_f32_32x32x16_bf16(PAF(2),VFR(2),o[0],0,0,0), C1,0); \
    KRD(GL,3); GAPB(o[1]=__builtin_amdgcn_mfma_f32_32x32x16_bf16(PAF(2),VFR(6),o[1],0,0,0), C1,4); \
    GAPB(o[0]=__builtin_amdgcn_mfma_f32_32x32x16_bf16(PAF(3),VFR(3),o[0],0,0,0), C1,8); \
    GAPB(o[1]=__builtin_amdgcn_mfma_f32_32x32x16_bf16(PAF(3),VFR(7),o[1],0,0,0), C1,12); \
    }while(0)
  int t=1;
  #undef CMASK
  #define CMASK(P0,P1,t) do{}while(0)
  for(;t+5<NT;t+=2){
    STEP(pB0,pB1,pA0,pA1,t,true,true,true);     WAIT_BAR(2); ROT();
    STEP(pA0,pA1,pB0,pB1,t+1,true,true,true);   WAIT_BAR(2); ROT();
  }
  #undef CMASK
  #define CMASK(P0,P1,t) do{int jb_=(t)-(NT-4); if(jb_>=0)cmask(P0,P1,jb_,qrel,hi);}while(0)
  #define ENDW(tt) do{ if((tt)+3<NT){WAIT_BAR(2);} else if((tt)+2<NT){WAIT_BAR(1);} else {WAIT_BAR(0);} }while(0)
  for(;t+1<NT;t+=2){
    STEP(pB0,pB1,pA0,pA1,t,(t+3<NT),(t+1<NT),(t+1<NT));       ENDW(t);   ROT();
    STEP(pA0,pA1,pB0,pB1,t+1,(t+4<NT),(t+2<NT),(t+2<NT));     ENDW(t+1); ROT();
  }
  STEP(pB0,pB1,pA0,pA1,NT-1,false,false,false);
  { float sacc=pB0[0]+pB0[1]; _Pragma("unroll") for(int r=2;r<16;++r)sacc+=pB0[r]; _Pragma("unroll") for(int r=0;r<16;++r)sacc+=pB1[r]; l_reg+=sacc;
    pw0=(u32x4){PKW(pB0,0),PKW(pB0,2),PKW(pB0,4),PKW(pB0,6)};pw1=(u32x4){PKW(pB0,8),PKW(pB0,10),PKW(pB0,12),PKW(pB0,14)};pw2=(u32x4){PKW(pB1,0),PKW(pB1,2),PKW(pB1,4),PKW(pB1,6)};pw3=(u32x4){PKW(pB1,8),PKW(pB1,10),PKW(pB1,12),PKW(pB1,14)};
    SBAR(); pv(o,vb0+sl_cur,PAF(0),PAF(1),PAF(2),PAF(3)); }
  #undef PKW
  #undef PAF
  #undef VFR
  #undef PIN
  #undef MX3
  #undef GAPA
  #undef GAPB
  #undef EX
  #undef VRD
  #undef KRD
  #undef STEP
  #undef ENDW
  {auto rr=__builtin_amdgcn_permlane32_swap(__float_as_uint(l_reg),__float_as_uint(l_reg),false,false);l_reg=__uint_as_float(rr[0])+__uint_as_float(rr[1]);}
  if(hi==0)wsf[32+r32]=l_reg;asm volatile("s_waitcnt lgkmcnt(0)":::"memory");
  float rli[16];
  #pragma unroll
  for(int r=0;r<16;++r)rli[r]=__builtin_amdgcn_rcpf(wsf[32+crow(r,hi)]);
  bf16*Ow=O+(rowbase+q0+wid*QBLK)*PITCH+h*D;
  { bf16*stg=(bf16*)(shm+LDS_OST)+wid*2048;
    #pragma unroll
    for(int r=0;r<16;++r){const int orow=crow(r,hi);
      #pragma unroll
      for(int d0=0;d0<2;++d0)stg[orow*64+d0*32+r32]=__float2bfloat16(o[d0][r]*rli[r]);}
    asm volatile("s_waitcnt lgkmcnt(0)":::"memory");
    #pragma unroll
    for(int i=0;i<4;++i){const int row=i*8+(lane>>3),ch=lane&7; const u32x4 v=*(const u32x4*)(stg+row*64+ch*8); ATTN_STORE16(Ow+(long)row*PITCH+ch*8,v);} }
  asm volatile("s_waitcnt lgkmcnt(0)\n\ts_barrier":::"memory");
  #undef DMA_K
  #undef DMA_V
  #undef CMASK
  #undef CBIAS
  #undef ROT
}
constexpr int ATTN_LDS_BYTES=LDS_BYTES;
struct AttnTensors { const bf16* Q; const bf16* K; const bf16* V; bf16* O; const float* cum; float M0; };
struct AttnUnit { int bh; int qb; };
struct PairOrder {
  int vcu,G;
  __device__ __forceinline__ bool next(int i,AttnUnit&u)const{ const int p=vcu+(i>>1)*G; if(p>=256)return false; const int s=p&15; u.bh=p>>4; u.qb=(i&1)?s:31-s; return true; }
};
template<class Sched> __device__ __forceinline__ void attn_phase(char*lds,const AttnTensors&T,const Sched&S,int wave_){
  AttnUnit u;
  for(int i=0;S.next(i,u);++i){ attn_unit<0>(u.bh/NHEAD,u.bh%NHEAD,u.qb,T.Q,T.K,T.V,T.O,T.cum,T.M0,lds,wave_); }
}
__device__ __forceinline__ void attn_phase_dyn(char*lds,const AttnTensors&T,unsigned*ctr,volatile __attribute__((address_space(3))) unsigned*slot,int wave_){
  for(;;){
    if(wave_==0&&lane_id()==0)*slot=__hip_atomic_fetch_add(ctr,1u,__ATOMIC_RELAXED,__HIP_MEMORY_SCOPE_AGENT);
    __syncthreads();
    const unsigned n=*slot;
    __syncthreads();
    if(n>=512u)break;
    attn_unit<0>((int)(n&15u)/NHEAD,(int)(n&15u)%NHEAD,31-(int)(n>>4),T.Q,T.K,T.V,T.O,T.cum,T.M0,lds,wave_);
  }
}
#undef SBAR
#undef WAIT_BAR
}
constexpr int NPH = FAST_MOE ? 11 : 9;
struct Args { const float* in[26]; float* out; unsigned char* ws; int ph_lo, ph_hi; };
__global__ void __launch_bounds__(NTHR, 2) mega(Args a) {
    extern __shared__ __attribute__((aligned(16))) unsigned char lds[];
    const int wave = __builtin_amdgcn_readfirstlane((int)threadIdx.x >> 6);
#define LANE_ (lane_id())
#define TID_ (wave * 64 + lane_id())
    LAS unsigned char* L8 = (LAS unsigned char*)lds;
    LAS float* L = (LAS float*)lds;
    volatile LAS unsigned* MISC = (volatile LAS unsigned*)(L8 + MISC_OFF);
    for (int u = TID_; u < (LDS_BYTES - LDSCTL_OFF) / 4; u += NTHR) ((LAS unsigned*)(L8 + LDSCTL_OFF))[u] = 0u;
    __syncthreads();
    unsigned char* ws = a.ws;
    unsigned* ctl = (unsigned*)(ws + WS_CTL);
    if (!MK_SPLIT) (void)xcd_barrier_post(ctl + CW_BAR, MISC + 8, wave == 0 && lane_id() == 0);
#define WIN   ((bf16*)(opq(ws) + WS_WIN))
#define WBR   ((bf16*)(opq(ws) + WS_WBR))
#define WOUT  ((bf16*)(opq(ws) + WS_WOUT))
#define HB    ((bf16*)(opq(ws) + WS_HB))
#define FOX   ((bf16*)(opq(ws) + WS_FOX))
#define GLA   ((bf16*)(opq(ws) + WS_GLA))
#define SSM   ((bf16*)(opq(ws) + WS_SSM))
#define SML   ((float*)(opq(ws) + WS_SML))
#define CUM   ((float*)(opq(ws) + WS_CUM))
#define TOKE  ((int*)(opq(ws) + WS_TOKE))
#define TOKW  ((float*)(opq(ws) + WS_TOKW))
#define GATES ((bf16*)(opq(ws) + WS_GATES))
#define LRANK ((int*)(opq(ws) + WS_LRANK))
#define ROWTOK ((int*)(opq(ws) + WS_ROWTOK))
#define ROWW  ((float*)(opq(ws) + WS_ROWW))
#define CNTBLK ((int*)(opq(ws) + WS_CNTBLK))
#define W1E   ((bf16*)(opq(ws) + WS_W1E))
#define WDE   ((bf16*)(opq(ws) + WS_WDE))
#define HID   ((bf16*)(opq(ws) + WS_HID))
#define HS    ((bf16*)(opq(ws) + WS_HS))
#define YB    ((bf16*)(opq(ws) + WS_YB))
#define ROWOF ((int*)(opq(ws) + WS_ROWOF))
#define GST   ((bf16*)(opq(ws) + WS_GST))
#define SST   ((bf16*)(opq(ws) + WS_SSTB))
#define XC    ((bf16*)(opq(ws) + WS_XC))
#define GDEC  ((float*)(opq(ws) + WS_GDEC))
#define SDEC  ((float*)(opq(ws) + WS_SDEC))
    const int lo = a.ph_lo, hi = a.ph_hi;
#define IN(k) (lo <= (k) && (k) < hi)
#define GRID_BARRIER() do { XcdBarrier b_; b_.bar = (unsigned*)(opq(ws) + WS_CTL) + CW_BAR; b_.x = xb_xcc_id(); b_.st = (volatile LAS unsigned*)((LAS unsigned char*)lds + MISC_OFF) + 8; xcd_barrier(b_, wave == 0 && lane_id() == 0); } while (0)
#define PH_BEGIN(k) if (IN(pb + (k))) for (int rep_ = 0; rep_ < (((k) == REPEAT_PHASE && l == 0) ? 2 : 1); ++rep_) { if (rep_) GRID_BARRIER();
#define DUMMY_(k) ((k) == REPEAT_PHASE && l == 0 && rep_ == 0)
#if PROF_PHASE >= 0
    unsigned long long tacc = 0ull, tprev = __builtin_amdgcn_s_memrealtime();
#define SEAM(k) do { if (IN(k) && IN((k) + 1)) GRID_BARRIER(); { const unsigned long long tn_ = __builtin_amdgcn_s_memrealtime(); if (((k) % NPH) == PROF_PHASE || PROF_PHASE == 99) tacc += tn_ - tprev; tprev = tn_; } } while (0)
#else
#define SEAM(k) do { if (IN(k) && IN((k) + 1)) GRID_BARRIER(); } while (0)
#endif
    for (int l = 0; l < NLAYER; ++l) {
        const int pb = l * NPH;
        const float* xin = (l == 0) ? ((const float*)(const GAS float*)a.in[0]) : ((float*)(GAS float*)a.out);
        PH_BEGIN(0) if (l == 0) ph_norm(xin, ((const float*)(const GAS float*)a.in[1]) + l * D_, HB, wave, LANE_);
            else ph_norm_combine(((float*)(GAS float*)a.out), YB, ROWOF, ((const float*)(const GAS float*)a.in[1]) + l * D_, HB, wave, LANE_);
            convert_small_weights(((const float*)(const GAS float*)a.in[2]) + (size_t)l * D_ * INC, ((const float*)(const GAS float*)a.in[15]) + (size_t)l * 3 * 512 * 1024, ((const float*)(const GAS float*)a.in[17]) + (size_t)l * D_ * D_, WIN, WBR, WOUT, L + wave * 2304, wave, LANE_); }
        SEAM(pb + 0);
        PH_BEGIN(1)
#if FAST_INPROJ
#if DUAL_INPROJ
            ph_inproj_simple(HB, ((const float*)(const GAS float*)a.in[2]) + (size_t)l * D_ * INC, ((const float*)(const GAS float*)a.in[3]) + l * 8, ((const float*)(const GAS float*)a.in[4]) + l * 64, ((const float*)(const GAS float*)a.in[5]) + l * 64, ((const float*)(const GAS float*)a.in[11]) + l * 8, ((const float*)(const GAS float*)a.in[16]) + l * 3072, FOX, GLA, SSM, SML, GATES, TID_);
            GRID_BARRIER();
#endif
            pg8::GridOrder S; S.init(T_, 7680, (int)gridDim.x, (int)blockIdx.x, HB, 1024, WIN, 1024);
            { LAS float* LB = (LAS float*)(L8 + LDS_BIAS); const int t_ = TID_;
#pragma unroll
              for (int i = 0; i < 6; ++i) LB[t_ + i * NTHR] = ((const float*)(const GAS float*)a.in[16])[l * 3072 + t_ + i * NTHR];
              if (t_ < 64) { LB[3072 + t_] = ((const float*)(const GAS float*)a.in[4])[l * 64 + t_]; LB[3136 + t_] = ((const float*)(const GAS float*)a.in[5])[l * 64 + t_]; }
              if (t_ < 8) { LB[3200 + t_] = ((const float*)(const GAS float*)a.in[3])[l * 8 + t_]; LB[3208 + t_] = ((const float*)(const GAS float*)a.in[11])[l * 8 + t_]; }
              __syncthreads(); }
            const LAS float* LBc = (const LAS float*)(L8 + LDS_BIAS);
            pg8::EpiInproj E{FOX, GLA, SSM, SML, GATES, LBc + 3072, LBc + 3136, LBc + 3200, LBc + 3208, LBc};
            pg8::gemm_phase(L8, 1024, 1024, S, E, wave);
#else
            ph_inproj_simple(HB, ((const float*)(const GAS float*)a.in[2]) + (size_t)l * D_ * INC, ((const float*)(const GAS float*)a.in[3]) + l * 8, ((const float*)(const GAS float*)a.in[4]) + l * 64, ((const float*)(const GAS float*)a.in[5]) + l * 64, ((const float*)(const GAS float*)a.in[11]) + l * 8, ((const float*)(const GAS float*)a.in[16]) + l * 3072, FOX, GLA, SSM, SML, GATES, TID_);
#endif
        }
        SEAM(pb + 1);
        PH_BEGIN(2) ph_cumsum(SML, CUM, L, TID_);
#if FAST_MIX
            ph_local(SML, GLA, DUMMY_(2) ? (bf16*)((float*)(GAS float*)a.out) : GLA, SSM, ((const float*)(const GAS float*)a.in[6]) + l * 16 * 256, ((const float*)(const GAS float*)a.in[7]) + l * 256, ((const float*)(const GAS float*)a.in[9]) + l * 4 * 768, ((const float*)(const GAS float*)a.in[10]) + l * 768, ((const float*)(const GAS float*)a.in[12]) + l * 8, GST, GDEC, XC, SST, SDEC, L8, TID_, wave, LANE_);
#endif
        }
        SEAM(pb + 2);
        PH_BEGIN(3)
#if FAST_MIX
            if (!DUMMY_(3)) ph_scan(GST, GDEC, SST, SDEC, TID_);
#else
            ph_mix_simple(FOX, CUM, GLA, SSM, SML, ((const float*)(const GAS float*)a.in[6]) + l * 16 * 256, ((const float*)(const GAS float*)a.in[7]) + l * 256, ((const float*)(const GAS float*)a.in[9]) + l * 4 * 768, ((const float*)(const GAS float*)a.in[10]) + l * 768, ((const float*)(const GAS float*)a.in[12]) + l * 8, ((const float*)(const GAS float*)a.in[13]) + l * 8, L, TID_, wave, LANE_);
#endif
#if FAST_ATTN
            { const float gq = ((const float*)(const GAS float*)a.in[4])[l * 64 + LANE_], gk = ((const float*)(const GAS float*)a.in[5])[l * 64 + LANE_];
              float gm = fabsf(gq * gk);
#pragma unroll
              for (int o = 1; o < 64; o <<= 1) gm = fmaxf(gm, __shfl_xor(gm, o));
              const float M0 = 8.f * LOG2E * 1.01f * gm;
              const attn_body::AttnTensors AT{(const attn_body::bf16*)FOX, (const attn_body::bf16*)(FOX + 512), (const attn_body::bf16*)(FOX + 1024), DUMMY_(3) ? (attn_body::bf16*)((float*)(GAS float*)a.out) : (attn_body::bf16*)FOX, CUM, M0};
              const int G = (int)gridDim.x, bx = (int)blockIdx.x;
              const attn_body::PairOrder S{(G % 8 == 0) ? (bx % 8) * (G / 8) + bx / 8 : bx, G};
              (void)S; attn_body::attn_phase_dyn((char*)lds, AT, (unsigned*)(opq(ws) + WS_CTL) + 8192 + 64 * l + (DUMMY_(3) ? 32 : 0), MISC + 16, wave); }
#endif
        }
        SEAM(pb + 3);
        PH_BEGIN(4)
#if FAST_MIX
            ph_mixout(GLA, SSM, DUMMY_(4) ? (bf16*)((float*)(GAS float*)a.out) : GLA, DUMMY_(4) ? (bf16*)((float*)(GAS float*)a.out) : SSM, SML, ((const float*)(const GAS float*)a.in[8]) + l * 128, XC, ((const float*)(const GAS float*)a.in[12]) + l * 8, ((const float*)(const GAS float*)a.in[13]) + l * 8, ((const float*)(const GAS float*)a.in[14]) + l * 512, GST, SST, L8, TID_, wave, LANE_);
#else
            ph_post(GLA, SSM, ((const float*)(const GAS float*)a.in[8]) + l * 128, ((const float*)(const GAS float*)a.in[14]) + l * 512, wave, LANE_);
#endif
        }
        SEAM(pb + 4);
        PH_BEGIN(5)
#if FAST_MERGE
            pg8::MergeOrder S{(int)gridDim.x, (int)blockIdx.x, (const char*)opq(ws), (const char*)WBR};
            pg8::EpiMerge E{GATES, FOX + 512};
            pg8::gemm_phase(L8, 512, 1536, S, E, wave);
#else
            ph_merge_simple(FOX, GLA, SSM, GATES, ((const float*)(const GAS float*)a.in[15]) + (size_t)l * 3 * 512 * 1024, TID_);
#endif
        }
        SEAM(pb + 5);
        PH_BEGIN(6)
#if FAST_OUT
            pg8::GridOrder S; S.init(T_, 1024, (int)gridDim.x, (int)blockIdx.x, FOX + 512, 1536, WOUT, 1024);
            pg8::EpiResidual E{xin, ((float*)(GAS float*)a.out)};
            pg8::gemm_phase(L8, 1024, 1536, S, E, wave);
#else
            ph_out_simple(FOX, ((const float*)(const GAS float*)a.in[17]) + (size_t)l * D_ * D_, xin, ((float*)(GAS float*)a.out), TID_);
#endif
        }
        SEAM(pb + 6);
#if FAST_MOE
        PH_BEGIN(7)
            ph_norm2_route_blk(((float*)(GAS float*)a.out), ((const float*)(const GAS float*)a.in[18]) + l * D_, HB, ((const float*)(const GAS float*)a.in[19]) + l * D_ * 4, ((const float*)(const GAS float*)a.in[20]) + l * 4,
                               ((const float*)(const GAS float*)a.in[21]) + l * D_ * 16, ((const float*)(const GAS float*)a.in[22]) + l * 16, TOKE, TOKW, LRANK, CNTBLK, L8, TID_, wave, LANE_);
            convert_expert_weights(((const float*)(const GAS float*)a.in[23]) + (size_t)l * 16 * 1024 * 512, ((const float*)(const GAS float*)a.in[24]) + (size_t)l * 16 * 1024 * 512,
                                   ((const float*)(const GAS float*)a.in[25]) + (size_t)l * 16 * 512 * 1024, W1E, WDE, L + wave * 2304, wave, LANE_);
        }
        SEAM(pb + 7);
        PH_BEGIN(8) ph_moe_scatter(HB, HS, TOKE, TOKW, LRANK, CNTBLK, ROWTOK, ROWW, ROWOF, (LAS int*)L8, (LAS int*)(L8 + 40960), (LAS int*)(L8 + LDS_TB), (LAS int*)(L8 + LDS_TOT), TID_, wave, LANE_); }
        SEAM(pb + 8);
        PH_BEGIN(9)
            pg8::MoeOrder S{(int)gridDim.x, (int)blockIdx.x, (const char*)HS, (size_t)256 * 1024 * 2, (const char*)W1E, (size_t)1024 * 1024 * 2, (size_t)256 * 1024 * 2, (const LAS int*)(L8 + LDS_TB)};
            pg8::EpiMoe1 E{HID};
            pg8::gemm_phase(L8, 1024, 1024, S, E, wave);
        }
        SEAM(pb + 9);
        PH_BEGIN(10)
            pg8::MoeOrder S{(int)gridDim.x, (int)blockIdx.x, (const char*)HID, (size_t)256 * 512 * 2, (const char*)WDE, (size_t)1024 * 512 * 2, (size_t)256 * 512 * 2, (const LAS int*)(L8 + LDS_TB)};
            pg8::EpiMoe2 E{ROWW, YB};
            pg8::gemm_phase(L8, 512, 512, S, E, wave);
        }
        SEAM(pb + 10);
#else
        if (IN(pb + 7)) ph_norm2_route(((float*)(GAS float*)a.out), ((const float*)(const GAS float*)a.in[18]) + l * D_, HB, ((const float*)(const GAS float*)a.in[19]) + l * D_ * 4, ((const float*)(const GAS float*)a.in[20]) + l * 4, ((const float*)(const GAS float*)a.in[21]) + l * D_ * 16, ((const float*)(const GAS float*)a.in[22]) + l * 16, TOKE, TOKW, wave, LANE_);
        SEAM(pb + 7);
        if (IN(pb + 8)) ph_moe_simple(HB, TOKE, TOKW, ((const float*)(const GAS float*)a.in[23]) + (size_t)l * 16 * 1024 * 512, ((const float*)(const GAS float*)a.in[24]) + (size_t)l * 16 * 1024 * 512, ((const float*)(const GAS float*)a.in[25]) + (size_t)l * 16 * 512 * 1024, ((float*)(GAS float*)a.out), L, TID_);
        SEAM(pb + 8);
#endif
    }
    if (IN(NLAYER * NPH)) ph_norm_combine(((float*)(GAS float*)a.out), YB, ROWOF, nullptr, nullptr, wave, LANE_);
#if PROF_PHASE >= 0
    if (blockIdx.x == 0 && TID_ == 0) ((float*)(GAS float*)a.out)[0] = (float)tacc * 1.0e4f;
#endif
#undef IN
#undef SEAM
}

extern "C" void kernel_launch(void* const* d_in, const int* in_sizes, int n_in, void* d_out, int out_size, void* d_ws, size_t ws_size, hipStream_t stream) {
    static int grid = 0;
    if (grid == 0) {
        if (n_in != 26 || out_size != T_ * D_ || ws_size < WS_END) { fprintf(stderr, "kernel_launch: unexpected sizes\n"); grid = -1; return; }
        int dev = 0, cus = 0;
        if (hipGetDevice(&dev) != hipSuccess || hipDeviceGetAttribute(&cus, hipDeviceAttributeMultiprocessorCount, dev) != hipSuccess) { grid = -1; return; }
        if (hipFuncSetAttribute((const void*)mega, hipFuncAttributeMaxDynamicSharedMemorySize, LDS_BYTES) != hipSuccess) { grid = -1; return; }
        int per_cu = 0;
        (void)hipOccupancyMaxActiveBlocksPerMultiprocessor(&per_cu, (const void*)mega, NTHR, LDS_BYTES);
        (void)hipGetLastError();
        grid = cus;
    }
    if (grid < 0) return;
    if (hipMemsetAsync((char*)d_ws + WS_CTL, 0, CTL_ZERO_BYTES, stream) != hipSuccess) return;
    Args a{};
    for (int i = 0; i < 26; ++i) a.in[i] = (const float*)d_in[i];
    a.out = (float*)d_out; a.ws = (unsigned char*)d_ws;
#if MK_SPLIT
    for (int p = 0; p < NLAYER * NPH + 1; ++p) { a.ph_lo = p; a.ph_hi = p + 1; hipLaunchKernelGGL(mega, dim3(grid), dim3(NTHR), LDS_BYTES, stream, a); }
#else
    a.ph_lo = 0; a.ph_hi = NLAYER * NPH + 1;
    hipLaunchKernelGGL(mega, dim3(grid), dim3(NTHR), LDS_BYTES, stream, a);
#endif
}
```
